# Optimizing an MI355X kernel written in HIP

```python
import math
import jax, jax.numpy as jnp
from jax import lax
import numpy as np

D_MODEL = 2048
BATCH = 8
SEQ = 4096
DEPTH = 1
DEC_BATCH = 32
DEC_SEQ = 16
PAST_LEN = 1024

CHUNK = 64
LEFT_CHUNKS = 8
BAND_ROWS = LEFT_CHUNKS * CHUNK
HEAD_DIM = 128
A_HEADS = 8
A_WIDTH = A_HEADS * HEAD_DIM
MAX_REL = 256
N_REL = 2 * MAX_REL + 1
R_WIDTH = 1024
R_BLOCKS = 16
R_BLOCK = R_WIDTH // R_BLOCKS
CONV_W = 4
LRU_C = 8.0
N_MEM = 256
M_HEADS = 4
M_WIDTH = M_HEADS * HEAD_DIM
D_FF = 5632
EPS = 1e-6
IN_COLS = 3 * A_WIDTH + 2 * R_WIDTH + 2 * D_MODEL
SPLITS = [A_WIDTH, 2 * A_WIDTH, 3 * A_WIDTH, 3 * A_WIDTH + R_WIDTH,
          3 * A_WIDTH + 2 * R_WIDTH, 3 * A_WIDTH + 2 * R_WIDTH + D_MODEL]

kernel_name = 'hybrid_chunk_attn_rglru_macaron_step'


def _rmsnorm(x, g):
    xf = x.astype(jnp.float32)
    y = xf * lax.rsqrt(jnp.mean(xf * xf, axis=-1, keepdims=True) + EPS)
    return (y * g.astype(jnp.float32)).astype(x.dtype)


def _swiglu(x, wg, wu, wd):
    return (jax.nn.silu(x @ wg) * (x @ wu)) @ wd


def _chunk_attn_prompt(q, k, v, rel_bias):
    B, S, H, Dh = q.shape
    nc = S // CHUNK
    band = BAND_ROWS + CHUNK
    pad = ((0, 0), (BAND_ROWS, 0), (0, 0), (0, 0))
    kp = jnp.pad(k, pad)
    vp = jnp.pad(v, pad)
    qc = q.reshape(B, nc, CHUNK, H, Dh).transpose(1, 0, 2, 3, 4)
    qi = jnp.arange(CHUNK)[:, None]
    kj = jnp.arange(band)[None, :]
    rel = jnp.clip(qi + BAND_ROWS - kj, -MAX_REL, MAX_REL) + MAX_REL
    bias = rel_bias.astype(jnp.float32)[:, rel]
    scale = Dh ** -0.5

    def one_chunk(args):
        c, qb = args
        start = c * CHUNK
        kb = lax.dynamic_slice_in_dim(kp, start, band, axis=1)
        vb = lax.dynamic_slice_in_dim(vp, start, band, axis=1)
        s = jnp.einsum('bqhd,bkhd->bhqk', qb, kb).astype(jnp.float32) * scale + bias[None]
        kpos = start - BAND_ROWS + jnp.arange(band)
        s = jnp.where((kpos >= 0)[None, None, None, :], s, -1e30)
        p = jax.nn.softmax(s, axis=-1).astype(vb.dtype)
        return jnp.einsum('bhqk,bkhd->bqhd', p, vb)

    out = lax.map(one_chunk, (jnp.arange(nc), qc))
    return out.transpose(1, 0, 2, 3, 4).reshape(B, S, H * Dh)


def _chunk_attn_sample(q, k, v, rel_bias, k_cache, v_cache):
    Bd, T, H, Dh = q.shape
    W = k_cache.shape[1]
    kk = jnp.concatenate([k_cache, k], axis=1)
    vv = jnp.concatenate([v_cache, v], axis=1)
    qpos = PAST_LEN + jnp.arange(T)
    kpos = jnp.concatenate([PAST_LEN - W + jnp.arange(W), PAST_LEN + jnp.arange(T)])
    rel = jnp.clip(qpos[:, None] - kpos[None, :], -MAX_REL, MAX_REL) + MAX_REL
    bias = rel_bias.astype(jnp.float32)[:, rel]
    qc = qpos[:, None] // CHUNK
    kc = kpos[None, :] // CHUNK
    vis = (kc <= qc) & (kc >= qc - LEFT_CHUNKS) & (kpos[None, :] >= 0)
    s = jnp.einsum('bqhd,bkhd->bhqk', q, kk).astype(jnp.float32) * (Dh ** -0.5) + bias[None]
    s = jnp.where(vis[None, None], s, -1e30)
    p = jax.nn.softmax(s, axis=-1).astype(vv.dtype)
    return jnp.einsum('bhqk,bkhd->bqhd', p, vv).reshape(Bd, T, H * Dh)


def _causal_conv(xr, buf, w, b):
    T = xr.shape[1]
    xp = jnp.concatenate([buf.astype(xr.dtype), xr], axis=1)
    y = b
    for j in range(CONV_W):
        y = y + xp[:, j:j + T] * w[j]
    return y, xp[:, -(CONV_W - 1):]


def _rglru(xc, h0, wa, ba, wx, bx, lam):
    B, T, _ = xc.shape
    xb = xc.reshape(B, T, R_BLOCKS, R_BLOCK)
    r = jax.nn.sigmoid((jnp.einsum('btni,nij->btnj', xb, wa) + ba).astype(jnp.float32)).reshape(B, T, R_WIDTH)
    ig = jax.nn.sigmoid((jnp.einsum('btni,nij->btnj', xb, wx) + bx).astype(jnp.float32)).reshape(B, T, R_WIDTH)
    log_a = -LRU_C * r * jax.nn.softplus(-lam.astype(jnp.float32))
    a = jnp.exp(log_a)
    mult = jnp.sqrt(-jnp.expm1(2.0 * log_a))
    bterm = mult * (ig * xc.astype(jnp.float32))
    bterm = bterm.at[:, 0].add(a[:, 0] * h0.astype(jnp.float32))

    def comb(l, rr):
        return (l[0] * rr[0], rr[0] * l[1] + rr[1])

    _, h = lax.associative_scan(comb, (a, bterm), axis=1)
    return h.astype(xc.dtype), h[:, -1].astype(xc.dtype)


def _mem_kv(mem, g_m, w_mk, w_mv, mk_norm):
    B, N, _ = mem.shape
    m = _rmsnorm(mem, g_m)
    k = _rmsnorm((m @ w_mk).reshape(B, N, M_HEADS, HEAD_DIM), mk_norm)
    v = (m @ w_mv).reshape(B, N, M_HEADS, HEAD_DIM)
    return k, v


def _mem_attend(q, k, v):
    B, T = q.shape[:2]
    s = jnp.einsum('bthd,bnhd->bhtn', q, k).astype(jnp.float32) * (HEAD_DIM ** -0.5)
    p = jax.nn.softmax(s, axis=-1).astype(v.dtype)
    return jnp.einsum('bhtn,bnhd->bthd', p, v).reshape(B, T, M_WIDTH)


def _layer(x, lp, attend, conv_buf, h0, mem_k, mem_v):
    B, T, _ = x.shape
    x = x + 0.5 * _swiglu(_rmsnorm(x, lp['ffn1_norm']), lp['ffn1_wg'], lp['ffn1_wu'], lp['ffn1_wd'])
    u = _rmsnorm(x, lp['mix_norm']) @ lp['w_in']
    q, k, v, xr, gr, ga, gb = jnp.split(u, SPLITS, axis=-1)
    q = _rmsnorm(q.reshape(B, T, A_HEADS, HEAD_DIM), lp['q_norm'])
    k = _rmsnorm(k.reshape(B, T, A_HEADS, HEAD_DIM), lp['k_norm'])
    v = v.reshape(B, T, A_HEADS, HEAD_DIM)
    a_out = attend(q, k, v, lp['rel_bias'])
    xc, new_buf = _causal_conv(xr, conv_buf, lp['conv_w'], lp['conv_b'])
    h, h_last = _rglru(xc, h0, lp['lru_wa'], lp['lru_ba'], lp['lru_wx'], lp['lru_bx'], lp['lru_lambda'])
    r_out = jax.nn.gelu(gr) * h
    merged = jax.nn.sigmoid(ga) * (a_out @ lp['w_proj_a']) + jax.nn.sigmoid(gb) * (r_out @ lp['w_proj_b'])
    x = x + merged @ lp['w_out']
    mq = _rmsnorm((_rmsnorm(x, lp['mem_norm_x']) @ lp['w_mq']).reshape(B, T, M_HEADS, HEAD_DIM), lp['mq_norm'])
    x = x + _mem_attend(mq, mem_k, mem_v) @ lp['w_mo']
    x = x + 0.5 * _swiglu(_rmsnorm(x, lp['ffn2_norm']), lp['ffn2_wg'], lp['ffn2_wu'], lp['ffn2_wd'])
    x = _rmsnorm(x, lp['final_norm'])
    return x, k, v, new_buf, h_last


def setup_inputs(seed: int = 0) -> dict:
    key = jax.random.key(seed)
    ks = iter(jax.random.split(key, 64))
    f32 = jnp.float32

    def nrm(shape, scale):
        return jax.random.normal(next(ks), shape, f32) * scale

    def gain(n):
        return 1.0 + 0.05 * jax.random.normal(next(ks), (DEPTH, n), f32)

    wc = min(BAND_ROWS, PAST_LEN)
    inp = {}
    inp['x_prompt'] = nrm((BATCH, SEQ, D_MODEL), 1.0)
    inp['x_sample'] = nrm((DEC_BATCH, DEC_SEQ, D_MODEL), 1.0)
    inp['cache_attn_k'] = nrm((DEPTH, DEC_BATCH, wc, A_HEADS, HEAD_DIM), 1.0)
    inp['cache_attn_v'] = nrm((DEPTH, DEC_BATCH, wc, A_HEADS, HEAD_DIM), 1.0)
    inp['state_conv'] = nrm((DEPTH, DEC_BATCH, CONV_W - 1, R_WIDTH), 1.0)
    inp['state_lru'] = nrm((DEPTH, DEC_BATCH, R_WIDTH), 0.5)
    inp['cache_mem_k'] = nrm((DEPTH, DEC_BATCH, N_MEM, M_HEADS, HEAD_DIM), 1.0)
    inp['cache_mem_v'] = nrm((DEPTH, DEC_BATCH, N_MEM, M_HEADS, HEAD_DIM), 1.0)
    inp['mem_prompt'] = nrm((BATCH, N_MEM, D_MODEL), 1.0)
    inp['ffn1_norm'] = gain(D_MODEL)
    inp['ffn1_wg'] = nrm((DEPTH, D_MODEL, D_FF), D_MODEL ** -0.5)
    inp['ffn1_wu'] = nrm((DEPTH, D_MODEL, D_FF), D_MODEL ** -0.5)
    inp['ffn1_wd'] = nrm((DEPTH, D_FF, D_MODEL), D_FF ** -0.5)
    inp['mix_norm'] = gain(D_MODEL)
    inp['w_in'] = nrm((DEPTH, D_MODEL, IN_COLS), D_MODEL ** -0.5)
    inp['q_norm'] = gain(HEAD_DIM)
    inp['k_norm'] = gain(HEAD_DIM)
    inp['rel_bias'] = nrm((DEPTH, A_HEADS, N_REL), 0.1)
    inp['conv_w'] = nrm((DEPTH, CONV_W, R_WIDTH), 0.5)
    inp['conv_b'] = nrm((DEPTH, R_WIDTH), 0.02)
    inp['lru_wa'] = nrm((DEPTH, R_BLOCKS, R_BLOCK, R_BLOCK), R_BLOCK ** -0.5)
    inp['lru_ba'] = nrm((DEPTH, R_BLOCKS, R_BLOCK), 0.02)
    inp['lru_wx'] = nrm((DEPTH, R_BLOCKS, R_BLOCK, R_BLOCK), R_BLOCK ** -0.5)
    inp['lru_bx'] = nrm((DEPTH, R_BLOCKS, R_BLOCK), 0.02)
    a0 = jax.random.uniform(next(ks), (DEPTH, R_WIDTH), f32, 0.9, 0.999)
    inp['lru_lambda'] = jnp.log(a0) - jnp.log1p(-a0)
    inp['w_proj_a'] = nrm((DEPTH, A_WIDTH, D_MODEL), A_WIDTH ** -0.5)
    inp['w_proj_b'] = nrm((DEPTH, R_WIDTH, D_MODEL), R_WIDTH ** -0.5)
    inp['w_out'] = nrm((DEPTH, D_MODEL, D_MODEL), D_MODEL ** -0.5)
    inp['mem_norm_x'] = gain(D_MODEL)
    inp['mem_norm_m'] = gain(D_MODEL)
    inp['w_mq'] = nrm((DEPTH, D_MODEL, M_WIDTH), D_MODEL ** -0.5)
    inp['w_mk'] = nrm((DEPTH, D_MODEL, M_WIDTH), D_MODEL ** -0.5)
    inp['w_mv'] = nrm((DEPTH, D_MODEL, M_WIDTH), D_MODEL ** -0.5)
    inp['mq_norm'] = gain(HEAD_DIM)
    inp['mk_norm'] = gain(HEAD_DIM)
    inp['w_mo'] = nrm((DEPTH, M_WIDTH, D_MODEL), M_WIDTH ** -0.5)
    inp['ffn2_norm'] = gain(D_MODEL)
    inp['ffn2_wg'] = nrm((DEPTH, D_MODEL, D_FF), D_MODEL ** -0.5)
    inp['ffn2_wu'] = nrm((DEPTH, D_MODEL, D_FF), D_MODEL ** -0.5)
    inp['ffn2_wd'] = nrm((DEPTH, D_FF, D_MODEL), D_FF ** -0.5)
    inp['final_norm'] = gain(D_MODEL)
    return inp


def reference(x_prompt, x_sample, cache_attn_k, cache_attn_v, state_conv, state_lru,
              cache_mem_k, cache_mem_v, mem_prompt,
              ffn1_norm, ffn1_wg, ffn1_wu, ffn1_wd, mix_norm, w_in, q_norm, k_norm, rel_bias,
              conv_w, conv_b, lru_wa, lru_ba, lru_wx, lru_bx, lru_lambda,
              w_proj_a, w_proj_b, w_out, mem_norm_x, mem_norm_m, w_mq, w_mk, w_mv,
              mq_norm, mk_norm, w_mo, ffn2_norm, ffn2_wg, ffn2_wu, ffn2_wd, final_norm):
    yp, ys = x_prompt, x_sample
    pk, pv, pconv, plru, pmk, pmv = [], [], [], [], [], []
    sk, sv, sconv, slru = [], [], [], []
    B, S, _ = x_prompt.shape
    Bd = x_sample.shape[0]
    n_keep = min(BAND_ROWS, S)
    for l in range(DEPTH):
        lp = {'ffn1_norm': ffn1_norm[l], 'ffn1_wg': ffn1_wg[l], 'ffn1_wu': ffn1_wu[l], 'ffn1_wd': ffn1_wd[l],
              'mix_norm': mix_norm[l], 'w_in': w_in[l], 'q_norm': q_norm[l], 'k_norm': k_norm[l],
              'rel_bias': rel_bias[l], 'conv_w': conv_w[l], 'conv_b': conv_b[l],
              'lru_wa': lru_wa[l], 'lru_ba': lru_ba[l], 'lru_wx': lru_wx[l], 'lru_bx': lru_bx[l],
              'lru_lambda': lru_lambda[l], 'w_proj_a': w_proj_a[l], 'w_proj_b': w_proj_b[l],
              'w_out': w_out[l], 'mem_norm_x': mem_norm_x[l], 'w_mq': w_mq[l], 'mq_norm': mq_norm[l],
              'w_mo': w_mo[l], 'ffn2_norm': ffn2_norm[l], 'ffn2_wg': ffn2_wg[l], 'ffn2_wu': ffn2_wu[l],
              'ffn2_wd': ffn2_wd[l], 'final_norm': final_norm[l]}
        mk, mv = _mem_kv(mem_prompt, mem_norm_m[l], w_mk[l], w_mv[l], mk_norm[l])
        buf0 = jnp.zeros((B, CONV_W - 1, R_WIDTH), yp.dtype)
        h0 = jnp.zeros((B, R_WIDTH), jnp.float32)
        yp, k_p, v_p, cb_p, hl_p = _layer(yp, lp, _chunk_attn_prompt, buf0, h0, mk, mv)
        pk.append(k_p[:, S - n_keep:])
        pv.append(v_p[:, S - n_keep:])
        pconv.append(cb_p)
        plru.append(hl_p)
        pmk.append(mk)
        pmv.append(mv)
        kc_l, vc_l = cache_attn_k[l], cache_attn_v[l]
        attend_s = lambda q, k, v, rb, kc=kc_l, vc=vc_l: _chunk_attn_sample(q, k, v, rb, kc, vc)
        ys, k_s, v_s, cb_s, hl_s = _layer(ys, lp, attend_s, state_conv[l], state_lru[l],
                                          cache_mem_k[l], cache_mem_v[l])
        sk.append(k_s)
        sv.append(v_s)
        sconv.append(cb_s)
        slru.append(hl_s)
    k_prompt = jnp.stack(pk)
    v_prompt = jnp.stack(pv)
    conv_prompt = jnp.stack(pconv)
    lru_prompt = jnp.stack(plru)
    mem_k_prompt = jnp.stack(pmk)
    mem_v_prompt = jnp.stack(pmv)
    k_sample = jnp.stack(sk)
    v_sample = jnp.stack(sv)
    conv_sample = jnp.stack(sconv)
    lru_sample = jnp.stack(slru)
    return (yp, ys, k_prompt, v_prompt, conv_prompt, lru_prompt, mem_k_prompt, mem_v_prompt,
            k_sample, v_sample, conv_sample, lru_sample)
```

```cpp
#include <hip/hip_runtime.h>
#include <hip/hip_cooperative_groups.h>
#include <cstdio>
#include <cstdint>
namespace cg = cooperative_groups;

#define LAS __attribute__((address_space(3)))
typedef unsigned short bf16_t;
typedef short bf16x8 __attribute__((ext_vector_type(8)));
typedef float f32x4 __attribute__((ext_vector_type(4)));
typedef float f32x2 __attribute__((ext_vector_type(2)));
typedef unsigned u32x4 __attribute__((ext_vector_type(4)));
typedef unsigned u32x2 __attribute__((ext_vector_type(2)));
typedef __bf16 bf16x2_t __attribute__((ext_vector_type(2)));
#define DI __device__ __forceinline__

constexpr int D = 2048, NBATCH = 8, TSEQ = 4096, MP = NBATCH * TSEQ, SBATCH = 32, STOK = 16, MS = SBATCH * STOK, MT = MP + MS;
constexpr int FF = 5632, NU = 9216, NWAVES = 8;
constexpr int OQ = 0, OKK = 1024, OV = 2048, OXR = 3072, OGR = 4096, OGA = 5120, OGB = 7168;
constexpr int SKEYS = 544;
constexpr float EPS = 1e-6f, LOG2E = 1.4426950408889634f;
constexpr int NSEQ = NBATCH + SBATCH;

constexpr size_t O_YP = 0, O_YS = (size_t)MP * D, O_KP = O_YS + (size_t)MS * D, O_VP = O_KP + (size_t)NBATCH * 512 * 1024,
                 O_CP = O_VP + (size_t)NBATCH * 512 * 1024, O_LP = O_CP + (size_t)NBATCH * 3 * 1024, O_MK = O_LP + (size_t)NBATCH * 1024,
                 O_MV = O_MK + (size_t)NBATCH * 256 * 512, O_KS = O_MV + (size_t)NBATCH * 256 * 512, O_VS = O_KS + (size_t)MS * 1024,
                 O_CS = O_VS + (size_t)MS * 1024, O_LS = O_CS + (size_t)SBATCH * 3 * 1024, O_END = O_LS + (size_t)SBATCH * 1024;

constexpr size_t al256(size_t x) { return (x + 255) & ~(size_t)255; }
constexpr size_t W_GU1 = 0, W_D1 = W_GU1 + (size_t)2 * FF * D * 2, W_IN = W_D1 + (size_t)D * FF * 2, W_PA = W_IN + (size_t)NU * D * 2,
                 W_PB = W_PA + (size_t)D * 1024 * 2, W_OUT = W_PB + (size_t)D * 1024 * 2, W_MQ = W_OUT + (size_t)D * D * 2, W_MKV = W_MQ + (size_t)512 * D * 2,
                 W_MO = W_MKV + (size_t)1024 * D * 2, W_GU2 = W_MO + (size_t)D * 512 * 2, W_D2 = W_GU2 + (size_t)2 * FF * D * 2, W_LRU = W_D2 + (size_t)D * FF * 2,
                 W_C8 = W_LRU + (size_t)2 * 16 * 64 * 64 * 2, W_XN = al256(W_C8 + 1024 * 4), W_U = W_XN + (size_t)MT * D * 2, W_VT = W_U + (size_t)MT * NU * 2,
                 W_KS = W_VT + (size_t)NBATCH * 8 * 128 * TSEQ * 2, W_VTS = W_KS + (size_t)SBATCH * SKEYS * 1024 * 2, W_KM = W_VTS + (size_t)SBATCH * 8 * 128 * SKEYS * 2,
                 W_VTM = W_KM + (size_t)NSEQ * 256 * 512 * 2, W_CA = W_VTM + (size_t)NSEQ * 4 * 128 * 256 * 2, W_CB = W_CA + (size_t)NBATCH * 64 * 1024 * 4,
                 W_END = W_CB + (size_t)NBATCH * 64 * 1024 * 4;
constexpr size_t W_H = W_U, W_MQB = W_U, W_MN = W_U + (size_t)MT * FF * 2, W_MKVF = W_MN + (size_t)2048 * D * 2;

#ifndef PHM
#define PHM 0x1ffff
#endif
constexpr int RING_BYTES = 131072, LDS_BYTES = 147456;

struct Params { const float* in[41]; float* out; unsigned char* ws; };

DI unsigned pk2(float a, float b) { f32x2 v = {a, b}; bf16x2_t r = __builtin_convertvector(v, bf16x2_t); return __builtin_bit_cast(unsigned, r); }
DI float bf_lo(unsigned w) { return __builtin_bit_cast(float, w << 16); }
DI float bf_hi(unsigned w) { return __builtin_bit_cast(float, w & 0xffff0000u); }
DI void unpack8(const u32x4 w, float (&f)[8]) { f[0] = bf_lo(w.x); f[1] = bf_hi(w.x); f[2] = bf_lo(w.y); f[3] = bf_hi(w.y); f[4] = bf_lo(w.z); f[5] = bf_hi(w.z); f[6] = bf_lo(w.w); f[7] = bf_hi(w.w); }
DI u32x4 pack8(const float (&f)[8]) { u32x4 w; w.x = pk2(f[0], f[1]); w.y = pk2(f[2], f[3]); w.z = pk2(f[4], f[5]); w.w = pk2(f[6], f[7]); return w; }
DI float wave_sum(float v) {
#pragma unroll
    for (int o = 1; o < 64; o <<= 1) v += __shfl_xor(v, o);
    return v;
}
DI float fast_exp2(float x) { return __builtin_amdgcn_exp2f(x); }
DI float fast_rcp(float x) { return __builtin_amdgcn_rcpf(x); }
DI float sigmoidf_(float x) { return fast_rcp(1.0f + fast_exp2(-x * LOG2E)); }
template <int S> DI float dpp_shr(float old, float v) {
    return __builtin_bit_cast(float, __builtin_amdgcn_update_dpp(__builtin_bit_cast(int, old), __builtin_bit_cast(int, v), 0x110 + S, 0xf, 0xf, false));
}
#define LDS_WAIT() asm volatile("s_waitcnt lgkmcnt(0)" ::: "memory")

namespace pg8 {
constexpr int BM = 256, BK = 64, HALF = 128, HTB = HALF * BK * 2, STAGE_BYTES = 8 * HTB, NXCD = 8, WGM = 8;
DI int lds_byte(int r, int c) { const int st = (r >> 4) * 2 + (c >> 5), rr = r & 15, cc = c & 31, ob = rr * 64 + cc * 2; return st * 1024 + (ob ^ (((ob >> 9) & 1) << 5)); }
DI void stage_rc(int b, int& R, int& C) { const int st = b / 1024, sb = b % 1024, swz = sb ^ (((sb >> 9) & 1) << 5); R = (st >> 1) * 16 + swz / 64; C = (st & 1) * 32 + (swz % 64) / 2; }
DI int perm32(int rho) { const int n = rho >> 4, i = rho & 15; return 8 * (i >> 2) + 4 * n + (i & 3); }
struct Unit { int pm, pn; };
struct Gemm { const bf16_t* A; const bf16_t* Bt; int M, N, K, lda; };
struct StaticOrder {
    int nM, nN, nwg, G, c;
    DI void init(int M, int N, int G_, int c_) { nM = M / BM; nN = N / BM; nwg = nM * nN; G = G_; c = c_; }
    DI bool next(int i, Unit& u) const {
        const long L = (long)i * G + c; if (L >= nwg) return false;
        int wgid = (int)L; { const int q = nwg / NXCD, r = nwg % NXCD, xcd = wgid % NXCD, off = wgid / NXCD; wgid = (xcd < r ? xcd * (q + 1) : r * (q + 1) + (xcd - r) * q) + off; }
        const int nig = WGM * nN, gid = wgid / nig, fm = gid * WGM, gsz = (nM - fm) < WGM ? (nM - fm) : WGM;
        u.pm = fm + ((wgid % nig) % gsz); u.pn = (wgid % nig) / gsz; return true;
    }
};
typedef f32x4 Acc[2][2][4][2];

struct EpiBf16 {
    static constexpr bool PERM = true;
    bf16_t* O; int ldc;
    DI void operator()(const Acc& acc, const Unit& u, int wr, int wc, int fr, int fq) const {
        const int row0 = u.pm * BM + wr * 64 + fr, col0 = u.pn * BM + wc * 32 + 8 * fq;
#pragma unroll
        for (int ai = 0; ai < 2; ++ai)
#pragma unroll
            for (int m = 0; m < 4; ++m) { bf16_t* rowp = O + (size_t)(row0 + ai * HALF + m * 16) * ldc + col0;
#pragma unroll
                for (int bj = 0; bj < 2; ++bj) { const f32x4 v0 = acc[ai][bj][m][0], v1 = acc[ai][bj][m][1];
                    u32x4 w; w.x = pk2(v0[0], v0[1]); w.y = pk2(v0[2], v0[3]); w.z = pk2(v1[0], v1[1]); w.w = pk2(v1[2], v1[3]);
                    *(u32x4*)(rowp + bj * HALF) = w; } }
    }
};
struct EpiSwiglu {
    static constexpr bool PERM = true;
    bf16_t* O; int ldc;
    DI void operator()(const Acc& acc, const Unit& u, int wr, int wc, int fr, int fq) const {
        const int row0 = u.pm * BM + wr * 64 + fr, col0 = u.pn * HALF + wc * 32 + 8 * fq;
#pragma unroll
        for (int ai = 0; ai < 2; ++ai)
#pragma unroll
            for (int m = 0; m < 4; ++m) {
                float h[8];
#pragma unroll
                for (int n = 0; n < 2; ++n)
#pragma unroll
                    for (int j = 0; j < 4; ++j) { const float g = acc[ai][0][m][n][j], up = acc[ai][1][m][n][j]; h[n * 4 + j] = g * sigmoidf_(g) * up; }
                *(u32x4*)(O + (size_t)(row0 + ai * HALF + m * 16) * ldc + col0) = pack8(h); }
    }
};
struct EpiGate {
    static constexpr bool PERM = true;
    bf16_t* O; const bf16_t* G; int ld; int accum;
    DI void operator()(const Acc& acc, const Unit& u, int wr, int wc, int fr, int fq) const {
        const int row0 = u.pm * BM + wr * 64 + fr, col0 = u.pn * BM + wc * 32 + 8 * fq;
#pragma unroll
        for (int ai = 0; ai < 2; ++ai)
#pragma unroll
            for (int m = 0; m < 4; ++m)
#pragma unroll
                for (int bj = 0; bj < 2; ++bj) {
                    const size_t off = (size_t)(row0 + ai * HALF + m * 16) * ld + col0 + bj * HALF;
                    float gv[8], o[8]; unpack8(*(const u32x4*)(G + off), gv);
                    if (accum) unpack8(*(const u32x4*)(O + off), o);
                    else {
#pragma unroll
                        for (int i = 0; i < 8; ++i) o[i] = 0.f; }
#pragma unroll
                    for (int n = 0; n < 2; ++n)
#pragma unroll
                        for (int j = 0; j < 4; ++j) o[n * 4 + j] += sigmoidf_(gv[n * 4 + j]) * acc[ai][bj][m][n][j];
                    *(u32x4*)(O + off) = pack8(o); }
    }
};
struct EpiResid {
    static constexpr bool PERM = false;
    float* R; const float* xp; const float* xs; float alpha;
    DI void operator()(const Acc& acc, const Unit& u, int wr, int wc, int fr, int fq) const {
        const int row0 = u.pm * BM + wr * 64 + fr, col0 = u.pn * BM + wc * 32 + 4 * fq;
#pragma unroll
        for (int ai = 0; ai < 2; ++ai)
#pragma unroll
            for (int m = 0; m < 4; ++m) { const int row = row0 + ai * HALF + m * 16;
                float* rp = R + (size_t)row * D + col0;
                const float* bp = xp ? (row < MP ? xp + (size_t)row * D + col0 : xs + (size_t)(row - MP) * D + col0) : rp;
#pragma unroll
                for (int bj = 0; bj < 2; ++bj)
#pragma unroll
                    for (int n = 0; n < 2; ++n) { const f32x4 b = *(const f32x4*)(bp + bj * HALF + n * 16); *(f32x4*)(rp + bj * HALF + n * 16) = b + alpha * acc[ai][bj][m][n]; } }
    }
};
struct EpiF32 {
    static constexpr bool PERM = false;
    float* C; int ldc;
    DI void operator()(const Acc& acc, const Unit& u, int wr, int wc, int fr, int fq) const {
        const int row0 = u.pm * BM + wr * 64 + fr, col0 = u.pn * BM + wc * 32 + 4 * fq;
#pragma unroll
        for (int ai = 0; ai < 2; ++ai)
#pragma unroll
            for (int m = 0; m < 4; ++m) { float* rp = C + (size_t)(row0 + ai * HALF + m * 16) * ldc + col0;
#pragma unroll
                for (int bj = 0; bj < 2; ++bj)
#pragma unroll
                    for (int n = 0; n < 2; ++n) *(f32x4*)(rp + bj * HALF + n * 16) = acc[ai][bj][m][n]; }
    }
};

template <class Epi, bool ALIGN_EPI>
DI void gemm_phase(LAS unsigned char* lds, const Gemm g, const StaticOrder& S, const Epi& E) {
    const int tid = threadIdx.x, wid = __builtin_amdgcn_readfirstlane(tid >> 6), lane = tid & 63, wr = wid >> 2, wc = wid & 3, fr = lane & 15, fq = lane >> 4;
    const int K = g.K, nt = K / BK;
    unsigned voffA[2], voffB[2];
#pragma unroll
    for (int i = 0; i < 2; ++i) { int R, C; stage_rc(tid * 16 + i * 8192, R, C); const int Rb = Epi::PERM ? ((R & ~31) + perm32(R & 31)) : R;
        voffA[i] = (unsigned)(R * g.lda + C) * 2u; voffB[i] = (unsigned)(Rb * K + C) * 2u; }
    const size_t kstep = (size_t)(BK * 2);
    const size_t hstepA = (size_t)HALF * g.lda * 2, hstepB = (size_t)HALF * K * 2;
    const size_t tstepA = 2 * hstepA, tstepB = 2 * hstepB;
    const unsigned ldsw = (unsigned)wid * 1024u;
    const int aoff = lds_byte(wr * 64 + fr, fq * 8), boff = lds_byte(wc * 32 + fr, fq * 8);
#define PG8_SA(b, h) (((b) * 2 + (h)) * HTB)
#define PG8_SB(b, h) ((4 + (b) * 2 + (h)) * HTB)
#define PG8_STAGE(bufoff, gbase, voff) do { _Pragma("unroll") for (int _i = 0; _i < 2; ++_i) \
        __builtin_amdgcn_global_load_lds((const unsigned*)((const char*)(gbase) + (voff)[_i]), (LAS unsigned*)(lds + (bufoff) + ldsw + _i * 8192), 16, 0, 0); } while (0)
#define PG8_LDA(dst, b, h) do { _Pragma("unroll") for (int m = 0; m < 4; ++m) _Pragma("unroll") for (int k = 0; k < 2; ++k) dst[m][k] = *(const LAS bf16x8*)(lds + PG8_SA(b, h) + aoff + m * 2048 + k * 1024); } while (0)
#define PG8_LDB(dst, b, h) do { _Pragma("unroll") for (int n = 0; n < 2; ++n) _Pragma("unroll") for (int k = 0; k < 2; ++k) dst[n][k] = *(const LAS bf16x8*)(lds + PG8_SB(b, h) + boff + n * 2048 + k * 1024); } while (0)
#define PG8_MMA(ai, bj, At, Bt) do { __builtin_amdgcn_s_setprio(1); _Pragma("unroll") for (int m = 0; m < 4; ++m) _Pragma("unroll") for (int n = 0; n < 2; ++n) _Pragma("unroll") for (int k = 0; k < 2; ++k) \
        acc[ai][bj][m][n] = __builtin_amdgcn_mfma_f32_16x16x32_bf16(Bt[n][k], At[m][k], acc[ai][bj][m][n], 0, 0, 0); __builtin_amdgcn_s_setprio(0); } while (0)
#define PG8_WAIT_V(n) asm volatile("s_waitcnt vmcnt(" #n ")" ::: "memory")
#define PG8_WAIT_L(n) asm volatile("s_waitcnt lgkmcnt(" #n ")" ::: "memory")
#define PG8_BAR __builtin_amdgcn_s_barrier()
#define PG8_SCHED __builtin_amdgcn_sched_barrier(0)
    Unit cur, nxt; int ui = 0;
    if (!S.next(0, cur)) return;
    Acc acc;
#pragma unroll
    for (int a = 0; a < 2; ++a)
#pragma unroll
        for (int b = 0; b < 2; ++b)
#pragma unroll
            for (int m = 0; m < 4; ++m)
#pragma unroll
                for (int n = 0; n < 2; ++n) acc[a][b][m][n] = (f32x4){0.f, 0.f, 0.f, 0.f};
    bf16x8 At[4][2], B0[2][2], B1[2][2];
    const char* cA = (const char*)g.A + (size_t)cur.pm * tstepA; const char* cB = (const char*)g.Bt + (size_t)cur.pn * tstepB;
    PG8_STAGE(PG8_SB(0, 0), cB, voffB); PG8_STAGE(PG8_SB(0, 1), cB + hstepB, voffB); PG8_STAGE(PG8_SA(0, 0), cA, voffA); PG8_STAGE(PG8_SA(0, 1), cA + hstepA, voffA);
    if (wr == 1) PG8_BAR;
    PG8_WAIT_V(2); PG8_BAR;
    PG8_STAGE(PG8_SB(1, 0), cB + kstep, voffB); PG8_STAGE(PG8_SA(1, 0), cA + kstep, voffA); PG8_STAGE(PG8_SB(1, 1), cB + hstepB + kstep, voffB);
    PG8_WAIT_V(6); PG8_BAR;
    for (;;) {
        const bool has_next = S.next(ui + 1, nxt);
        const char* nA = has_next ? (const char*)g.A + (size_t)nxt.pm * tstepA : cA; const char* nB = has_next ? (const char*)g.Bt + (size_t)nxt.pn * tstepB : cB;
        for (int t = 0; t < nt; t += 2) {
            const bool last = (t == nt - 2);
            const char* a1 = cA + (size_t)(t + 1) * kstep;
            const char* a2 = last ? nA : cA + (size_t)(t + 2) * kstep; const char* b2 = last ? nB : cB + (size_t)(t + 2) * kstep;
            const char* a3 = a2 + kstep; const char* b3 = b2 + kstep;
            PG8_LDB(B0, 0, 0); PG8_LDB(B1, 0, 1); PG8_SCHED; PG8_LDA(At, 0, 0); PG8_STAGE(PG8_SA(1, 1), a1 + hstepA, voffA);
            PG8_WAIT_V(8); PG8_WAIT_L(0); PG8_BAR; PG8_MMA(0, 0, At, B0); PG8_MMA(0, 1, At, B1); PG8_BAR; PG8_SCHED;
            PG8_LDA(At, 0, 1); PG8_STAGE(PG8_SB(0, 0), b2, voffB); PG8_STAGE(PG8_SB(0, 1), b2 + hstepB, voffB); PG8_STAGE(PG8_SA(0, 0), a2, voffA);
            PG8_WAIT_V(8); PG8_WAIT_L(0); PG8_BAR; PG8_MMA(1, 0, At, B0); PG8_MMA(1, 1, At, B1); PG8_BAR; PG8_SCHED;
            PG8_LDB(B0, 1, 0); PG8_LDB(B1, 1, 1); PG8_SCHED; PG8_LDA(At, 1, 0); PG8_STAGE(PG8_SA(0, 1), a2 + hstepA, voffA);
            PG8_WAIT_V(8); PG8_WAIT_L(0); PG8_BAR; PG8_MMA(0, 0, At, B0); PG8_MMA(0, 1, At, B1); PG8_BAR; PG8_SCHED;
            PG8_LDA(At, 1, 1); PG8_STAGE(PG8_SB(1, 0), b3, voffB); PG8_STAGE(PG8_SB(1, 1), b3 + hstepB, voffB); PG8_STAGE(PG8_SA(1, 0), a3, voffA);
            PG8_WAIT_V(8); PG8_WAIT_L(0); PG8_BAR; PG8_MMA(1, 0, At, B0); PG8_MMA(1, 1, At, B1); PG8_BAR; PG8_SCHED;
        }
        if constexpr (ALIGN_EPI) { if (wr == 0) PG8_BAR; }
        E(acc, cur, wr, wc, fr, fq);
        if (!has_next) break;
#pragma unroll
        for (int a = 0; a < 2; ++a)
#pragma unroll
            for (int b = 0; b < 2; ++b)
#pragma unroll
                for (int m = 0; m < 4; ++m)
#pragma unroll
                    for (int n = 0; n < 2; ++n) acc[a][b][m][n] = (f32x4){0.f, 0.f, 0.f, 0.f};
        cur = nxt; cA = nA; cB = nB; ++ui;
        if constexpr (ALIGN_EPI) { if (wr == 1) PG8_BAR; }
    }
    PG8_WAIT_V(0);
    if constexpr (!ALIGN_EPI) { if (wr == 0) PG8_BAR; }
    PG8_BAR;
#undef PG8_SA
#undef PG8_SB
#undef PG8_STAGE
#undef PG8_LDA
#undef PG8_LDB
#undef PG8_MMA
#undef PG8_WAIT_V
#undef PG8_WAIT_L
#undef PG8_BAR
#undef PG8_SCHED
}
}

DI void transpose_item(const float* W, int K, int N, bf16_t* WT, int sh, int add, LAS float* scr, int item, int lane) {
    const int nblk = N / 32, kb = item / nblk, nb = item % nblk, k0 = 64 * kb, n0 = 32 * nb;
#pragma unroll 8
    for (int i = 0; i < 32; ++i) { const int kk = 2 * i + (lane >> 5); scr[kk * 33 + (lane & 31)] = W[(size_t)(k0 + kk) * N + n0 + (lane & 31)]; }
    LDS_WAIT();
    const int c = lane & 7;
#pragma unroll
    for (int j = 0; j < 4; ++j) { const int n = (lane >> 3) + 8 * j; const LAS float* s = scr + (8 * c) * 33 + n;
        u32x4 o; o.x = pk2(s[0 * 33], s[1 * 33]); o.y = pk2(s[2 * 33], s[3 * 33]); o.z = pk2(s[4 * 33], s[5 * 33]); o.w = pk2(s[6 * 33], s[7 * 33]);
        const int cc = n0 + n, drow = ((cc >> 7) << sh) + add + (cc & 127);
        *(u32x4*)(WT + (size_t)drow * K + k0 + 8 * c) = o; }
    LDS_WAIT();
}
DI void norm_row_bf16(const float* xrow, const float* gain, bf16_t* orow, int lane) {
    const f32x4* xr = (const f32x4*)xrow + lane;
    f32x4 v[8]; float s = 0.f;
#pragma unroll
    for (int j = 0; j < 8; ++j) { v[j] = xr[64 * j]; s += (v[j].x * v[j].x + v[j].y * v[j].y) + (v[j].z * v[j].z + v[j].w * v[j].w); }
    const float rstd = rsqrtf(wave_sum(s) * (1.f / D) + EPS);
    u32x2* o8 = (u32x2*)orow + lane;
#pragma unroll
    for (int j = 0; j < 8; ++j) { const f32x4 gg = ((const f32x4*)gain)[lane + 64 * j]; u32x2 w; w.x = pk2(v[j].x * rstd * gg.x, v[j].y * rstd * gg.y); w.y = pk2(v[j].z * rstd * gg.z, v[j].w * rstd * gg.w); o8[64 * j] = w; }
}
DI void norm_row_f32(float* xrow, const float* gain, int lane) {
    f32x4* xr = (f32x4*)xrow + lane;
    f32x4 v[8]; float s = 0.f;
#pragma unroll
    for (int j = 0; j < 8; ++j) { v[j] = xr[64 * j]; s += (v[j].x * v[j].x + v[j].y * v[j].y) + (v[j].z * v[j].z + v[j].w * v[j].w); }
    const float rstd = rsqrtf(wave_sum(s) * (1.f / D) + EPS);
#pragma unroll
    for (int j = 0; j < 8; ++j) { const f32x4 gg = ((const f32x4*)gain)[lane + 64 * j]; xr[64 * j] = v[j] * rstd * gg; }
}

template <bool BIAS>
DI void attn_task(const bf16_t* Qp, int ldq, bf16_t* Op, int ldo, const bf16_t* Kp, int ldk, const bf16_t* Vtp, int ldv,
                  int nkt, int nvalid, int nqg, const float* qgain, const LAS float* tbl, int dbase, int lane) {
    const int fr = lane & 15, fq = lane >> 4;
    bf16x8 qf[2][4];
#pragma unroll
    for (int g = 0; g < 2; ++g) {
        if (g < nqg) {
            const bf16_t* qrow = Qp + (size_t)(g * 16 + fr) * ldq + fq * 8;
            float qv[4][8]; float ss = 0.f;
#pragma unroll
            for (int s = 0; s < 4; ++s) { unpack8(*(const u32x4*)(qrow + s * 32), qv[s]);
#pragma unroll
                for (int e = 0; e < 8; ++e) ss += qv[s][e] * qv[s][e]; }
            ss += __shfl_xor(ss, 16); ss += __shfl_xor(ss, 32);
            const float rs = rsqrtf(ss * (1.f / 128.f) + EPS) * (0.08838834764831845f * LOG2E);
#pragma unroll
            for (int s = 0; s < 4; ++s) { const f32x4 g0 = *(const f32x4*)(qgain + s * 32 + fq * 8), g1 = *(const f32x4*)(qgain + s * 32 + fq * 8 + 4);
                float t[8];
#pragma unroll
                for (int e = 0; e < 4; ++e) { t[e] = qv[s][e] * rs * g0[e]; t[4 + e] = qv[s][4 + e] * rs * g1[e]; }
                qf[g][s] = __builtin_bit_cast(bf16x8, pack8(t)); }
        } else {
#pragma unroll
            for (int s = 0; s < 4; ++s) qf[g][s] = (bf16x8){0, 0, 0, 0, 0, 0, 0, 0};
        }
    }
    f32x4 o[2][8];
#pragma unroll
    for (int g = 0; g < 2; ++g)
#pragma unroll
        for (int dt = 0; dt < 8; ++dt) o[g][dt] = (f32x4){0.f, 0.f, 0.f, 0.f};
    float mrun[2] = {-1e30f, -1e30f}, lrun[2] = {0.f, 0.f};
    const bf16_t* kb0 = Kp + (size_t)((fr >> 2) * 8 + (fr & 3)) * ldk + fq * 8;
    const bf16_t* vb0 = Vtp + (size_t)fr * ldv + fq * 8;
#pragma unroll 1
    for (int kt = 0; kt < nkt; ++kt) {
        const bf16_t* kb = kb0 + (size_t)kt * 32 * ldk;
        bf16x8 kf[2][4];
#pragma unroll
        for (int hh = 0; hh < 2; ++hh)
#pragma unroll
            for (int s = 0; s < 4; ++s) kf[hh][s] = *(const bf16x8*)(kb + (size_t)hh * 4 * ldk + s * 32);
        bf16x8 vf[8];
#pragma unroll
        for (int dt = 0; dt < 8; ++dt) vf[dt] = *(const bf16x8*)(vb0 + (size_t)dt * 16 * ldv + kt * 32);
        f32x4 st[2][2];
#pragma unroll
        for (int g = 0; g < 2; ++g)
#pragma unroll
            for (int hh = 0; hh < 2; ++hh) { st[g][hh] = (f32x4){0.f, 0.f, 0.f, 0.f};
#pragma unroll
                for (int s = 0; s < 4; ++s) st[g][hh] = __builtin_amdgcn_mfma_f32_16x16x32_bf16(kf[hh][s], qf[g][s], st[g][hh], 0, 0, 0); }
        const bool tail = (kt * 32 + 32 > nvalid);
#pragma unroll
        for (int g = 0; g < 2; ++g) {
            if (g < nqg) {
                float sv[8];
#pragma unroll
                for (int e = 0; e < 4; ++e) { sv[e] = st[g][0][e]; sv[4 + e] = st[g][1][e]; }
                if (BIAS) { const int idx0 = dbase + g * 16 + fr - kt * 32 - fq * 8;
#pragma unroll
                    for (int e = 0; e < 8; ++e) sv[e] += tbl[idx0 - e]; }
                if (tail) {
#pragma unroll
                    for (int e = 0; e < 8; ++e) if (kt * 32 + fq * 8 + e >= nvalid) sv[e] = -1e30f; }
                float tmax = fmaxf(fmaxf(fmaxf(sv[0], sv[1]), fmaxf(sv[2], sv[3])), fmaxf(fmaxf(sv[4], sv[5]), fmaxf(sv[6], sv[7])));
                tmax = fmaxf(tmax, __shfl_xor(tmax, 16)); tmax = fmaxf(tmax, __shfl_xor(tmax, 32));
                const float mn = fmaxf(mrun[g], tmax), alpha = fast_exp2(mrun[g] - mn); mrun[g] = mn;
                float p[8], ps = 0.f;
#pragma unroll
                for (int e = 0; e < 8; ++e) { p[e] = fast_exp2(sv[e] - mn); ps += p[e]; }
                lrun[g] = lrun[g] * alpha + ps;
                const bf16x8 pf = __builtin_bit_cast(bf16x8, pack8(p));
#pragma unroll
                for (int dt = 0; dt < 8; ++dt) { o[g][dt] = o[g][dt] * alpha; o[g][dt] = __builtin_amdgcn_mfma_f32_16x16x32_bf16(vf[dt], pf, o[g][dt], 0, 0, 0); }
            }
        }
    }
#pragma unroll
    for (int g = 0; g < 2; ++g) {
        if (g < nqg) {
            float lt = lrun[g]; lt += __shfl_xor(lt, 16); lt += __shfl_xor(lt, 32);
            const float inv = 1.0f / lt;
            bf16_t* orow = Op + (size_t)(g * 16 + fr) * ldo + fq * 4;
#pragma unroll
            for (int dt = 0; dt < 8; ++dt) { u32x2 w; w.x = pk2(o[g][dt][0] * inv, o[g][dt][1] * inv); w.y = pk2(o[g][dt][2] * inv, o[g][dt][3] * inv); *(u32x2*)(orow + dt * 16) = w; }
        }
    }
}

template <int PASS>
DI void lru_unit(const Params& p, int seq, int chunk, int nblk, int lane) {
    unsigned char* ws = p.ws;
    const char* Ub = (const char*)(ws + W_U);
    const char* WtA = (const char*)(ws + W_LRU); const char* WtX = WtA + 16 * 64 * 64 * 2;
    const char* c8 = (const char*)(ws + W_C8);
    float* cA = (float*)(ws + W_CA); float* cB = (float*)(ws + W_CB);
    const char* conv_w = (const char*)p.in[18]; const char* conv_b = (const char*)p.in[19]; const char* lba = (const char*)p.in[21]; const char* lbx = (const char*)p.in[23];
    const bool is_s = seq >= NBATCH;
    const int sb = seq - NBATCH;
    const unsigned row0 = is_s ? (unsigned)MP + (unsigned)sb * STOK : (unsigned)seq * TSEQ;
    const int t0 = is_s ? 0 : chunk * 64, ntt = is_s ? 1 : 4;
    float hc[2][8], arun[2][8];
#pragma unroll
    for (int ks = 0; ks < 2; ++ks)
#pragma unroll
        for (int e = 0; e < 8; ++e) { hc[ks][e] = 0.f; arun[ks][e] = 1.f; }
    if (PASS == 1) {
        float H;
        if (is_s) H = p.in[5][(size_t)sb * 1024 + nblk * 64 + lane];
        else { H = 0.f; for (int c2 = 0; c2 < chunk; ++c2) { const size_t o = ((size_t)seq * 64 + c2) * 1024 + nblk * 64 + lane; H = cA[o] * H + cB[o]; } }
        const int fq0 = lane >> 4;
#pragma unroll
        for (int ks = 0; ks < 2; ++ks)
#pragma unroll
            for (int e = 0; e < 8; ++e) hc[ks][e] = __shfl(H, ks * 32 + fq0 * 8 + e);
    }
#pragma unroll 1
    for (int tt = 0; tt < ntt; ++tt) {
        int lo = lane; asm volatile("" : "+v"(lo) :: "memory");
        const int fr = lo & 15, fq = lo >> 4;
        const int t = t0 + tt * 16 + fr;
        const unsigned chb0 = (unsigned)(nblk * 64 + fq * 8);
        float xc[2][8]; bf16x8 xf[2];
#pragma unroll
        for (int ks = 0; ks < 2; ++ks) {
            const unsigned chb = chb0 + ks * 32;
            const f32x4 b0 = *(const f32x4*)(conv_b + chb * 4u), b1 = *(const f32x4*)(conv_b + chb * 4u + 16u);
#pragma unroll
            for (int e = 0; e < 4; ++e) { xc[ks][e] = b0[e]; xc[ks][4 + e] = b1[e]; }
#pragma unroll
            for (int j = 0; j < 4; ++j) {
                const int tj = t - 3 + j;
                float xv[8];
                if (tj >= 0) unpack8(*(const u32x4*)(Ub + ((row0 + (unsigned)tj) * (unsigned)NU + OXR + chb) * 2u), xv);
                else if (is_s) { const char* sp = (const char*)p.in[4] + (((unsigned)sb * 3u + (unsigned)(3 + tj)) * 1024u + chb) * 4u; const f32x4 s0 = *(const f32x4*)sp, s1 = *(const f32x4*)(sp + 16);
#pragma unroll
                    for (int e = 0; e < 4; ++e) { xv[e] = s0[e]; xv[4 + e] = s1[e]; } }
                else {
#pragma unroll
                    for (int e = 0; e < 8; ++e) xv[e] = 0.f; }
                const f32x4 w0 = *(const f32x4*)(conv_w + (j * 1024u + chb) * 4u), w1 = *(const f32x4*)(conv_w + (j * 1024u + chb) * 4u + 16u);
#pragma unroll
                for (int e = 0; e < 4; ++e) { xc[ks][e] += w0[e] * xv[e]; xc[ks][4 + e] += w1[e] * xv[4 + e]; }
            }
            xf[ks] = __builtin_bit_cast(bf16x8, pack8(xc[ks]));
        }
        float av[2][8], bv[2][8];
        const unsigned wbase = ((unsigned)(nblk * 64 + (fr >> 2) * 8 + (fr & 3)) * 64u + (unsigned)fq * 8u) * 2u;
#pragma unroll
        for (int ct = 0; ct < 4; ++ct) {
            const int ks = ct >> 1, hq = ct & 1;
            const unsigned woff = wbase + (unsigned)((ks * 32 + hq * 4) * 64) * 2u;
            f32x4 aa = (f32x4){0.f, 0.f, 0.f, 0.f}, ax = (f32x4){0.f, 0.f, 0.f, 0.f};
#pragma unroll
            for (int k2 = 0; k2 < 2; ++k2) {
                const bf16x8 wa = *(const bf16x8*)(WtA + woff + k2 * 64u), wx = *(const bf16x8*)(WtX + woff + k2 * 64u);
                aa = __builtin_amdgcn_mfma_f32_16x16x32_bf16(wa, xf[k2], aa, 0, 0, 0);
                ax = __builtin_amdgcn_mfma_f32_16x16x32_bf16(wx, xf[k2], ax, 0, 0, 0); }
            const unsigned chq = (chb0 + ks * 32 + hq * 4) * 4u;
            const f32x4 ba4 = *(const f32x4*)(lba + chq), bx4 = *(const f32x4*)(lbx + chq), c84 = *(const f32x4*)(c8 + chq);
#pragma unroll
            for (int j = 0; j < 4; ++j) {
                const int e = hq * 4 + j;
                const float r = sigmoidf_(aa[j] + ba4[j]), ig = sigmoidf_(ax[j] + bx4[j]);
                const float a = fast_exp2(c84[j] * r);
                av[ks][e] = a; bv[ks][e] = sqrtf(fmaxf(1.0f - a * a, 0.f)) * ig * xc[ks][e];
            }
        }
#pragma unroll
        for (int ks = 0; ks < 2; ++ks)
#pragma unroll
            for (int e = 0; e < 8; ++e) {
                float a = av[ks][e], b = bv[ks][e], pa, pb;
                pa = dpp_shr<1>(1.f, a); pb = dpp_shr<1>(0.f, b); b = a * pb + b; a = a * pa;
                pa = dpp_shr<2>(1.f, a); pb = dpp_shr<2>(0.f, b); b = a * pb + b; a = a * pa;
                pa = dpp_shr<4>(1.f, a); pb = dpp_shr<4>(0.f, b); b = a * pb + b; a = a * pa;
                pa = dpp_shr<8>(1.f, a); pb = dpp_shr<8>(0.f, b); b = a * pb + b; a = a * pa;
                const float h = a * hc[ks][e] + b;
                bv[ks][e] = h; av[ks][e] = a;
            }
        const int l15 = (lo & 48) | 15;
        if (PASS == 1) {
#pragma unroll
            for (int ks = 0; ks < 2; ++ks) {
                const unsigned chb = chb0 + ks * 32;
                char* gp = (char*)Ub + ((row0 + (unsigned)t) * (unsigned)NU + OGR + chb) * 2u;
                float gv[8], ov[8]; unpack8(*(const u32x4*)gp, gv);
#pragma unroll
                for (int e = 0; e < 8; ++e) { const float x = gv[e]; const float u2 = 1.5957691216057308f * (x + 0.044715f * x * x * x); ov[e] = x * fast_rcp(1.0f + fast_exp2(-u2 * LOG2E)) * bv[ks][e]; }
                *(u32x4*)gp = pack8(ov);
                if (fr == 15 && tt == ntt - 1 && (is_s || chunk == 63)) {
                    float* lo2 = p.out + (is_s ? O_LS + (size_t)sb * 1024 : O_LP + (size_t)seq * 1024) + chb;
                    *(f32x4*)lo2 = (f32x4){bv[ks][0], bv[ks][1], bv[ks][2], bv[ks][3]}; *(f32x4*)(lo2 + 4) = (f32x4){bv[ks][4], bv[ks][5], bv[ks][6], bv[ks][7]};
                }
#pragma unroll
                for (int e = 0; e < 8; ++e) hc[ks][e] = __shfl(bv[ks][e], l15);
            }
        } else {
#pragma unroll
            for (int ks = 0; ks < 2; ++ks)
#pragma unroll
                for (int e = 0; e < 8; ++e) { hc[ks][e] = __shfl(bv[ks][e], l15); arun[ks][e] *= __shfl(av[ks][e], l15); }
        }
    }
    if (PASS == 0 && (lane & 15) == 0) {
        const int fq = lane >> 4;
#pragma unroll
        for (int ks = 0; ks < 2; ++ks) { const size_t o = ((size_t)seq * 64 + chunk) * 1024 + nblk * 64 + ks * 32 + fq * 8;
            *(f32x4*)(cA + o) = (f32x4){arun[ks][0], arun[ks][1], arun[ks][2], arun[ks][3]}; *(f32x4*)(cA + o + 4) = (f32x4){arun[ks][4], arun[ks][5], arun[ks][6], arun[ks][7]};
            *(f32x4*)(cB + o) = (f32x4){hc[ks][0], hc[ks][1], hc[ks][2], hc[ks][3]}; *(f32x4*)(cB + o + 4) = (f32x4){hc[ks][4], hc[ks][5], hc[ks][6], hc[ks][7]}; }
    }
}

__global__ void __launch_bounds__(NWAVES * 64, 2) fwd_megakernel(Params p) {
    extern __shared__ __attribute__((aligned(16))) unsigned char lds_raw[];
    cg::grid_group grid = cg::this_grid();
    LAS unsigned char* lds = (LAS unsigned char*)lds_raw;
    const int tid = threadIdx.x, lane = tid & 63, wave = __builtin_amdgcn_readfirstlane(tid >> 6);
    const int G = gridDim.x, gw = blockIdx.x * NWAVES + wave, NGW = G * NWAVES;
    unsigned char* ws = p.ws;
    float* R = p.out;
    bf16_t* XN = (bf16_t*)(ws + W_XN); bf16_t* U = (bf16_t*)(ws + W_U); bf16_t* H = (bf16_t*)(ws + W_H);
    bf16_t* Vt = (bf16_t*)(ws + W_VT); bf16_t* Ks = (bf16_t*)(ws + W_KS); bf16_t* Vts = (bf16_t*)(ws + W_VTS);
    bf16_t* Km = (bf16_t*)(ws + W_KM); bf16_t* Vtm = (bf16_t*)(ws + W_VTM);
    bf16_t* MN = (bf16_t*)(ws + W_MN); float* MKVF = (float*)(ws + W_MKVF); bf16_t* MQ = (bf16_t*)(ws + W_MQB);

    if constexpr ((PHM >> 0) & 1) {
        LAS float* scr = (LAS float*)(lds + wave * 16384);
        constexpr int I_FU = (D / 64) * (FF / 32), I_FD = (FF / 64) * (D / 32), I_IN = (D / 64) * (NU / 32), I_P = (1024 / 64) * (D / 32), I_O = (D / 64) * (D / 32),
                      I_M = (D / 64) * (512 / 32), I_MO = (512 / 64) * (D / 32);
        constexpr int NITEMS = 4 * I_FU + 2 * I_FD + I_IN + 2 * I_P + I_O + 3 * I_M + I_MO;
        for (int it = gw; it < NITEMS; it += NGW) {
            int r = it;
#define TJ(IDX, KK, NN, OFF, SH, ADD, NI) if (r < (NI)) { transpose_item(p.in[IDX], KK, NN, (bf16_t*)(ws + (OFF)), SH, ADD, scr, r, lane); continue; } r -= (NI);
            TJ(10, D, FF, W_GU1, 8, 0, I_FU) TJ(11, D, FF, W_GU1, 8, 128, I_FU) TJ(12, FF, D, W_D1, 7, 0, I_FD)
            TJ(37, D, FF, W_GU2, 8, 0, I_FU) TJ(38, D, FF, W_GU2, 8, 128, I_FU) TJ(39, FF, D, W_D2, 7, 0, I_FD)
            TJ(14, D, NU, W_IN, 7, 0, I_IN) TJ(25, 1024, D, W_PA, 7, 0, I_P) TJ(26, 1024, D, W_PB, 7, 0, I_P) TJ(27, D, D, W_OUT, 7, 0, I_O)
            TJ(30, D, 512, W_MQ, 7, 0, I_M) TJ(31, D, 512, W_MKV, 7, 0, I_M) TJ(32, D, 512, W_MKV, 7, 512, I_M)
            transpose_item(p.in[35], 512, D, (bf16_t*)(ws + W_MO), 7, 0, scr, r, lane);
#undef TJ
        }
        for (int m = gw; m < MT; m += NGW) norm_row_bf16(m < MP ? p.in[0] + (size_t)m * D : p.in[1] + (size_t)(m - MP) * D, p.in[9], XN + (size_t)m * D, lane);
        for (int m = gw; m < 2048; m += NGW) norm_row_bf16(p.in[8] + (size_t)m * D, p.in[29], MN + (size_t)m * D, lane);
        {
            bf16_t* Wt = (bf16_t*)(ws + W_LRU); float* c8 = (float*)(ws + W_C8);
            for (int i = blockIdx.x * 512 + tid; i < 2 * 65536; i += G * 512) { const int gsel = i >> 16, n = (i >> 12) & 15, c = (i >> 6) & 63, k = i & 63;
                const float v = p.in[gsel ? 22 : 20][n * 4096 + k * 64 + c]; Wt[i] = (bf16_t)(pk2(v, 0.f) & 0xffffu); }
            for (int i = blockIdx.x * 512 + tid; i < 1024; i += G * 512) c8[i] = -8.0f * log1pf(expf(-p.in[24][i])) * LOG2E;
        }
    }
    grid.sync();

    if constexpr ((PHM >> 1) & 1) {
        pg8::Gemm g{XN, (const bf16_t*)(ws + W_GU1), MT, 2 * FF, D, D}; pg8::StaticOrder S; S.init(MT, 2 * FF, G, (int)blockIdx.x);
        pg8::EpiSwiglu E{H, FF};
        pg8::gemm_phase<pg8::EpiSwiglu, true>(lds, g, S, E);
        pg8::Gemm g2{MN, (const bf16_t*)(ws + W_MKV), 2048, 1024, D, D}; pg8::StaticOrder S2; S2.init(2048, 1024, G, (int)((blockIdx.x + 128) % G));
        pg8::EpiF32 E2{MKVF, 1024};
        pg8::gemm_phase<pg8::EpiF32, true>(lds, g2, S2, E2);
    }
    grid.sync();

    if constexpr ((PHM >> 2) & 1) {
        pg8::Gemm g{H, (const bf16_t*)(ws + W_D1), MT, D, FF, FF}; pg8::StaticOrder S; S.init(MT, D, G, (int)blockIdx.x);
        pg8::EpiResid E{R, p.in[0], p.in[1], 0.5f};
        pg8::gemm_phase<pg8::EpiResid, true>(lds, g, S, E);
    }
    grid.sync();

    if constexpr ((PHM >> 3) & 1) {
        for (int m = gw; m < MT; m += NGW) norm_row_bf16(R + (size_t)m * D, p.in[13], XN + (size_t)m * D, lane);
        for (int r = gw; r < 2048; r += NGW) {
            const float* src = MKVF + (size_t)r * 1024 + lane * 8;
            const f32x4 k0 = *(const f32x4*)src, k1 = *(const f32x4*)(src + 4), v0 = *(const f32x4*)(src + 512), v1 = *(const f32x4*)(src + 516);
            float ss = (k0.x * k0.x + k0.y * k0.y + k0.z * k0.z + k0.w * k0.w) + (k1.x * k1.x + k1.y * k1.y + k1.z * k1.z + k1.w * k1.w);
            ss += __shfl_xor(ss, 1); ss += __shfl_xor(ss, 2); ss += __shfl_xor(ss, 4); ss += __shfl_xor(ss, 8);
            const float rs = rsqrtf(ss * (1.f / 128.f) + EPS);
            const f32x4 g0 = *(const f32x4*)(p.in[34] + (lane * 8) % 128), g1 = *(const f32x4*)(p.in[34] + (lane * 8) % 128 + 4);
            const f32x4 n0 = k0 * rs * g0, n1 = k1 * rs * g1;
            float* ko = p.out + O_MK + (size_t)r * 512 + lane * 8; *(f32x4*)ko = n0; *(f32x4*)(ko + 4) = n1;
            float* vo = p.out + O_MV + (size_t)r * 512 + lane * 8; *(f32x4*)vo = v0; *(f32x4*)(vo + 4) = v1;
            u32x4 w; w.x = pk2(n0.x, n0.y); w.y = pk2(n0.z, n0.w); w.z = pk2(n1.x, n1.y); w.w = pk2(n1.z, n1.w);
            *(u32x4*)(Km + (size_t)r * 512 + lane * 8) = w;
        }
        for (int r = gw; r < SBATCH * 256; r += NGW) {
            const float* src = p.in[6] + (size_t)r * 512 + lane * 8; const f32x4 k0 = *(const f32x4*)src, k1 = *(const f32x4*)(src + 4);
            u32x4 w; w.x = pk2(k0.x, k0.y); w.y = pk2(k0.z, k0.w); w.z = pk2(k1.x, k1.y); w.w = pk2(k1.z, k1.w);
            *(u32x4*)(Km + ((size_t)NBATCH * 256 + r) * 512 + lane * 8) = w;
        }
        for (int it = gw; it < NSEQ * 4 * 4; it += NGW) {
            const int seq = it >> 4, h = (it >> 2) & 3, j = (it & 3) * 64 + lane;
            const float* src = seq < NBATCH ? MKVF + ((size_t)seq * 256 + j) * 1024 + 512 + h * 128 : p.in[7] + (((size_t)(seq - NBATCH) * 256 + j) * 4 + h) * 128;
            bf16_t* dst = Vtm + ((size_t)(seq * 4 + h) * 128) * 256 + j;
#pragma unroll 4
            for (int dc = 0; dc < 32; ++dc) { const f32x4 v = *(const f32x4*)(src + dc * 4);
                dst[(size_t)(dc * 4 + 0) * 256] = (bf16_t)(pk2(v.x, 0.f)); dst[(size_t)(dc * 4 + 1) * 256] = (bf16_t)(pk2(v.y, 0.f));
                dst[(size_t)(dc * 4 + 2) * 256] = (bf16_t)(pk2(v.z, 0.f)); dst[(size_t)(dc * 4 + 3) * 256] = (bf16_t)(pk2(v.w, 0.f)); }
        }
    }
    grid.sync();

    if constexpr ((PHM >> 4) & 1) {
        pg8::Gemm g{XN, (const bf16_t*)(ws + W_IN), MT, NU, D, D}; pg8::StaticOrder S; S.init(MT, NU, G, (int)blockIdx.x);
        pg8::EpiBf16 E{U, NU};
        pg8::gemm_phase<pg8::EpiBf16, true>(lds, g, S, E);
    }
    grid.sync();

    if constexpr ((PHM >> 5) & 1) {
        constexpr int T_ROWS = MT, T_VT = NBATCH * 64 * 8, T_KS = SBATCH * 512, T_VTS = SBATCH * 8 * 8, T_LRU = NBATCH * 64 * 16;
        constexpr int NT = T_ROWS + T_VT + T_KS + T_VTS + T_LRU;
        for (int it = gw; it < NT; it += NGW) {
            int r = it;
            if (r < T_ROWS) {
                const bool is_s = r >= MP; const int rs_ = r - MP;
                const int b = is_s ? (rs_ >> 4) : (r >> 12), t = is_s ? (rs_ & 15) : (r & 4095);
                bf16_t* urow = U + (size_t)r * NU;
                float kv[16], vv[16];
                { const u32x4 a = *(const u32x4*)(urow + OKK + lane * 16), c = *(const u32x4*)(urow + OKK + lane * 16 + 8);
                  float t0[8], t1[8]; unpack8(a, t0); unpack8(c, t1);
#pragma unroll
                  for (int i = 0; i < 8; ++i) { kv[i] = t0[i]; kv[8 + i] = t1[i]; } }
                { const u32x4 a = *(const u32x4*)(urow + OV + lane * 16), c = *(const u32x4*)(urow + OV + lane * 16 + 8);
                  float t0[8], t1[8]; unpack8(a, t0); unpack8(c, t1);
#pragma unroll
                  for (int i = 0; i < 8; ++i) { vv[i] = t0[i]; vv[8 + i] = t1[i]; } }
                float ss = 0.f;
#pragma unroll
                for (int i = 0; i < 16; ++i) ss += kv[i] * kv[i];
                ss += __shfl_xor(ss, 1); ss += __shfl_xor(ss, 2); ss += __shfl_xor(ss, 4);
                const float rstd = rsqrtf(ss * (1.f / 128.f) + EPS);
                const float* gp = p.in[16] + (lane * 16) % 128;
#pragma unroll
                for (int i = 0; i < 4; ++i) { const f32x4 gg = *(const f32x4*)(gp + 4 * i);
#pragma unroll
                    for (int j = 0; j < 4; ++j) kv[4 * i + j] *= rstd * gg[j]; }
                bf16_t* kd = is_s ? Ks + ((size_t)b * SKEYS + 512 + t) * 1024 + lane * 16 : urow + OKK + lane * 16;
                { float t0[8], t1[8];
#pragma unroll
                  for (int i = 0; i < 8; ++i) { t0[i] = kv[i]; t1[i] = kv[8 + i]; }
                  *(u32x4*)kd = pack8(t0); *(u32x4*)(kd + 8) = pack8(t1); }
                const bool wr_kv = is_s || t >= TSEQ - 512;
                if (wr_kv) {
                    const size_t ro = is_s ? (size_t)rs_ * 1024 : ((size_t)b * 512 + (t - (TSEQ - 512))) * 1024;
                    float* ko = p.out + (is_s ? O_KS : O_KP) + ro + lane * 16; float* vo = p.out + (is_s ? O_VS : O_VP) + ro + lane * 16;
#pragma unroll
                    for (int i = 0; i < 4; ++i) { *(f32x4*)(ko + 4 * i) = (f32x4){kv[4 * i], kv[4 * i + 1], kv[4 * i + 2], kv[4 * i + 3]}; *(f32x4*)(vo + 4 * i) = (f32x4){vv[4 * i], vv[4 * i + 1], vv[4 * i + 2], vv[4 * i + 3]}; }
                }
                const int tl = is_s ? STOK : TSEQ;
                if (t >= tl - 3) {
                    float xv[16];
                    { const u32x4 a = *(const u32x4*)(urow + OXR + lane * 16), c = *(const u32x4*)(urow + OXR + lane * 16 + 8);
                      float t0[8], t1[8]; unpack8(a, t0); unpack8(c, t1);
#pragma unroll
                      for (int i = 0; i < 8; ++i) { xv[i] = t0[i]; xv[8 + i] = t1[i]; } }
                    float* co = p.out + (is_s ? O_CS : O_CP) + ((size_t)b * 3 + (t - (tl - 3))) * 1024 + lane * 16;
#pragma unroll
                    for (int i = 0; i < 4; ++i) *(f32x4*)(co + 4 * i) = (f32x4){xv[4 * i], xv[4 * i + 1], xv[4 * i + 2], xv[4 * i + 3]};
                }
                if (is_s) {
                    const int h = lane >> 3, d0 = (lane & 7) * 16;
                    bf16_t* dst = Vts + ((size_t)(b * 8 + h) * 128 + d0) * SKEYS + 512 + t;
#pragma unroll
                    for (int i = 0; i < 16; ++i) dst[(size_t)i * SKEYS] = (bf16_t)pk2(vv[i], 0.f);
                }
                continue;
            }
            r -= T_ROWS;
            if (r < T_VT) {
                const int b = r >> 9, c = (r >> 3) & 63, h = r & 7, t = c * 64 + lane;
                const bf16_t* src = U + ((size_t)b * TSEQ + t) * NU + OV + h * 128;
                bf16_t* dst = Vt + ((size_t)(b * 8 + h) * 128) * TSEQ + t;
#pragma unroll 4
                for (int dc = 0; dc < 16; ++dc) { const u32x4 w = *(const u32x4*)(src + dc * 8);
                    dst[(size_t)(dc * 8 + 0) * TSEQ] = (bf16_t)(w.x & 0xffffu); dst[(size_t)(dc * 8 + 1) * TSEQ] = (bf16_t)(w.x >> 16);
                    dst[(size_t)(dc * 8 + 2) * TSEQ] = (bf16_t)(w.y & 0xffffu); dst[(size_t)(dc * 8 + 3) * TSEQ] = (bf16_t)(w.y >> 16);
                    dst[(size_t)(dc * 8 + 4) * TSEQ] = (bf16_t)(w.z & 0xffffu); dst[(size_t)(dc * 8 + 5) * TSEQ] = (bf16_t)(w.z >> 16);
                    dst[(size_t)(dc * 8 + 6) * TSEQ] = (bf16_t)(w.w & 0xffffu); dst[(size_t)(dc * 8 + 7) * TSEQ] = (bf16_t)(w.w >> 16); }
                continue;
            }
            r -= T_VT;
            if (r < T_KS) {
                const int b = r >> 9, j = r & 511;
                const float* src = p.in[2] + (size_t)r * 1024 + lane * 16;
                float t0[8], t1[8];
                { const f32x4 a = *(const f32x4*)src, c = *(const f32x4*)(src + 4), d = *(const f32x4*)(src + 8), e = *(const f32x4*)(src + 12);
                  t0[0] = a.x; t0[1] = a.y; t0[2] = a.z; t0[3] = a.w; t0[4] = c.x; t0[5] = c.y; t0[6] = c.z; t0[7] = c.w;
                  t1[0] = d.x; t1[1] = d.y; t1[2] = d.z; t1[3] = d.w; t1[4] = e.x; t1[5] = e.y; t1[6] = e.z; t1[7] = e.w; }
                bf16_t* kd = Ks + ((size_t)b * SKEYS + j) * 1024 + lane * 16;
                *(u32x4*)kd = pack8(t0); *(u32x4*)(kd + 8) = pack8(t1);
                continue;
            }
            r -= T_KS;
            if (r < T_VTS) {
                const int b = r >> 6, h = (r >> 3) & 7, jg = r & 7, j = jg * 64 + lane;
                const float* src = p.in[3] + (((size_t)b * 512 + j) * 8 + h) * 128;
                bf16_t* dst = Vts + ((size_t)(b * 8 + h) * 128) * SKEYS + j;
#pragma unroll 4
                for (int dc = 0; dc < 32; ++dc) { const f32x4 v = *(const f32x4*)(src + dc * 4);
                    dst[(size_t)(dc * 4 + 0) * SKEYS] = (bf16_t)pk2(v.x, 0.f); dst[(size_t)(dc * 4 + 1) * SKEYS] = (bf16_t)pk2(v.y, 0.f);
                    dst[(size_t)(dc * 4 + 2) * SKEYS] = (bf16_t)pk2(v.z, 0.f); dst[(size_t)(dc * 4 + 3) * SKEYS] = (bf16_t)pk2(v.w, 0.f); }
                if (jg == 7 && lane < 16) { bf16_t* pz = Vts + ((size_t)(b * 8 + h) * 128) * SKEYS + 528 + lane;
                    for (int d = 0; d < 128; ++d) pz[(size_t)d * SKEYS] = 0; }
                continue;
            }
            r -= T_VTS;
            lru_unit<0>(p, r >> 10, (r >> 4) & 63, r & 15, lane);
        }
    }
    grid.sync();

    if constexpr ((PHM >> 6) & 1) {
        LAS float* tbl = (LAS float*)(lds + wave * 4096);
        constexpr int T_AP = NBATCH * 64 * 8 * 2, T_AS = SBATCH * 8, T_LP = NBATCH * 64 * 16, T_LS = SBATCH * 16;
        constexpr int NT = T_AP + T_AS + T_LP + T_LS;
        for (int it = gw; it < NT; it += NGW) {
            int r = it;
            if (r < T_AP + T_AS) {
                const bool is_s = r >= T_AP;
                int b, c, h, half;
                if (is_s) { const int q = r - T_AP; b = q >> 3; h = q & 7; c = 0; half = 0; }
                else { b = r >> 10; c = (r >> 4) & 63; h = (r >> 1) & 7; half = r & 1; }
                asm volatile("s_waitcnt lgkmcnt(0)" ::: "memory");
                __builtin_amdgcn_wave_barrier();
                for (int i = lane; i < 640; i += 64) { int d = i - 63; d = d < -256 ? -256 : (d > 256 ? 256 : d); tbl[i] = p.in[17][h * 513 + d + 256] * LOG2E; }
                asm volatile("s_waitcnt lgkmcnt(0)" ::: "memory");
                __builtin_amdgcn_wave_barrier();
                if (is_s) {
                    bf16_t* qp = U + ((size_t)MP + (size_t)b * STOK) * NU + OQ + h * 128;
                    attn_task<true>(qp, NU, qp, NU, Ks + (size_t)b * SKEYS * 1024 + h * 128, 1024, Vts + ((size_t)(b * 8 + h) * 128) * SKEYS, SKEYS,
                                    17, 528, 1, p.in[15], tbl, 1024 - 512 + 63, lane);
                } else {
                    const int key0 = c * 64 - 512 > 0 ? c * 64 - 512 : 0, nkt = (c * 64 + 64 - key0) / 32;
                    bf16_t* qp = U + ((size_t)b * TSEQ + c * 64 + half * 32) * NU + OQ + h * 128;
                    attn_task<true>(qp, NU, qp, NU, U + ((size_t)b * TSEQ + key0) * NU + OKK + h * 128, NU, Vt + ((size_t)(b * 8 + h) * 128) * TSEQ + key0, TSEQ,
                                    nkt, nkt * 32, 2, p.in[15], tbl, c * 64 + half * 32 - key0 + 63, lane);
                }
                continue;
            }
            r -= T_AP + T_AS;
            { const bool pr = r < T_LP; const int r2 = r - T_LP;
              lru_unit<1>(p, pr ? (r >> 10) : NBATCH + (r2 >> 4), pr ? ((r >> 4) & 63) : 0, pr ? (r & 15) : (r2 & 15), lane); }
        }
    }
    grid.sync();

    if constexpr ((PHM >> 7) & 1) {
        pg8::StaticOrder S; S.init(MT, D, G, (int)blockIdx.x);
        pg8::Gemm g1{U + OQ, (const bf16_t*)(ws + W_PA), MT, D, 1024, NU};
        pg8::EpiGate E1{U + OGA, U + OGA, NU, 0};
        pg8::gemm_phase<pg8::EpiGate, true>(lds, g1, S, E1);
        pg8::Gemm g2{U + OGR, (const bf16_t*)(ws + W_PB), MT, D, 1024, NU};
        pg8::EpiGate E2{U + OGA, U + OGB, NU, 1};
        pg8::gemm_phase<pg8::EpiGate, true>(lds, g2, S, E2);
    }
    grid.sync();

    if constexpr ((PHM >> 8) & 1) {
        pg8::Gemm g{U + OGA, (const bf16_t*)(ws + W_OUT), MT, D, D, NU}; pg8::StaticOrder S; S.init(MT, D, G, (int)blockIdx.x);
        pg8::EpiResid E{R, nullptr, nullptr, 1.0f};
        pg8::gemm_phase<pg8::EpiResid, true>(lds, g, S, E);
    }
    grid.sync();

    if constexpr ((PHM >> 9) & 1)
    for (int m = gw; m < MT; m += NGW) norm_row_bf16(R + (size_t)m * D, p.in[28], XN + (size_t)m * D, lane);
    grid.sync();

    if constexpr ((PHM >> 10) & 1) {
        pg8::Gemm g{XN, (const bf16_t*)(ws + W_MQ), MT, 512, D, D}; pg8::StaticOrder S; S.init(MT, 512, G, (int)blockIdx.x);
        pg8::EpiBf16 E{MQ, 512};
        pg8::gemm_phase<pg8::EpiBf16, true>(lds, g, S, E);
    }
    grid.sync();

    if constexpr ((PHM >> 11) & 1) {
        constexpr int T_P = (MP / 32) * 4, T_S = SBATCH * 4;
        for (int it = gw; it < T_P + T_S; it += NGW) {
            if (it < T_P) { const int rt = it >> 2, h = it & 3, seq = rt >> 7;
                bf16_t* qp = MQ + (size_t)rt * 32 * 512 + h * 128;
                attn_task<false>(qp, 512, qp, 512, Km + (size_t)seq * 256 * 512 + h * 128, 512, Vtm + ((size_t)(seq * 4 + h) * 128) * 256, 256, 8, 256, 2, p.in[33], nullptr, 0, lane);
            } else { const int q = it - T_P, b = q >> 2, h = q & 3, seq = NBATCH + b;
                bf16_t* qp = MQ + ((size_t)MP + (size_t)b * STOK) * 512 + h * 128;
                attn_task<false>(qp, 512, qp, 512, Km + (size_t)seq * 256 * 512 + h * 128, 512, Vtm + ((size_t)(seq * 4 + h) * 128) * 256, 256, 8, 256, 1, p.in[33], nullptr, 0, lane);
            }
        }
    }
    grid.sync();

    if constexpr ((PHM >> 12) & 1) {
        pg8::Gemm g{MQ, (const bf16_t*)(ws + W_MO), MT, D, 512, 512}; pg8::StaticOrder S; S.init(MT, D, G, (int)blockIdx.x);
        pg8::EpiResid E{R, nullptr, nullptr, 1.0f};
        pg8::gemm_phase<pg8::EpiResid, true>(lds, g, S, E);
    }
    grid.sync();

    if constexpr ((PHM >> 13) & 1)
    for (int m = gw; m < MT; m += NGW) norm_row_bf16(R + (size_t)m * D, p.in[36], XN + (size_t)m * D, lane);
    grid.sync();

    if constexpr ((PHM >> 14) & 1) {
        pg8::Gemm g{XN, (const bf16_t*)(ws + W_GU2), MT, 2 * FF, D, D}; pg8::StaticOrder S; S.init(MT, 2 * FF, G, (int)blockIdx.x);
        pg8::EpiSwiglu E{H, FF};
        pg8::gemm_phase<pg8::EpiSwiglu, true>(lds, g, S, E);
    }
    grid.sync();

    if constexpr ((PHM >> 15) & 1) {
        pg8::Gemm g{H, (const bf16_t*)(ws + W_D2), MT, D, FF, FF}; pg8::StaticOrder S; S.init(MT, D, G, (int)blockIdx.x);
        pg8::EpiResid E{R, nullptr, nullptr, 0.5f};
        pg8::gemm_phase<pg8::EpiResid, true>(lds, g, S, E);
    }
    grid.sync();

    if constexpr ((PHM >> 16) & 1)
    for (int m = gw; m < MT; m += NGW) norm_row_f32(R + (size_t)m * D, p.in[40], lane);
}

extern "C" void kernel_launch(void* const* d_in, const int* in_sizes, int n_in, void* d_out, int out_size, void* d_ws, size_t ws_size, hipStream_t stream) {
    static int grid = 0;
    if (grid == 0) {
        if (n_in != 41 || (size_t)out_size != O_END || ws_size < W_END) {
            fprintf(stderr, "kernel_launch: unexpected sizes: n_in %d out %d (want %zu) ws %zu (want >= %zu)\n", n_in, out_size, (size_t)O_END, ws_size, (size_t)W_END); grid = -1; return; }
        int dev = 0, cus = 0, per_cu = 0;
        hipGetDevice(&dev); hipDeviceGetAttribute(&cus, hipDeviceAttributeMultiprocessorCount, dev);
        hipFuncSetAttribute((const void*)fwd_megakernel, hipFuncAttributeMaxDynamicSharedMemorySize, LDS_BYTES);
        hipOccupancyMaxActiveBlocksPerMultiprocessor(&per_cu, (const void*)fwd_megakernel, NWAVES * 64, LDS_BYTES);
        if (per_cu < 1) { fprintf(stderr, "kernel_launch: occupancy query says %d blocks per CU\n", per_cu); per_cu = 1; }
        (void)hipGetLastError();
        grid = cus * 1;
    }
    if (grid < 0) return;
    Params p{};
    for (int i = 0; i < 41; ++i) p.in[i] = (const float*)d_in[i];
    p.out = (float*)d_out; p.ws = (unsigned char*)d_ws;
    void* args[] = {&p};
    hipError_t e = hipLaunchCooperativeKernel((const void*)fwd_megakernel, dim3(grid), dim3(NWAVES * 64), args, LDS_BYTES, stream);
    if (e != hipSuccess) fprintf(stderr, "kernel_launch: cooperative launch failed: %s (grid %d)\n", hipGetErrorString(e), grid);
}
```

```cpp
#include <hip/hip_runtime.h>
#include <hip/hip_cooperative_groups.h>
#include <cstdio>
#include <cstdint>
namespace cg = cooperative_groups;

#define LAS __attribute__((address_space(3)))
typedef unsigned short bf16_t;
typedef short bf16x8 __attribute__((ext_vector_type(8)));
typedef float f32x4 __attribute__((ext_vector_type(4)));
typedef float f32x2 __attribute__((ext_vector_type(2)));
typedef unsigned u32x4 __attribute__((ext_vector_type(4)));
typedef unsigned u32x2 __attribute__((ext_vector_type(2)));
typedef __bf16 bf16x2_t __attribute__((ext_vector_type(2)));
#define DI __device__ __forceinline__

constexpr int D = 2048, NBATCH = 8, TSEQ = 4096, MP = NBATCH * TSEQ, SBATCH = 32, STOK = 16, MS = SBATCH * STOK, MT = MP + MS;
constexpr int FF = 5632, NU = 9216, NWAVES = 8;
constexpr int OQ = 0, OKK = 1024, OV = 2048, OXR = 3072, OGR = 4096, OGA = 5120, OGB = 7168;
constexpr int SKEYS = 544;
constexpr float EPS = 1e-6f, LOG2E = 1.4426950408889634f;
constexpr int NSEQ = NBATCH + SBATCH;

constexpr size_t O_YP = 0, O_YS = (size_t)MP * D, O_KP = O_YS + (size_t)MS * D, O_VP = O_KP + (size_t)NBATCH * 512 * 1024,
                 O_CP = O_VP + (size_t)NBATCH * 512 * 1024, O_LP = O_CP + (size_t)NBATCH * 3 * 1024, O_MK = O_LP + (size_t)NBATCH * 1024,
                 O_MV = O_MK + (size_t)NBATCH * 256 * 512, O_KS = O_MV + (size_t)NBATCH * 256 * 512, O_VS = O_KS + (size_t)MS * 1024,
                 O_CS = O_VS + (size_t)MS * 1024, O_LS = O_CS + (size_t)SBATCH * 3 * 1024, O_END = O_LS + (size_t)SBATCH * 1024;

constexpr size_t al256(size_t x) { return (x + 255) & ~(size_t)255; }
constexpr size_t W_GU1 = 0, W_D1 = W_GU1 + (size_t)2 * FF * D * 2, W_IN = W_D1 + (size_t)D * FF * 2, W_PA = W_IN + (size_t)NU * D * 2,
                 W_PB = W_PA + (size_t)D * 1024 * 2, W_OUT = W_PB + (size_t)D * 1024 * 2, W_MQ = W_OUT + (size_t)D * D * 2, W_MKV = W_MQ + (size_t)512 * D * 2,
                 W_MO = W_MKV + (size_t)1024 * D * 2, W_GU2 = W_MO + (size_t)D * 512 * 2, W_D2 = W_GU2 + (size_t)2 * FF * D * 2, W_LRU = W_D2 + (size_t)D * FF * 2,
                 W_C8 = W_LRU + (size_t)2 * 16 * 64 * 64 * 2, W_XN = al256(W_C8 + 1024 * 4), W_U = W_XN + (size_t)MT * D * 2, W_VT = W_U + (size_t)MT * NU * 2,
                 W_KS = W_VT + (size_t)NBATCH * 8 * 128 * TSEQ * 2, W_VTS = W_KS + (size_t)SBATCH * SKEYS * 1024 * 2, W_KM = W_VTS + (size_t)SBATCH * 8 * 128 * SKEYS * 2,
                 W_VTM = W_KM + (size_t)NSEQ * 256 * 512 * 2, W_CA = W_VTM + (size_t)NSEQ * 4 * 128 * 256 * 2, W_CB = W_CA + (size_t)NBATCH * 64 * 1024 * 4,
                 W_SS = W_CB + (size_t)NBATCH * 64 * 1024 * 4, W_END = W_SS + (size_t)3 * MT * 4;
constexpr size_t W_H = W_U, W_MQB = W_U, W_MN = W_U + (size_t)MT * FF * 2, W_MKVF = W_MN + (size_t)2048 * D * 2;

#ifndef REPM
#define REPM 0
#endif
constexpr int RING_BYTES = 131072, LDS_BYTES = 147456;

struct Params { const float* in[41]; float* out; unsigned char* ws; };

DI unsigned pk2(float a, float b) { f32x2 v = {a, b}; bf16x2_t r = __builtin_convertvector(v, bf16x2_t); return __builtin_bit_cast(unsigned, r); }
DI float bf_lo(unsigned w) { return __builtin_bit_cast(float, w << 16); }
DI float bf_hi(unsigned w) { return __builtin_bit_cast(float, w & 0xffff0000u); }
DI void unpack8(const u32x4 w, float (&f)[8]) { f[0] = bf_lo(w.x); f[1] = bf_hi(w.x); f[2] = bf_lo(w.y); f[3] = bf_hi(w.y); f[4] = bf_lo(w.z); f[5] = bf_hi(w.z); f[6] = bf_lo(w.w); f[7] = bf_hi(w.w); }
DI u32x4 pack8(const float (&f)[8]) { u32x4 w; w.x = pk2(f[0], f[1]); w.y = pk2(f[2], f[3]); w.z = pk2(f[4], f[5]); w.w = pk2(f[6], f[7]); return w; }
DI float wave_sum(float v) {
#pragma unroll
    for (int o = 1; o < 64; o <<= 1) v += __shfl_xor(v, o);
    return v;
}
DI float fast_exp2(float x) { return __builtin_amdgcn_exp2f(x); }
DI float fast_rcp(float x) { return __builtin_amdgcn_rcpf(x); }
DI float sigmoidf_(float x) { return fast_rcp(1.0f + fast_exp2(-x * LOG2E)); }
template <int S> DI float dpp_shr(float old, float v) {
    return __builtin_bit_cast(float, __builtin_amdgcn_update_dpp(__builtin_bit_cast(int, old), __builtin_bit_cast(int, v), 0x110 + S, 0xf, 0xf, false));
}
#define LDS_WAIT() asm volatile("s_waitcnt lgkmcnt(0)" ::: "memory")

namespace pg8 {
constexpr int BM = 256, BK = 64, HALF = 128, HTB = HALF * BK * 2, STAGE_BYTES = 8 * HTB, NXCD = 8, WGM = 8;
DI int lds_byte(int r, int c) { const int st = (r >> 4) * 2 + (c >> 5), rr = r & 15, cc = c & 31, ob = rr * 64 + cc * 2; return st * 1024 + (ob ^ (((ob >> 9) & 1) << 5)); }
DI void stage_rc(int b, int& R, int& C) { const int st = b / 1024, sb = b % 1024, swz = sb ^ (((sb >> 9) & 1) << 5); R = (st >> 1) * 16 + swz / 64; C = (st & 1) * 32 + (swz % 64) / 2; }
DI int perm32(int rho) { const int n = rho >> 4, i = rho & 15; return 8 * (i >> 2) + 4 * n + (i & 3); }
struct Unit { int pm, pn, ks; };
struct Gemm { const bf16_t* A; const bf16_t* Bt; int M, N, K, lda, kloop; };
struct StaticOrder {
    int nM, nN, nwg, G, c;
    DI void init(int M, int N, int G_, int c_) { nM = M / BM; nN = N / BM; nwg = nM * nN; G = G_; c = c_; }
    DI bool next(int i, Unit& u) const {
        const long L = (long)i * G + c; if (L >= nwg) return false;
        int wgid = (int)L; { const int q = nwg / NXCD, r = nwg % NXCD, xcd = wgid % NXCD, off = wgid / NXCD; wgid = (xcd < r ? xcd * (q + 1) : r * (q + 1) + (xcd - r) * q) + off; }
        const int nig = WGM * nN, gid = wgid / nig, fm = gid * WGM, gsz = (nM - fm) < WGM ? (nM - fm) : WGM;
        u.pm = fm + ((wgid % nig) % gsz); u.pn = (wgid % nig) / gsz; u.ks = 0; return true;
    }
};
struct SplitOrder {
    int nM, nN, ntot, G, c;
    DI void init(int M, int N, int nsplit, int G_, int c_) { nM = M / BM; nN = N / BM; ntot = nM * nN * nsplit; G = G_; c = c_; }
    DI bool next(int i, Unit& u) const {
        const int L = i * G + c; if (L >= ntot) return false;
        u.pm = L % nM; const int r = L / nM; u.pn = r % nN; u.ks = r / nN; return true;
    }
};
typedef f32x4 Acc[2][2][4][2];

struct EpiBf16 {
    static constexpr bool PERM = true;
    bf16_t* O; int ldc; const float* ss;
    DI void operator()(const Acc& acc, const Unit& u, int wr, int wc, int fr, int fq) const {
        const int row0 = u.pm * BM + wr * 64 + fr, col0 = u.pn * BM + wc * 32 + 8 * fq;
#pragma unroll
        for (int ai = 0; ai < 2; ++ai)
#pragma unroll
            for (int m = 0; m < 4; ++m) { bf16_t* rowp = O + (size_t)(row0 + ai * HALF + m * 16) * ldc + col0;
                const float rs = ss ? rsqrtf(ss[row0 + ai * HALF + m * 16] * (1.f / D) + EPS) : 1.f;
#pragma unroll
                for (int bj = 0; bj < 2; ++bj) { const f32x4 v0 = acc[ai][bj][m][0] * rs, v1 = acc[ai][bj][m][1] * rs;
                    u32x4 w; w.x = pk2(v0[0], v0[1]); w.y = pk2(v0[2], v0[3]); w.z = pk2(v1[0], v1[1]); w.w = pk2(v1[2], v1[3]);
                    *(u32x4*)(rowp + bj * HALF) = w; } }
    }
};
struct EpiSwiglu {
    static constexpr bool PERM = true;
    bf16_t* O; int ldc; const float* ss;
    DI void operator()(const Acc& acc, const Unit& u, int wr, int wc, int fr, int fq) const {
        const int row0 = u.pm * BM + wr * 64 + fr, col0 = u.pn * HALF + wc * 32 + 8 * fq;
#pragma unroll
        for (int ai = 0; ai < 2; ++ai)
#pragma unroll
            for (int m = 0; m < 4; ++m) {
                const float rs = ss ? rsqrtf(ss[row0 + ai * HALF + m * 16] * (1.f / D) + EPS) : 1.f;
                float h[8];
#pragma unroll
                for (int n = 0; n < 2; ++n)
#pragma unroll
                    for (int j = 0; j < 4; ++j) { const float g = acc[ai][0][m][n][j] * rs, up = acc[ai][1][m][n][j] * rs; h[n * 4 + j] = g * sigmoidf_(g) * up; }
                *(u32x4*)(O + (size_t)(row0 + ai * HALF + m * 16) * ldc + col0) = pack8(h); }
    }
};
struct EpiGate {
    static constexpr bool PERM = true;
    bf16_t* O; const bf16_t* G; int ld; int accum;
    DI void operator()(const Acc& acc, const Unit& u, int wr, int wc, int fr, int fq) const {
        const int row0 = u.pm * BM + wr * 64 + fr, col0 = u.pn * BM + wc * 32 + 8 * fq;
#pragma unroll
        for (int ai = 0; ai < 2; ++ai)
#pragma unroll
            for (int m = 0; m < 4; ++m)
#pragma unroll
                for (int bj = 0; bj < 2; ++bj) {
                    const size_t off = (size_t)(row0 + ai * HALF + m * 16) * ld + col0 + bj * HALF;
                    float gv[8], o[8]; unpack8(*(const u32x4*)(G + off), gv);
                    if (accum) unpack8(*(const u32x4*)(O + off), o);
                    else {
#pragma unroll
                        for (int i = 0; i < 8; ++i) o[i] = 0.f; }
#pragma unroll
                    for (int n = 0; n < 2; ++n)
#pragma unroll
                        for (int j = 0; j < 4; ++j) o[n * 4 + j] += sigmoidf_(gv[n * 4 + j]) * acc[ai][bj][m][n][j];
                    *(u32x4*)(O + off) = pack8(o); }
    }
};
struct EpiResid {
    static constexpr bool PERM = false;
    float* R; const float* xp; const float* xs; bf16_t* Xb; float* ss; float alpha;
    DI void operator()(const Acc& acc, const Unit& u, int wr, int wc, int fr, int fq) const {
        const float al = alpha; bf16_t* const xb = Xb; float* const ssp = ss;
        const int row0 = u.pm * BM + wr * 64 + fr, col0 = u.pn * BM + wc * 32 + 4 * fq;
#pragma unroll
        for (int ai = 0; ai < 2; ++ai)
#pragma unroll
            for (int m = 0; m < 4; ++m) { const int row = row0 + ai * HALF + m * 16;
                float* rp = R + (size_t)row * D + col0;
                const float* bp = xp ? (row < MP ? xp + (size_t)row * D + col0 : xs + (size_t)(row - MP) * D + col0) : rp;
                float sq = 0.f;
#pragma unroll
                for (int bj = 0; bj < 2; ++bj)
#pragma unroll
                    for (int n = 0; n < 2; ++n) { const f32x4 b = *(const f32x4*)(bp + bj * HALF + n * 16); const f32x4 a4 = acc[ai][bj][m][n];
                        f32x4 v; v[0] = b[0] + al * a4[0]; v[1] = b[1] + al * a4[1]; v[2] = b[2] + al * a4[2]; v[3] = b[3] + al * a4[3];
                        *(f32x4*)(rp + bj * HALF + n * 16) = v;
                        if (xb) { u32x2 w; w.x = pk2(v[0], v[1]); w.y = pk2(v[2], v[3]); *(u32x2*)(xb + (size_t)row * D + col0 + bj * HALF + n * 16) = w;
                            sq += (v[0] * v[0] + v[1] * v[1]) + (v[2] * v[2] + v[3] * v[3]); } }
                if (xb) { sq += __shfl_xor(sq, 16); sq += __shfl_xor(sq, 32); if (fq == 0) unsafeAtomicAdd(ssp + row, sq); } }
    }
};
struct EpiResidAtomic {
    static constexpr bool PERM = false;
    float* R; float alpha;
    DI void operator()(const Acc& acc, const Unit& u, int wr, int wc, int fr, int fq) const {
        const int row0 = u.pm * BM + wr * 64 + fr, col0 = u.pn * BM + wc * 32 + 4 * fq;
#pragma unroll
        for (int ai = 0; ai < 2; ++ai)
#pragma unroll
            for (int m = 0; m < 4; ++m) { float* rp = R + (size_t)(row0 + ai * HALF + m * 16) * D + col0;
#pragma unroll
                for (int bj = 0; bj < 2; ++bj)
#pragma unroll
                    for (int n = 0; n < 2; ++n)
#pragma unroll
                        for (int j = 0; j < 4; ++j) unsafeAtomicAdd(rp + bj * HALF + n * 16 + j, alpha * acc[ai][bj][m][n][j]); }
    }
};
struct EpiF32 {
    static constexpr bool PERM = false;
    float* C; int ldc;
    DI void operator()(const Acc& acc, const Unit& u, int wr, int wc, int fr, int fq) const {
        const int row0 = u.pm * BM + wr * 64 + fr, col0 = u.pn * BM + wc * 32 + 4 * fq;
#pragma unroll
        for (int ai = 0; ai < 2; ++ai)
#pragma unroll
            for (int m = 0; m < 4; ++m) { float* rp = C + (size_t)(row0 + ai * HALF + m * 16) * ldc + col0;
#pragma unroll
                for (int bj = 0; bj < 2; ++bj)
#pragma unroll
                    for (int n = 0; n < 2; ++n) *(f32x4*)(rp + bj * HALF + n * 16) = acc[ai][bj][m][n]; }
    }
};

template <class Epi, bool ALIGN_EPI, class Sched>
DI void gemm_phase(LAS unsigned char* lds, const Gemm g, const Sched& S, const Epi& E) {
    int tid = threadIdx.x; asm volatile("" : "+v"(tid));
    const int wid = __builtin_amdgcn_readfirstlane(tid >> 6), lane = tid & 63, wr = wid >> 2, wc = wid & 3, fr = lane & 15, fq = lane >> 4;
    const int K = g.K, nt = g.kloop / BK;
    const size_t ksl = (size_t)g.kloop * 2;
    unsigned voffA[2], voffB[2];
#pragma unroll
    for (int i = 0; i < 2; ++i) { int R, C; stage_rc(tid * 16 + i * 8192, R, C); const int Rb = Epi::PERM ? ((R & ~31) + perm32(R & 31)) : R;
        voffA[i] = (unsigned)(R * g.lda + C) * 2u; voffB[i] = (unsigned)(Rb * K + C) * 2u; }
    const size_t kstep = (size_t)(BK * 2);
    const size_t hstepA = (size_t)HALF * g.lda * 2, hstepB = (size_t)HALF * K * 2;
    const size_t tstepA = 2 * hstepA, tstepB = 2 * hstepB;
    const unsigned ldsw = (unsigned)wid * 1024u;
    const int aoff = lds_byte(wr * 64 + fr, fq * 8), boff = lds_byte(wc * 32 + fr, fq * 8);
#define PG8_SA(b, h) (((b) * 2 + (h)) * HTB)
#define PG8_SB(b, h) ((4 + (b) * 2 + (h)) * HTB)
#define PG8_STAGE(bufoff, gbase, voff) do { _Pragma("unroll") for (int _i = 0; _i < 2; ++_i) \
        __builtin_amdgcn_global_load_lds((const unsigned*)((const char*)(gbase) + (voff)[_i]), (LAS unsigned*)(lds + (bufoff) + ldsw + _i * 8192), 16, 0, 0); } while (0)
#define PG8_LDA(dst, b, h) do { _Pragma("unroll") for (int m = 0; m < 4; ++m) _Pragma("unroll") for (int k = 0; k < 2; ++k) dst[m][k] = *(const LAS bf16x8*)(lds + PG8_SA(b, h) + aoff + m * 2048 + k * 1024); } while (0)
#define PG8_LDB(dst, b, h) do { _Pragma("unroll") for (int n = 0; n < 2; ++n) _Pragma("unroll") for (int k = 0; k < 2; ++k) dst[n][k] = *(const LAS bf16x8*)(lds + PG8_SB(b, h) + boff + n * 2048 + k * 1024); } while (0)
#define PG8_MMA(ai, bj, At, Bt) do { __builtin_amdgcn_s_setprio(1); _Pragma("unroll") for (int m = 0; m < 4; ++m) _Pragma("unroll") for (int n = 0; n < 2; ++n) _Pragma("unroll") for (int k = 0; k < 2; ++k) \
        acc[ai][bj][m][n] = __builtin_amdgcn_mfma_f32_16x16x32_bf16(Bt[n][k], At[m][k], acc[ai][bj][m][n], 0, 0, 0); __builtin_amdgcn_s_setprio(0); } while (0)
#define PG8_WAIT_V(n) asm volatile("s_waitcnt vmcnt(" #n ")" ::: "memory")
#define PG8_WAIT_L(n) asm volatile("s_waitcnt lgkmcnt(" #n ")" ::: "memory")
#define PG8_BAR __builtin_amdgcn_s_barrier()
#define PG8_SCHED __builtin_amdgcn_sched_barrier(0)
    Unit cur, nxt; int ui = 0;
    if (!S.next(0, cur)) return;
    Acc acc;
#pragma unroll
    for (int a = 0; a < 2; ++a)
#pragma unroll
        for (int b = 0; b < 2; ++b)
#pragma unroll
            for (int m = 0; m < 4; ++m)
#pragma unroll
                for (int n = 0; n < 2; ++n) acc[a][b][m][n] = (f32x4){0.f, 0.f, 0.f, 0.f};
    bf16x8 At[4][2], B0[2][2], B1[2][2];
    const char* cA = (const char*)g.A + (size_t)cur.pm * tstepA + (size_t)cur.ks * ksl; const char* cB = (const char*)g.Bt + (size_t)cur.pn * tstepB + (size_t)cur.ks * ksl;
    PG8_STAGE(PG8_SB(0, 0), cB, voffB); PG8_STAGE(PG8_SB(0, 1), cB + hstepB, voffB); PG8_STAGE(PG8_SA(0, 0), cA, voffA); PG8_STAGE(PG8_SA(0, 1), cA + hstepA, voffA);
    if (wr == 1) PG8_BAR;
    PG8_WAIT_V(2); PG8_BAR;
    PG8_STAGE(PG8_SB(1, 0), cB + kstep, voffB); PG8_STAGE(PG8_SA(1, 0), cA + kstep, voffA); PG8_STAGE(PG8_SB(1, 1), cB + hstepB + kstep, voffB);
    PG8_WAIT_V(6); PG8_BAR;
    for (;;) {
        const bool has_next = S.next(ui + 1, nxt);
        const char* nA = has_next ? (const char*)g.A + (size_t)nxt.pm * tstepA + (size_t)nxt.ks * ksl : cA; const char* nB = has_next ? (const char*)g.Bt + (size_t)nxt.pn * tstepB + (size_t)nxt.ks * ksl : cB;
        for (int t = 0; t < nt; t += 2) {
            const bool last = (t == nt - 2);
            const char* a1 = cA + (size_t)(t + 1) * kstep;
            const char* a2 = last ? nA : cA + (size_t)(t + 2) * kstep; const char* b2 = last ? nB : cB + (size_t)(t + 2) * kstep;
            const char* a3 = a2 + kstep; const char* b3 = b2 + kstep;
            PG8_LDB(B0, 0, 0); PG8_LDB(B1, 0, 1); PG8_SCHED; PG8_LDA(At, 0, 0); PG8_STAGE(PG8_SA(1, 1), a1 + hstepA, voffA);
            PG8_WAIT_V(8); PG8_WAIT_L(0); PG8_BAR; PG8_MMA(0, 0, At, B0); PG8_MMA(0, 1, At, B1); PG8_BAR; PG8_SCHED;
            PG8_LDA(At, 0, 1); PG8_STAGE(PG8_SB(0, 0), b2, voffB); PG8_STAGE(PG8_SB(0, 1), b2 + hstepB, voffB); PG8_STAGE(PG8_SA(0, 0), a2, voffA);
            PG8_WAIT_V(8); PG8_WAIT_L(0); PG8_BAR; PG8_MMA(1, 0, At, B0); PG8_MMA(1, 1, At, B1); PG8_BAR; PG8_SCHED;
            PG8_LDB(B0, 1, 0); PG8_LDB(B1, 1, 1); PG8_SCHED; PG8_LDA(At, 1, 0); PG8_STAGE(PG8_SA(0, 1), a2 + hstepA, voffA);
            PG8_WAIT_V(8); PG8_WAIT_L(0); PG8_BAR; PG8_MMA(0, 0, At, B0); PG8_MMA(0, 1, At, B1); PG8_BAR; PG8_SCHED;
            PG8_LDA(At, 1, 1); PG8_STAGE(PG8_SB(1, 0), b3, voffB); PG8_STAGE(PG8_SB(1, 1), b3 + hstepB, voffB); PG8_STAGE(PG8_SA(1, 0), a3, voffA);
            PG8_WAIT_V(8); PG8_WAIT_L(0); PG8_BAR; PG8_MMA(1, 0, At, B0); PG8_MMA(1, 1, At, B1); PG8_BAR; PG8_SCHED;
        }
        if constexpr (ALIGN_EPI) { if (wr == 0) PG8_BAR; }
        E(acc, cur, wr, wc, fr, fq);
        if (!has_next) break;
#pragma unroll
        for (int a = 0; a < 2; ++a)
#pragma unroll
            for (int b = 0; b < 2; ++b)
#pragma unroll
                for (int m = 0; m < 4; ++m)
#pragma unroll
                    for (int n = 0; n < 2; ++n) acc[a][b][m][n] = (f32x4){0.f, 0.f, 0.f, 0.f};
        cur = nxt; cA = nA; cB = nB; ++ui;
        if constexpr (ALIGN_EPI) { if (wr == 1) PG8_BAR; }
    }
    PG8_WAIT_V(0);
    if constexpr (!ALIGN_EPI) { if (wr == 0) PG8_BAR; }
    PG8_BAR;
#undef PG8_SA
#undef PG8_SB
#undef PG8_STAGE
#undef PG8_LDA
#undef PG8_LDB
#undef PG8_MMA
#undef PG8_WAIT_V
#undef PG8_WAIT_L
#undef PG8_BAR
#undef PG8_SCHED
}
}

DI void transpose_item(const float* W, int K, int N, bf16_t* WT, int sh, int add, LAS float* scr, int item, int lane, const float* gain) {
    const int nblk = N / 32, kb = item / nblk, nb = item % nblk, k0 = 64 * kb, n0 = 32 * nb;
#pragma unroll 8
    for (int i = 0; i < 32; ++i) { const int kk = 2 * i + (lane >> 5); const float gk = gain ? gain[k0 + kk] : 1.f; scr[kk * 33 + (lane & 31)] = W[(size_t)(k0 + kk) * N + n0 + (lane & 31)] * gk; }
    LDS_WAIT();
    const int c = lane & 7;
#pragma unroll
    for (int j = 0; j < 4; ++j) { const int n = (lane >> 3) + 8 * j; const LAS float* s = scr + (8 * c) * 33 + n;
        u32x4 o; o.x = pk2(s[0 * 33], s[1 * 33]); o.y = pk2(s[2 * 33], s[3 * 33]); o.z = pk2(s[4 * 33], s[5 * 33]); o.w = pk2(s[6 * 33], s[7 * 33]);
        const int cc = n0 + n, drow = ((cc >> 7) << sh) + add + (cc & 127);
        *(u32x4*)(WT + (size_t)drow * K + k0 + 8 * c) = o; }
    LDS_WAIT();
}
DI void norm_row_bf16(const float* xrow, const float* gain, bf16_t* orow, int lane) {
    const f32x4* xr = (const f32x4*)xrow + lane;
    f32x4 v[8]; float s = 0.f;
#pragma unroll
    for (int j = 0; j < 8; ++j) { v[j] = xr[64 * j]; s += (v[j].x * v[j].x + v[j].y * v[j].y) + (v[j].z * v[j].z + v[j].w * v[j].w); }
    const float rstd = rsqrtf(wave_sum(s) * (1.f / D) + EPS);
    u32x2* o8 = (u32x2*)orow + lane;
#pragma unroll
    for (int j = 0; j < 8; ++j) { const f32x4 gg = ((const f32x4*)gain)[lane + 64 * j]; u32x2 w; w.x = pk2(v[j].x * rstd * gg.x, v[j].y * rstd * gg.y); w.y = pk2(v[j].z * rstd * gg.z, v[j].w * rstd * gg.w); o8[64 * j] = w; }
}
DI void norm_row_f32(float* xrow, const float* gain, int lane) {
    f32x4* xr = (f32x4*)xrow + lane;
    f32x4 v[8]; float s = 0.f;
#pragma unroll
    for (int j = 0; j < 8; ++j) { v[j] = xr[64 * j]; s += (v[j].x * v[j].x + v[j].y * v[j].y) + (v[j].z * v[j].z + v[j].w * v[j].w); }
    const float rstd = rsqrtf(wave_sum(s) * (1.f / D) + EPS);
#pragma unroll
    for (int j = 0; j < 8; ++j) { const f32x4 gg = ((const f32x4*)gain)[lane + 64 * j]; xr[64 * j] = v[j] * rstd * gg; }
}

DI void feed_row(const float* xrow, bf16_t* orow, float* ssp, int lane) {
    const f32x4* xr = (const f32x4*)xrow + lane;
    f32x4 v[8]; float s = 0.f;
#pragma unroll
    for (int j = 0; j < 8; ++j) { v[j] = xr[64 * j]; s += (v[j].x * v[j].x + v[j].y * v[j].y) + (v[j].z * v[j].z + v[j].w * v[j].w); }
    s = wave_sum(s);
    u32x2* o8 = (u32x2*)orow + lane;
#pragma unroll
    for (int j = 0; j < 8; ++j) { u32x2 w; w.x = pk2(v[j].x, v[j].y); w.y = pk2(v[j].z, v[j].w); o8[64 * j] = w; }
    if (lane == 0) *ssp = s;
}

DI void attn_load_q(bf16x8 (&qf)[2][4], const bf16_t* Qp, int ldq, int nqg, const float* qgain, int fr, int fq) {
#pragma unroll
    for (int g = 0; g < 2; ++g) {
        if (g < nqg) {
            const bf16_t* qrow = Qp + (size_t)(g * 16 + fr) * ldq + fq * 8;
            float qv[4][8]; float ss = 0.f;
#pragma unroll
            for (int s = 0; s < 4; ++s) { unpack8(*(const u32x4*)(qrow + s * 32), qv[s]);
#pragma unroll
                for (int e = 0; e < 8; ++e) ss += qv[s][e] * qv[s][e]; }
            ss += __shfl_xor(ss, 16); ss += __shfl_xor(ss, 32);
            const float rs = rsqrtf(ss * (1.f / 128.f) + EPS) * (0.08838834764831845f * LOG2E);
#pragma unroll
            for (int s = 0; s < 4; ++s) { const f32x4 g0 = *(const f32x4*)(qgain + s * 32 + fq * 8), g1 = *(const f32x4*)(qgain + s * 32 + fq * 8 + 4);
                float t[8];
#pragma unroll
                for (int e = 0; e < 4; ++e) { t[e] = qv[s][e] * rs * g0[e]; t[4 + e] = qv[s][4 + e] * rs * g1[e]; }
                qf[g][s] = __builtin_bit_cast(bf16x8, pack8(t)); }
        } else {
#pragma unroll
            for (int s = 0; s < 4; ++s) qf[g][s] = (bf16x8){0, 0, 0, 0, 0, 0, 0, 0};
        }
    }
}
template <bool BIAS>
DI void attn_tile(const bf16x8 (&kf)[2][4], const bf16x8 (&vf)[8], const bf16x8 (&qf)[2][4], f32x4 (&o)[2][8], float (&mrun)[2], float (&lrun)[2],
                  int nqg, const LAS float* tbl, int idx0, bool tail, int kpos0, int nvalid) {
    f32x4 st[2][2];
#pragma unroll
    for (int g = 0; g < 2; ++g)
#pragma unroll
        for (int hh = 0; hh < 2; ++hh) { st[g][hh] = (f32x4){0.f, 0.f, 0.f, 0.f};
#pragma unroll
            for (int s = 0; s < 4; ++s) st[g][hh] = __builtin_amdgcn_mfma_f32_16x16x32_bf16(kf[hh][s], qf[g][s], st[g][hh], 0, 0, 0); }
#pragma unroll
    for (int g = 0; g < 2; ++g) {
        if (g < nqg) {
            float sv[8];
#pragma unroll
            for (int e = 0; e < 4; ++e) { sv[e] = st[g][0][e]; sv[4 + e] = st[g][1][e]; }
            if (BIAS) {
#pragma unroll
                for (int e = 0; e < 8; ++e) sv[e] += tbl[idx0 + g * 16 - e]; }
            if (tail) {
#pragma unroll
                for (int e = 0; e < 8; ++e) if (kpos0 + e >= nvalid) sv[e] = -1e30f; }
            float tmax = fmaxf(fmaxf(fmaxf(sv[0], sv[1]), fmaxf(sv[2], sv[3])), fmaxf(fmaxf(sv[4], sv[5]), fmaxf(sv[6], sv[7])));
            tmax = fmaxf(tmax, __shfl_xor(tmax, 16)); tmax = fmaxf(tmax, __shfl_xor(tmax, 32));
            const float mn = fmaxf(mrun[g], tmax), alpha = fast_exp2(mrun[g] - mn); mrun[g] = mn;
            float pv[8], ps = 0.f;
#pragma unroll
            for (int e = 0; e < 8; ++e) { pv[e] = fast_exp2(sv[e] - mn); ps += pv[e]; }
            lrun[g] = lrun[g] * alpha + ps;
            const bf16x8 pf = __builtin_bit_cast(bf16x8, pack8(pv));
#pragma unroll
            for (int dt = 0; dt < 8; ++dt) { o[g][dt] = o[g][dt] * alpha; o[g][dt] = __builtin_amdgcn_mfma_f32_16x16x32_bf16(vf[dt], pf, o[g][dt], 0, 0, 0); }
        }
    }
}
DI void attn_store_o(const f32x4 (&o)[2][8], const float (&lrun)[2], bf16_t* Op, int ldo, int nqg, int fr, int fq) {
#pragma unroll
    for (int g = 0; g < 2; ++g) {
        if (g < nqg) {
            float lt = lrun[g]; lt += __shfl_xor(lt, 16); lt += __shfl_xor(lt, 32);
            const float inv = 1.0f / lt;
            bf16_t* orow = Op + (size_t)(g * 16 + fr) * ldo + fq * 4;
#pragma unroll
            for (int dt = 0; dt < 8; ++dt) { u32x2 w; w.x = pk2(o[g][dt][0] * inv, o[g][dt][1] * inv); w.y = pk2(o[g][dt][2] * inv, o[g][dt][3] * inv); *(u32x2*)(orow + dt * 16) = w; }
        }
    }
}
template <bool BIAS>
DI void attn_task(const bf16_t* Qp, int ldq, bf16_t* Op, int ldo, const bf16_t* Kp, int ldk, const bf16_t* Vtp, int ldv,
                  int nkt, int nvalid, int nqg, const float* qgain, const LAS float* tbl, int dbase, int lane) {
    const int fr = lane & 15, fq = lane >> 4;
    bf16x8 qf[2][4];
    attn_load_q(qf, Qp, ldq, nqg, qgain, fr, fq);
    f32x4 o[2][8];
#pragma unroll
    for (int g = 0; g < 2; ++g)
#pragma unroll
        for (int dt = 0; dt < 8; ++dt) o[g][dt] = (f32x4){0.f, 0.f, 0.f, 0.f};
    float mrun[2] = {-1e30f, -1e30f}, lrun[2] = {0.f, 0.f};
    const bf16_t* kb0 = Kp + (size_t)((fr >> 2) * 8 + (fr & 3)) * ldk + fq * 8;
    const bf16_t* vb0 = Vtp + (size_t)fr * ldv + fq * 8;
#pragma unroll 1
    for (int kt = 0; kt < nkt; ++kt) {
        const bf16_t* kb = kb0 + (size_t)kt * 32 * ldk;
        bf16x8 kf[2][4];
#pragma unroll
        for (int hh = 0; hh < 2; ++hh)
#pragma unroll
            for (int s = 0; s < 4; ++s) kf[hh][s] = *(const bf16x8*)(kb + (size_t)hh * 4 * ldk + s * 32);
        bf16x8 vf[8];
#pragma unroll
        for (int dt = 0; dt < 8; ++dt) vf[dt] = *(const bf16x8*)(vb0 + (size_t)dt * 16 * ldv + kt * 32);
        attn_tile<BIAS>(kf, vf, qf, o, mrun, lrun, nqg, tbl, dbase + fr - kt * 32 - fq * 8, kt * 32 + 32 > nvalid, kt * 32 + fq * 8, nvalid);
    }
    attn_store_o(o, lrun, Op, ldo, nqg, fr, fq);
}
constexpr int AT_TBL = 0, AT_K = 4096, AT_KB = 32 * 272, AT_V = AT_K + 2 * AT_KB, AT_VB = 128 * 80;
DI void attn_wg_prompt(const Params& p, LAS unsigned char* lds, int b, int h, int cg, bf16_t* obase, int ldo, int ocol, int tid) {
    const int lane = tid & 63, wave = __builtin_amdgcn_readfirstlane(tid >> 6), fr = lane & 15, fq = lane >> 4;
    const int c = cg * 4 + (wave >> 1), half = wave & 1;
    const bf16_t* Ub = (const bf16_t*)(p.ws + W_U); const bf16_t* Vtg = (const bf16_t*)(p.ws + W_VT);
    LAS float* tbl = (LAS float*)(lds + AT_TBL);
    __syncthreads();
    for (int i = tid; i < 640; i += NWAVES * 64) { int d = i - 63; d = d < -256 ? -256 : (d > 256 ? 256 : d); tbl[i] = p.in[17][h * 513 + d + 256] * LOG2E; }
    const size_t qrow0 = (size_t)b * TSEQ + c * 64 + half * 32;
    bf16x8 qf[2][4];
    attn_load_q(qf, Ub + qrow0 * NU + OQ + h * 128, NU, 2, p.in[15], fr, fq);
    f32x4 o[2][8];
#pragma unroll
    for (int g = 0; g < 2; ++g)
#pragma unroll
        for (int dt = 0; dt < 8; ++dt) o[g][dt] = (f32x4){0.f, 0.f, 0.f, 0.f};
    float mrun[2] = {-1e30f, -1e30f}, lrun[2] = {0.f, 0.f};
    const int key_lo = (cg * 4 - 8) * 64 > 0 ? (cg * 4 - 8) * 64 : 0, nkt = ((cg * 4 + 4) * 64 - key_lo) / 32;
    const bf16_t* kg = Ub + ((size_t)b * TSEQ + key_lo + (tid >> 4)) * NU + OKK + h * 128 + (tid & 15) * 8;
    const bf16_t* vg = Vtg + ((size_t)(b * 8 + h) * 128 + (tid >> 2)) * TSEQ + key_lo + (tid & 3) * 8;
    const unsigned kw = (unsigned)(tid >> 4) * 272u + (unsigned)(tid & 15) * 16u, vw = (unsigned)(tid >> 2) * 80u + (unsigned)(tid & 3) * 16u;
    const unsigned kroff = (unsigned)((fr >> 2) * 8 + (fr & 3)) * 272u + (unsigned)fq * 16u, vroff = (unsigned)fr * 80u + (unsigned)fq * 16u;
    const int dbase = c * 64 + half * 32 - key_lo + 63;
    u32x4 kr = *(const u32x4*)kg, vr = *(const u32x4*)vg;
#pragma unroll 1
    for (int kt = 0; kt < nkt; ++kt) {
        const int buf = kt & 1;
        *(LAS u32x4*)(lds + AT_K + buf * AT_KB + kw) = kr; *(LAS u32x4*)(lds + AT_V + buf * AT_VB + vw) = vr;
        if (kt + 1 < nkt) { kr = *(const u32x4*)(kg + (size_t)(kt + 1) * 32 * NU); vr = *(const u32x4*)(vg + (kt + 1) * 32); }
        __syncthreads();
        const int kc = (key_lo + kt * 32) >> 6;
        if (kc >= c - 8 && kc <= c) {
            bf16x8 kf[2][4], vf[8];
#pragma unroll
            for (int hh = 0; hh < 2; ++hh)
#pragma unroll
                for (int s = 0; s < 4; ++s) kf[hh][s] = *(const LAS bf16x8*)(lds + AT_K + buf * AT_KB + kroff + hh * (4 * 272) + s * 64);
#pragma unroll
            for (int dt = 0; dt < 8; ++dt) vf[dt] = *(const LAS bf16x8*)(lds + AT_V + buf * AT_VB + vroff + dt * (16 * 80));
            attn_tile<true>(kf, vf, qf, o, mrun, lrun, 2, tbl, dbase + fr - kt * 32 - fq * 8, false, 0, 0);
        }
    }
    attn_store_o(o, lrun, obase + qrow0 * ldo + ocol + h * 128, ldo, 2, fr, fq);
}

template <int PASS>
DI void lru_unit(const Params& p, int seq, int chunk, int nblk, int lane, bf16_t* obase, unsigned opitch, unsigned ocol) {
    unsigned char* ws = p.ws;
    const char* Ub = (const char*)(ws + W_U);
    const char* WtA = (const char*)(ws + W_LRU); const char* WtX = WtA + 16 * 64 * 64 * 2;
    const char* c8 = (const char*)(ws + W_C8);
    float* cA = (float*)(ws + W_CA); float* cB = (float*)(ws + W_CB);
    const char* conv_w = (const char*)p.in[18]; const char* conv_b = (const char*)p.in[19]; const char* lba = (const char*)p.in[21]; const char* lbx = (const char*)p.in[23];
    const bool is_s = seq >= NBATCH;
    const int sb = seq - NBATCH;
    const unsigned row0 = is_s ? (unsigned)MP + (unsigned)sb * STOK : (unsigned)seq * TSEQ;
    const int t0 = is_s ? 0 : chunk * 64, ntt = is_s ? 1 : 4;
    float hc[2][8], arun[2][8];
#pragma unroll
    for (int ks = 0; ks < 2; ++ks)
#pragma unroll
        for (int e = 0; e < 8; ++e) { hc[ks][e] = 0.f; arun[ks][e] = 1.f; }
    if (PASS == 1) {
        float H;
        if (is_s) H = p.in[5][(size_t)sb * 1024 + nblk * 64 + lane];
        else { H = 0.f;
            const float* pa = cA + (size_t)seq * 64 * 1024 + nblk * 64 + lane; const float* pb = cB + (size_t)seq * 64 * 1024 + nblk * 64 + lane;
            for (int c2 = 0; c2 < chunk; c2 += 8) {
                float ta[8], tb[8];
#pragma unroll
                for (int j = 0; j < 8; ++j) { const int cc = (c2 + j < chunk) ? c2 + j : chunk - 1; ta[j] = pa[(size_t)cc * 1024]; tb[j] = pb[(size_t)cc * 1024]; }
#pragma unroll
                for (int j = 0; j < 8; ++j) if (c2 + j < chunk) H = ta[j] * H + tb[j];
            } }
        const int fq0 = lane >> 4;
#pragma unroll
        for (int ks = 0; ks < 2; ++ks)
#pragma unroll
            for (int e = 0; e < 8; ++e) hc[ks][e] = __shfl(H, ks * 32 + fq0 * 8 + e);
    }
#pragma unroll 1
    for (int tt = 0; tt < ntt; ++tt) {
        int lo = lane; asm volatile("" : "+v"(lo) :: "memory");
        const int fr = lo & 15, fq = lo >> 4;
        const int t = t0 + tt * 16 + fr;
        const unsigned chb0 = (unsigned)(nblk * 64 + fq * 8);
        float xc[2][8]; bf16x8 xf[2];
#pragma unroll
        for (int ks = 0; ks < 2; ++ks) {
            const unsigned chb = chb0 + ks * 32;
            const f32x4 b0 = *(const f32x4*)(conv_b + chb * 4u), b1 = *(const f32x4*)(conv_b + chb * 4u + 16u);
#pragma unroll
            for (int e = 0; e < 4; ++e) { xc[ks][e] = b0[e]; xc[ks][4 + e] = b1[e]; }
#pragma unroll
            for (int j = 0; j < 4; ++j) {
                const int tj = t - 3 + j;
                float xv[8];
                if (tj >= 0) unpack8(*(const u32x4*)(Ub + ((row0 + (unsigned)tj) * (unsigned)NU + OXR + chb) * 2u), xv);
                else if (is_s) { const char* sp = (const char*)p.in[4] + (((unsigned)sb * 3u + (unsigned)(3 + tj)) * 1024u + chb) * 4u; const f32x4 s0 = *(const f32x4*)sp, s1 = *(const f32x4*)(sp + 16);
#pragma unroll
                    for (int e = 0; e < 4; ++e) { xv[e] = s0[e]; xv[4 + e] = s1[e]; } }
                else {
#pragma unroll
                    for (int e = 0; e < 8; ++e) xv[e] = 0.f; }
                const f32x4 w0 = *(const f32x4*)(conv_w + (j * 1024u + chb) * 4u), w1 = *(const f32x4*)(conv_w + (j * 1024u + chb) * 4u + 16u);
#pragma unroll
                for (int e = 0; e < 4; ++e) { xc[ks][e] += w0[e] * xv[e]; xc[ks][4 + e] += w1[e] * xv[4 + e]; }
            }
            xf[ks] = __builtin_bit_cast(bf16x8, pack8(xc[ks]));
        }
        float av[2][8], bv[2][8];
        const unsigned wbase = ((unsigned)(nblk * 64 + (fr >> 2) * 8 + (fr & 3)) * 64u + (unsigned)fq * 8u) * 2u;
#pragma unroll
        for (int ct = 0; ct < 4; ++ct) {
            const int ks = ct >> 1, hq = ct & 1;
            const unsigned woff = wbase + (unsigned)((ks * 32 + hq * 4) * 64) * 2u;
            f32x4 aa = (f32x4){0.f, 0.f, 0.f, 0.f}, ax = (f32x4){0.f, 0.f, 0.f, 0.f};
#pragma unroll
            for (int k2 = 0; k2 < 2; ++k2) {
                const bf16x8 wa = *(const bf16x8*)(WtA + woff + k2 * 64u), wx = *(const bf16x8*)(WtX + woff + k2 * 64u);
                aa = __builtin_amdgcn_mfma_f32_16x16x32_bf16(wa, xf[k2], aa, 0, 0, 0);
                ax = __builtin_amdgcn_mfma_f32_16x16x32_bf16(wx, xf[k2], ax, 0, 0, 0); }
            const unsigned chq = (chb0 + ks * 32 + hq * 4) * 4u;
            const f32x4 ba4 = *(const f32x4*)(lba + chq), bx4 = *(const f32x4*)(lbx + chq), c84 = *(const f32x4*)(c8 + chq);
#pragma unroll
            for (int j = 0; j < 4; ++j) {
                const int e = hq * 4 + j;
                const float r = sigmoidf_(aa[j] + ba4[j]), ig = sigmoidf_(ax[j] + bx4[j]);
                const float a = fast_exp2(c84[j] * r);
                av[ks][e] = a; bv[ks][e] = sqrtf(fmaxf(1.0f - a * a, 0.f)) * ig * xc[ks][e];
            }
        }
#pragma unroll
        for (int ks = 0; ks < 2; ++ks)
#pragma unroll
            for (int e = 0; e < 8; ++e) {
                float a = av[ks][e], b = bv[ks][e], pa, pb;
                pa = dpp_shr<1>(1.f, a); pb = dpp_shr<1>(0.f, b); b = a * pb + b; a = a * pa;
                pa = dpp_shr<2>(1.f, a); pb = dpp_shr<2>(0.f, b); b = a * pb + b; a = a * pa;
                pa = dpp_shr<4>(1.f, a); pb = dpp_shr<4>(0.f, b); b = a * pb + b; a = a * pa;
                pa = dpp_shr<8>(1.f, a); pb = dpp_shr<8>(0.f, b); b = a * pb + b; a = a * pa;
                const float h = a * hc[ks][e] + b;
                bv[ks][e] = h; av[ks][e] = a;
            }
        const int l15 = (lo & 48) | 15;
        if (PASS == 1) {
#pragma unroll
            for (int ks = 0; ks < 2; ++ks) {
                const unsigned chb = chb0 + ks * 32;
                const char* gp = Ub + ((row0 + (unsigned)t) * (unsigned)NU + OGR + chb) * 2u;
                char* op = (char*)obase + ((row0 + (unsigned)t) * opitch + ocol + chb) * 2u;
                float gv[8], ov[8]; unpack8(*(const u32x4*)gp, gv);
#pragma unroll
                for (int e = 0; e < 8; ++e) { const float x = gv[e]; const float u2 = 1.5957691216057308f * (x + 0.044715f * x * x * x); ov[e] = x * fast_rcp(1.0f + fast_exp2(-u2 * LOG2E)) * bv[ks][e]; }
                *(u32x4*)op = pack8(ov);
                if (fr == 15 && tt == ntt - 1 && (is_s || chunk == 63)) {
                    float* lo2 = p.out + (is_s ? O_LS + (size_t)sb * 1024 : O_LP + (size_t)seq * 1024) + chb;
                    *(f32x4*)lo2 = (f32x4){bv[ks][0], bv[ks][1], bv[ks][2], bv[ks][3]}; *(f32x4*)(lo2 + 4) = (f32x4){bv[ks][4], bv[ks][5], bv[ks][6], bv[ks][7]};
                }
#pragma unroll
                for (int e = 0; e < 8; ++e) hc[ks][e] = __shfl(bv[ks][e], l15);
            }
        } else {
#pragma unroll
            for (int ks = 0; ks < 2; ++ks)
#pragma unroll
                for (int e = 0; e < 8; ++e) { hc[ks][e] = __shfl(bv[ks][e], l15); arun[ks][e] *= __shfl(av[ks][e], l15); }
        }
    }
    if (PASS == 0 && (lane & 15) == 0) {
        const int fq = lane >> 4;
#pragma unroll
        for (int ks = 0; ks < 2; ++ks) { const size_t o = ((size_t)seq * 64 + chunk) * 1024 + nblk * 64 + ks * 32 + fq * 8;
            *(f32x4*)(cA + o) = (f32x4){arun[ks][0], arun[ks][1], arun[ks][2], arun[ks][3]}; *(f32x4*)(cA + o + 4) = (f32x4){arun[ks][4], arun[ks][5], arun[ks][6], arun[ks][7]};
            *(f32x4*)(cB + o) = (f32x4){hc[ks][0], hc[ks][1], hc[ks][2], hc[ks][3]}; *(f32x4*)(cB + o + 4) = (f32x4){hc[ks][4], hc[ks][5], hc[ks][6], hc[ks][7]}; }
    }
}

__global__ void __launch_bounds__(NWAVES * 64, 2) fwd_megakernel(Params p) {
    extern __shared__ __attribute__((aligned(16))) unsigned char lds_raw[];
    cg::grid_group grid = cg::this_grid();
    LAS unsigned char* lds = (LAS unsigned char*)lds_raw;
#define PH_IDS int tid = threadIdx.x; asm volatile("" : "+v"(tid)); const int lane = tid & 63, wave = __builtin_amdgcn_readfirstlane(tid >> 6); \
    const int G = gridDim.x, gw = blockIdx.x * NWAVES + wave, NGW = G * NWAVES; (void)lane; (void)gw; (void)NGW; (void)G
    unsigned char* ws = p.ws;
    float* R = p.out;
    bf16_t* XN = (bf16_t*)(ws + W_XN); bf16_t* U = (bf16_t*)(ws + W_U); bf16_t* H = (bf16_t*)(ws + W_H);
    bf16_t* Vt = (bf16_t*)(ws + W_VT); bf16_t* Ks = (bf16_t*)(ws + W_KS); bf16_t* Vts = (bf16_t*)(ws + W_VTS);
    bf16_t* Km = (bf16_t*)(ws + W_KM); bf16_t* Vtm = (bf16_t*)(ws + W_VTM);
    bf16_t* MN = (bf16_t*)(ws + W_MN); float* MKVF = (float*)(ws + W_MKVF); bf16_t* MQ = (bf16_t*)(ws + W_MQB);

    for (int rep_ = 0; rep_ < 1 + ((REPM >> 0) & 1); ++rep_) { if (rep_) grid.sync(); PH_IDS;
        LAS float* scr = (LAS float*)(lds + wave * 16384);
        constexpr int I_FU = (D / 64) * (FF / 32), I_FD = (FF / 64) * (D / 32), I_IN = (D / 64) * (NU / 32), I_P = (1024 / 64) * (D / 32), I_O = (D / 64) * (D / 32),
                      I_M = (D / 64) * (512 / 32), I_MO = (512 / 64) * (D / 32);
        constexpr int NITEMS = 4 * I_FU + 2 * I_FD + I_IN + 2 * I_P + I_O + 3 * I_M + I_MO;
        for (int it = gw; it < NITEMS; it += NGW) {
            int r = it;
#define TJ(IDX, KK, NN, OFF, SH, ADD, NI, GN) if (r < (NI)) { transpose_item(p.in[IDX], KK, NN, (bf16_t*)(ws + (OFF)), SH, ADD, scr, r, lane, GN); continue; } r -= (NI);
            TJ(10, D, FF, W_GU1, 8, 0, I_FU, nullptr) TJ(11, D, FF, W_GU1, 8, 128, I_FU, nullptr) TJ(12, FF, D, W_D1, 7, 0, I_FD, nullptr)
            TJ(37, D, FF, W_GU2, 8, 0, I_FU, p.in[36]) TJ(38, D, FF, W_GU2, 8, 128, I_FU, p.in[36]) TJ(39, FF, D, W_D2, 7, 0, I_FD, nullptr)
            TJ(14, D, NU, W_IN, 7, 0, I_IN, p.in[13]) TJ(25, 1024, D, W_PA, 7, 0, I_P, nullptr) TJ(26, 1024, D, W_PB, 7, 0, I_P, nullptr) TJ(27, D, D, W_OUT, 7, 0, I_O, nullptr)
            TJ(30, D, 512, W_MQ, 7, 0, I_M, p.in[28]) TJ(31, D, 512, W_MKV, 7, 0, I_M, nullptr) TJ(32, D, 512, W_MKV, 7, 512, I_M, nullptr)
            transpose_item(p.in[35], 512, D, (bf16_t*)(ws + W_MO), 7, 0, scr, r, lane, nullptr);
#undef TJ
        }
        for (int m = gw; m < MT; m += NGW) norm_row_bf16(m < MP ? p.in[0] + (size_t)m * D : p.in[1] + (size_t)(m - MP) * D, p.in[9], XN + (size_t)m * D, lane);
        for (int m = gw; m < 2048; m += NGW) norm_row_bf16(p.in[8] + (size_t)m * D, p.in[29], MN + (size_t)m * D, lane);
        {
            bf16_t* Wt = (bf16_t*)(ws + W_LRU); float* c8 = (float*)(ws + W_C8);
            for (int i = blockIdx.x * 512 + tid; i < 2 * 65536; i += G * 512) { const int gsel = i >> 16, n = (i >> 12) & 15, c = (i >> 6) & 63, k = i & 63;
                const float v = p.in[gsel ? 22 : 20][n * 4096 + k * 64 + c]; Wt[i] = (bf16_t)(pk2(v, 0.f) & 0xffffu); }
            for (int i = blockIdx.x * 512 + tid; i < 1024; i += G * 512) c8[i] = -8.0f * log1pf(expf(-p.in[24][i])) * LOG2E;
            float* ssz = (float*)(ws + W_SS);
            for (int i = blockIdx.x * 512 + tid; i < 3 * MT; i += G * 512) ssz[i] = 0.f;
            for (int i = blockIdx.x * 512 + tid; i < MS * D / 4; i += G * 512) ((f32x4*)(R + (size_t)MP * D))[i] = ((const f32x4*)p.in[1])[i];
        }
    }
    grid.sync();

    for (int rep_ = 0; rep_ < 1 + ((REPM >> 1) & 1); ++rep_) { if (rep_) grid.sync(); PH_IDS;
        pg8::Gemm g{XN, (const bf16_t*)(ws + W_GU1), MT, 2 * FF, D, D, D}; pg8::StaticOrder S; S.init(MT, 2 * FF, G, (int)blockIdx.x);
        pg8::EpiSwiglu E{H, FF, nullptr};
        pg8::gemm_phase<pg8::EpiSwiglu, true>(lds, g, S, E);
        pg8::Gemm g2{MN, (const bf16_t*)(ws + W_MKV), 2048, 1024, D, D, D}; pg8::StaticOrder S2; S2.init(2048, 1024, G, (int)((blockIdx.x + 128) % G));
        pg8::EpiF32 E2{MKVF, 1024};
        pg8::gemm_phase<pg8::EpiF32, true>(lds, g2, S2, E2);
    }
    grid.sync();

    for (int rep_ = 0; rep_ < 1 + ((REPM >> 2) & 1); ++rep_) { if (rep_) grid.sync(); PH_IDS;
        pg8::Gemm g{H, (const bf16_t*)(ws + W_D1), MP, D, FF, FF, FF}; pg8::StaticOrder S; S.init(MP, D, G, (int)blockIdx.x);
        pg8::EpiResid E{R, p.in[0], p.in[1], XN, (float*)(ws + W_SS), 0.5f};
        pg8::gemm_phase<pg8::EpiResid, true>(lds, g, S, E);
        pg8::Gemm gs{H + (size_t)MP * FF, (const bf16_t*)(ws + W_D1), MS, D, FF, FF, FF / 4}; pg8::SplitOrder Ss; Ss.init(MS, D, 4, G, (int)blockIdx.x);
        pg8::EpiResidAtomic Es{R + (size_t)MP * D, 0.5f};
        pg8::gemm_phase<pg8::EpiResidAtomic, true>(lds, gs, Ss, Es);
    }
    grid.sync();

    for (int rep_ = 0; rep_ < 1 + ((REPM >> 3) & 1); ++rep_) { if (rep_) grid.sync(); PH_IDS;
        for (int m = MP + gw; m < MT; m += NGW) feed_row(R + (size_t)m * D, XN + (size_t)m * D, (float*)(ws + W_SS) + m, lane);
        for (int r = gw; r < 2048; r += NGW) {
            const float* src = MKVF + (size_t)r * 1024 + lane * 8;
            const f32x4 k0 = *(const f32x4*)src, k1 = *(const f32x4*)(src + 4), v0 = *(const f32x4*)(src + 512), v1 = *(const f32x4*)(src + 516);
            float ss = (k0.x * k0.x + k0.y * k0.y + k0.z * k0.z + k0.w * k0.w) + (k1.x * k1.x + k1.y * k1.y + k1.z * k1.z + k1.w * k1.w);
            ss += __shfl_xor(ss, 1); ss += __shfl_xor(ss, 2); ss += __shfl_xor(ss, 4); ss += __shfl_xor(ss, 8);
            const float rs = rsqrtf(ss * (1.f / 128.f) + EPS);
            const f32x4 g0 = *(const f32x4*)(p.in[34] + (lane * 8) % 128), g1 = *(const f32x4*)(p.in[34] + (lane * 8) % 128 + 4);
            const f32x4 n0 = k0 * rs * g0, n1 = k1 * rs * g1;
            float* ko = p.out + O_MK + (size_t)r * 512 + lane * 8; *(f32x4*)ko = n0; *(f32x4*)(ko + 4) = n1;
            float* vo = p.out + O_MV + (size_t)r * 512 + lane * 8; *(f32x4*)vo = v0; *(f32x4*)(vo + 4) = v1;
            u32x4 w; w.x = pk2(n0.x, n0.y); w.y = pk2(n0.z, n0.w); w.z = pk2(n1.x, n1.y); w.w = pk2(n1.z, n1.w);
            *(u32x4*)(Km + (size_t)r * 512 + lane * 8) = w;
        }
        for (int r = gw; r < SBATCH * 256; r += NGW) {
            const float* src = p.in[6] + (size_t)r * 512 + lane * 8; const f32x4 k0 = *(const f32x4*)src, k1 = *(const f32x4*)(src + 4);
            u32x4 w; w.x = pk2(k0.x, k0.y); w.y = pk2(k0.z, k0.w); w.z = pk2(k1.x, k1.y); w.w = pk2(k1.z, k1.w);
            *(u32x4*)(Km + ((size_t)NBATCH * 256 + r) * 512 + lane * 8) = w;
        }
        for (int it = gw; it < NSEQ * 4 * 4; it += NGW) {
            const int seq = it >> 4, h = (it >> 2) & 3, j = (it & 3) * 64 + lane;
            const float* src = seq < NBATCH ? MKVF + ((size_t)seq * 256 + j) * 1024 + 512 + h * 128 : p.in[7] + (((size_t)(seq - NBATCH) * 256 + j) * 4 + h) * 128;
            bf16_t* dst = Vtm + ((size_t)(seq * 4 + h) * 128) * 256 + j;
#pragma unroll 4
            for (int dc = 0; dc < 32; ++dc) { const f32x4 v = *(const f32x4*)(src + dc * 4);
                dst[(size_t)(dc * 4 + 0) * 256] = (bf16_t)(pk2(v.x, 0.f)); dst[(size_t)(dc * 4 + 1) * 256] = (bf16_t)(pk2(v.y, 0.f));
                dst[(size_t)(dc * 4 + 2) * 256] = (bf16_t)(pk2(v.z, 0.f)); dst[(size_t)(dc * 4 + 3) * 256] = (bf16_t)(pk2(v.w, 0.f)); }
        }
    }
    grid.sync();

    for (int rep_ = 0; rep_ < 1 + ((REPM >> 4) & 1); ++rep_) { if (rep_) grid.sync(); PH_IDS;
        pg8::Gemm g{XN, (const bf16_t*)(ws + W_IN), MT, NU, D, D, D}; pg8::StaticOrder S; S.init(MT, NU, G, (int)blockIdx.x);
        pg8::EpiBf16 E{U, NU, (const float*)(ws + W_SS)};
        pg8::gemm_phase<pg8::EpiBf16, true>(lds, g, S, E);
    }
    grid.sync();

    for (int rep_ = 0; rep_ < 1 + ((REPM >> 5) & 1); ++rep_) { if (rep_) grid.sync(); PH_IDS;
        const bool dummy5 = ((REPM >> 5) & 1) && rep_ == 0;
        constexpr int T_ROWS = MT, T_VT = NBATCH * 64 * 8, T_KS = SBATCH * 512, T_VTS = SBATCH * 8 * 8, T_LRU = NBATCH * 64 * 16;
        for (int r = gw; r < T_ROWS; r += NGW) {
                const bool is_s = r >= MP; const int rs_ = r - MP;
                const int b = is_s ? (rs_ >> 4) : (r >> 12), t = is_s ? (rs_ & 15) : (r & 4095);
                bf16_t* urow = U + (size_t)r * NU;
                float kv[16], vv[16];
                { const u32x4 a = *(const u32x4*)(urow + OKK + lane * 16), c = *(const u32x4*)(urow + OKK + lane * 16 + 8);
                  float t0[8], t1[8]; unpack8(a, t0); unpack8(c, t1);
#pragma unroll
                  for (int i = 0; i < 8; ++i) { kv[i] = t0[i]; kv[8 + i] = t1[i]; } }
                { const u32x4 a = *(const u32x4*)(urow + OV + lane * 16), c = *(const u32x4*)(urow + OV + lane * 16 + 8);
                  float t0[8], t1[8]; unpack8(a, t0); unpack8(c, t1);
#pragma unroll
                  for (int i = 0; i < 8; ++i) { vv[i] = t0[i]; vv[8 + i] = t1[i]; } }
                float ss = 0.f;
#pragma unroll
                for (int i = 0; i < 16; ++i) ss += kv[i] * kv[i];
                ss += __shfl_xor(ss, 1); ss += __shfl_xor(ss, 2); ss += __shfl_xor(ss, 4);
                const float rstd = rsqrtf(ss * (1.f / 128.f) + EPS);
                const float* gp = p.in[16] + (lane * 16) % 128;
#pragma unroll
                for (int i = 0; i < 4; ++i) { const f32x4 gg = *(const f32x4*)(gp + 4 * i);
#pragma unroll
                    for (int j = 0; j < 4; ++j) kv[4 * i + j] *= rstd * gg[j]; }
                bf16_t* kd = is_s ? Ks + ((size_t)b * SKEYS + 512 + t) * 1024 + lane * 16 : (dummy5 ? XN + (size_t)r * 1024 + lane * 16 : urow + OKK + lane * 16);
                { float t0[8], t1[8];
#pragma unroll
                  for (int i = 0; i < 8; ++i) { t0[i] = kv[i]; t1[i] = kv[8 + i]; }
                  *(u32x4*)kd = pack8(t0); *(u32x4*)(kd + 8) = pack8(t1); }
                const bool wr_kv = is_s || t >= TSEQ - 512;
                if (wr_kv) {
                    const size_t ro = is_s ? (size_t)rs_ * 1024 : ((size_t)b * 512 + (t - (TSEQ - 512))) * 1024;
                    float* ko = p.out + (is_s ? O_KS : O_KP) + ro + lane * 16; float* vo = p.out + (is_s ? O_VS : O_VP) + ro + lane * 16;
#pragma unroll
                    for (int i = 0; i < 4; ++i) { *(f32x4*)(ko + 4 * i) = (f32x4){kv[4 * i], kv[4 * i + 1], kv[4 * i + 2], kv[4 * i + 3]}; *(f32x4*)(vo + 4 * i) = (f32x4){vv[4 * i], vv[4 * i + 1], vv[4 * i + 2], vv[4 * i + 3]}; }
                }
                const int tl = is_s ? STOK : TSEQ;
                if (t >= tl - 3) {
                    float xv[16];
                    { const u32x4 a = *(const u32x4*)(urow + OXR + lane * 16), c = *(const u32x4*)(urow + OXR + lane * 16 + 8);
                      float t0[8], t1[8]; unpack8(a, t0); unpack8(c, t1);
#pragma unroll
                      for (int i = 0; i < 8; ++i) { xv[i] = t0[i]; xv[8 + i] = t1[i]; } }
                    float* co = p.out + (is_s ? O_CS : O_CP) + ((size_t)b * 3 + (t - (tl - 3))) * 1024 + lane * 16;
#pragma unroll
                    for (int i = 0; i < 4; ++i) *(f32x4*)(co + 4 * i) = (f32x4){xv[4 * i], xv[4 * i + 1], xv[4 * i + 2], xv[4 * i + 3]};
                }
                if (is_s) {
                    const int h = lane >> 3, d0 = (lane & 7) * 16;
                    bf16_t* dst = Vts + ((size_t)(b * 8 + h) * 128 + d0) * SKEYS + 512 + t;
#pragma unroll
                    for (int i = 0; i < 16; ++i) dst[(size_t)i * SKEYS] = (bf16_t)pk2(vv[i], 0.f);
                }


        }
        for (int r = gw; r < T_VT; r += NGW) {
                const int b = r >> 9, c = (r >> 3) & 63, h = r & 7, t = c * 64 + lane;
                const bf16_t* src = U + ((size_t)b * TSEQ + t) * NU + OV + h * 128;
                bf16_t* dst = Vt + ((size_t)(b * 8 + h) * 128) * TSEQ + t;
#pragma unroll 4
                for (int dc = 0; dc < 16; ++dc) { const u32x4 w = *(const u32x4*)(src + dc * 8);
                    dst[(size_t)(dc * 8 + 0) * TSEQ] = (bf16_t)(w.x & 0xffffu); dst[(size_t)(dc * 8 + 1) * TSEQ] = (bf16_t)(w.x >> 16);
                    dst[(size_t)(dc * 8 + 2) * TSEQ] = (bf16_t)(w.y & 0xffffu); dst[(size_t)(dc * 8 + 3) * TSEQ] = (bf16_t)(w.y >> 16);
                    dst[(size_t)(dc * 8 + 4) * TSEQ] = (bf16_t)(w.z & 0xffffu); dst[(size_t)(dc * 8 + 5) * TSEQ] = (bf16_t)(w.z >> 16);
                    dst[(size_t)(dc * 8 + 6) * TSEQ] = (bf16_t)(w.w & 0xffffu); dst[(size_t)(dc * 8 + 7) * TSEQ] = (bf16_t)(w.w >> 16); }


        }
        for (int r = gw; r < T_KS; r += NGW) {
                const int b = r >> 9, j = r & 511;
                const float* src = p.in[2] + (size_t)r * 1024 + lane * 16;
                float t0[8], t1[8];
                { const f32x4 a = *(const f32x4*)src, c = *(const f32x4*)(src + 4), d = *(const f32x4*)(src + 8), e = *(const f32x4*)(src + 12);
                  t0[0] = a.x; t0[1] = a.y; t0[2] = a.z; t0[3] = a.w; t0[4] = c.x; t0[5] = c.y; t0[6] = c.z; t0[7] = c.w;
                  t1[0] = d.x; t1[1] = d.y; t1[2] = d.z; t1[3] = d.w; t1[4] = e.x; t1[5] = e.y; t1[6] = e.z; t1[7] = e.w; }
                bf16_t* kd = Ks + ((size_t)b * SKEYS + j) * 1024 + lane * 16;
                *(u32x4*)kd = pack8(t0); *(u32x4*)(kd + 8) = pack8(t1);


        }
        for (int r = gw; r < T_VTS; r += NGW) {
                const int b = r >> 6, h = (r >> 3) & 7, jg = r & 7, j = jg * 64 + lane;
                const float* src = p.in[3] + (((size_t)b * 512 + j) * 8 + h) * 128;
                bf16_t* dst = Vts + ((size_t)(b * 8 + h) * 128) * SKEYS + j;
#pragma unroll 4
                for (int dc = 0; dc < 32; ++dc) { const f32x4 v = *(const f32x4*)(src + dc * 4);
                    dst[(size_t)(dc * 4 + 0) * SKEYS] = (bf16_t)pk2(v.x, 0.f); dst[(size_t)(dc * 4 + 1) * SKEYS] = (bf16_t)pk2(v.y, 0.f);
                    dst[(size_t)(dc * 4 + 2) * SKEYS] = (bf16_t)pk2(v.z, 0.f); dst[(size_t)(dc * 4 + 3) * SKEYS] = (bf16_t)pk2(v.w, 0.f); }
                if (jg == 7 && lane < 16) { bf16_t* pz = Vts + ((size_t)(b * 8 + h) * 128) * SKEYS + 528 + lane;
                    for (int d = 0; d < 128; ++d) pz[(size_t)d * SKEYS] = 0; }


        }
        for (int r = gw; r < T_LRU; r += NGW) lru_unit<0>(p, r >> 10, (r >> 4) & 63, r & 15, lane, nullptr, 0u, 0u);
    }
    grid.sync();

    for (int rep_ = 0; rep_ < 1 + ((REPM >> 6) & 1); ++rep_) { if (rep_) grid.sync(); PH_IDS;
        const bool dummy = ((REPM >> 6) & 1) && rep_ == 0;
        LAS float* tbl = (LAS float*)(lds + 65536);
        constexpr int T_AP = NBATCH * 64 * 8 * 2, T_AS = SBATCH * 8, T_LP = NBATCH * 64 * 16, T_LS = SBATCH * 16;
        for (int wt = blockIdx.x; wt < NBATCH * 8 * 16; wt += G) {
            int pair, cg4;
            if (G == 256) { const int itp = wt >> 8, x = blockIdx.x & 7, j = blockIdx.x >> 3; pair = x * 8 + itp * 2 + (j >> 4); cg4 = (j + itp * 4) & 15; }
            else { pair = wt >> 4; cg4 = wt & 15; }
            attn_wg_prompt(p, lds, pair >> 3, pair & 7, cg4, dummy ? XN : U, dummy ? 1024 : NU, dummy ? 0 : OQ, tid);
        }
        __syncthreads();
        for (int q = blockIdx.x; q < T_AS; q += G) if (wave == 0) {
            const int b = q >> 3, h = q & 7;
            for (int i = lane; i < 640; i += 64) { int d = i - 63; d = d < -256 ? -256 : (d > 256 ? 256 : d); tbl[i] = p.in[17][h * 513 + d + 256] * LOG2E; }
            asm volatile("s_waitcnt lgkmcnt(0)" ::: "memory");
            __builtin_amdgcn_wave_barrier();
            bf16_t* qp = U + ((size_t)MP + (size_t)b * STOK) * NU + OQ + h * 128;
            attn_task<true>(qp, NU, dummy ? XN + ((size_t)MP + (size_t)b * STOK) * 1024 + h * 128 : qp, dummy ? 1024 : NU, Ks + (size_t)b * SKEYS * 1024 + h * 128, 1024, Vts + ((size_t)(b * 8 + h) * 128) * SKEYS, SKEYS,
                            17, 528, 1, p.in[15], tbl, 1024 - 512 + 63, lane);
            asm volatile("s_waitcnt lgkmcnt(0)" ::: "memory");
            __builtin_amdgcn_wave_barrier();
        }
        for (int r = gw; r < T_LP + T_LS; r += NGW) {
            const bool pr = r < T_LP; const int r2 = r - T_LP;
            lru_unit<1>(p, pr ? (r >> 10) : NBATCH + (r2 >> 4), pr ? ((r >> 4) & 63) : 0, pr ? (r & 15) : (r2 & 15), lane, dummy ? XN + (size_t)MT * 1024 : U, dummy ? 1024u : (unsigned)NU, dummy ? 0u : (unsigned)OGR);
        }
    }
    grid.sync();

    for (int rep_ = 0; rep_ < 1 + ((REPM >> 7) & 1); ++rep_) { if (rep_) grid.sync(); PH_IDS;
        pg8::StaticOrder S; S.init(MT, D, G, (int)blockIdx.x);
        pg8::Gemm g1{U + OQ, (const bf16_t*)(ws + W_PA), MT, D, 1024, NU, 1024};
        pg8::EpiGate E1{U + OGA, U + OGA, NU, 0};
        pg8::gemm_phase<pg8::EpiGate, true>(lds, g1, S, E1);
        pg8::Gemm g2{U + OGR, (const bf16_t*)(ws + W_PB), MT, D, 1024, NU, 1024};
        pg8::EpiGate E2{U + OGA, U + OGB, NU, 1};
        pg8::gemm_phase<pg8::EpiGate, true>(lds, g2, S, E2);
    }
    grid.sync();

    for (int rep_ = 0; rep_ < 1 + ((REPM >> 8) & 1); ++rep_) { if (rep_) grid.sync(); PH_IDS;
        pg8::Gemm g{U + OGA, (const bf16_t*)(ws + W_OUT), MP, D, D, NU, D}; pg8::StaticOrder S; S.init(MP, D, G, (int)blockIdx.x);
        pg8::EpiResid E{R, nullptr, nullptr, XN, (float*)(ws + W_SS) + MT, 1.0f};
        pg8::gemm_phase<pg8::EpiResid, true>(lds, g, S, E);
        pg8::Gemm gs{U + (size_t)MP * NU + OGA, (const bf16_t*)(ws + W_OUT), MS, D, D, NU, D / 4}; pg8::SplitOrder Ss; Ss.init(MS, D, 4, G, (int)blockIdx.x);
        pg8::EpiResidAtomic Es{R + (size_t)MP * D, 1.0f};
        pg8::gemm_phase<pg8::EpiResidAtomic, true>(lds, gs, Ss, Es);
    }
    grid.sync();

    for (int rep_ = 0; rep_ < 1 + ((REPM >> 9) & 1); ++rep_) { PH_IDS;
    for (int m = MP + gw; m < MT; m += NGW) feed_row(R + (size_t)m * D, XN + (size_t)m * D, (float*)(ws + W_SS) + MT + m, lane); }
    grid.sync();

    for (int rep_ = 0; rep_ < 1 + ((REPM >> 10) & 1); ++rep_) { if (rep_) grid.sync(); PH_IDS;
        pg8::Gemm g{XN, (const bf16_t*)(ws + W_MQ), MT, 512, D, D, D}; pg8::StaticOrder S; S.init(MT, 512, G, (int)blockIdx.x);
        pg8::EpiBf16 E{MQ, 512, (const float*)(ws + W_SS) + MT};
        pg8::gemm_phase<pg8::EpiBf16, true>(lds, g, S, E);
    }
    grid.sync();

    for (int rep_ = 0; rep_ < 1 + ((REPM >> 11) & 1); ++rep_) { if (rep_) grid.sync(); PH_IDS;
        constexpr int T_P = (MP / 32) * 4, T_S = SBATCH * 4;
        for (int it = gw; it < T_P + T_S; it += NGW) {
            if (it < T_P) { const int rt = it >> 2, h = it & 3, seq = rt >> 7;
                bf16_t* qp = MQ + (size_t)rt * 32 * 512 + h * 128;
                attn_task<false>(qp, 512, qp, 512, Km + (size_t)seq * 256 * 512 + h * 128, 512, Vtm + ((size_t)(seq * 4 + h) * 128) * 256, 256, 8, 256, 2, p.in[33], nullptr, 0, lane);
            } else { const int q = it - T_P, b = q >> 2, h = q & 3, seq = NBATCH + b;
                bf16_t* qp = MQ + ((size_t)MP + (size_t)b * STOK) * 512 + h * 128;
                attn_task<false>(qp, 512, qp, 512, Km + (size_t)seq * 256 * 512 + h * 128, 512, Vtm + ((size_t)(seq * 4 + h) * 128) * 256, 256, 8, 256, 1, p.in[33], nullptr, 0, lane);
            }
        }
    }
    grid.sync();

    for (int rep_ = 0; rep_ < 1 + ((REPM >> 12) & 1); ++rep_) { if (rep_) grid.sync(); PH_IDS;
        pg8::Gemm g{MQ, (const bf16_t*)(ws + W_MO), MT, D, 512, 512, 512}; pg8::StaticOrder S; S.init(MT, D, G, (int)blockIdx.x);
        pg8::EpiResid E{R, nullptr, nullptr, XN, (float*)(ws + W_SS) + 2 * MT, 1.0f};
        pg8::gemm_phase<pg8::EpiResid, true>(lds, g, S, E);
    }
    grid.sync();

    for (int rep_ = 0; rep_ < 1 + ((REPM >> 14) & 1); ++rep_) { if (rep_) grid.sync(); PH_IDS;
        pg8::Gemm g{XN, (const bf16_t*)(ws + W_GU2), MT, 2 * FF, D, D, D}; pg8::StaticOrder S; S.init(MT, 2 * FF, G, (int)blockIdx.x);
        pg8::EpiSwiglu E{H, FF, (const float*)(ws + W_SS) + 2 * MT};
        pg8::gemm_phase<pg8::EpiSwiglu, true>(lds, g, S, E);
    }
    grid.sync();

    for (int rep_ = 0; rep_ < 1 + ((REPM >> 15) & 1); ++rep_) { if (rep_) grid.sync(); PH_IDS;
        pg8::Gemm g{H, (const bf16_t*)(ws + W_D2), MP, D, FF, FF, FF}; pg8::StaticOrder S; S.init(MP, D, G, (int)blockIdx.x);
        pg8::EpiResid E{R, nullptr, nullptr, nullptr, nullptr, 0.5f};
        pg8::gemm_phase<pg8::EpiResid, true>(lds, g, S, E);
        pg8::Gemm gs{H + (size_t)MP * FF, (const bf16_t*)(ws + W_D2), MS, D, FF, FF, FF / 4}; pg8::SplitOrder Ss; Ss.init(MS, D, 4, G, (int)blockIdx.x);
        pg8::EpiResidAtomic Es{R + (size_t)MP * D, 0.5f};
        pg8::gemm_phase<pg8::EpiResidAtomic, true>(lds, gs, Ss, Es);
    }
    grid.sync();

    for (int rep_ = 0; rep_ < 1 + ((REPM >> 16) & 1); ++rep_) { PH_IDS;
    for (int m = gw; m < MT; m += NGW) norm_row_f32(R + (size_t)m * D, p.in[40], lane); }
}

extern "C" void kernel_launch(void* const* d_in, const int* in_sizes, int n_in, void* d_out, int out_size, void* d_ws, size_t ws_size, hipStream_t stream) {
    static int grid = 0;
    if (grid == 0) {
        if (n_in != 41 || (size_t)out_size != O_END || ws_size < W_END) {
            fprintf(stderr, "kernel_launch: unexpected sizes: n_in %d out %d (want %zu) ws %zu (want >= %zu)\n", n_in, out_size, (size_t)O_END, ws_size, (size_t)W_END); grid = -1; return; }
        int dev = 0, cus = 0, per_cu = 0;
        hipGetDevice(&dev); hipDeviceGetAttribute(&cus, hipDeviceAttributeMultiprocessorCount, dev);
        hipFuncSetAttribute((const void*)fwd_megakernel, hipFuncAttributeMaxDynamicSharedMemorySize, LDS_BYTES);
        hipOccupancyMaxActiveBlocksPerMultiprocessor(&per_cu, (const void*)fwd_megakernel, NWAVES * 64, LDS_BYTES);
        if (per_cu < 1) { fprintf(stderr, "kernel_launch: occupancy query says %d blocks per CU\n", per_cu); per_cu = 1; }
        (void)hipGetLastError();
        grid = cus * 1;
    }
    if (grid < 0) return;
    Params p{};
    for (int i = 0; i < 41; ++i) p.in[i] = (const float*)d_in[i];
    p.out = (float*)d_out; p.ws = (unsigned char*)d_ws;
    void* args[] = {&p};
    hipError_t e = hipLaunchCooperativeKernel((const void*)fwd_megakernel, dim3(grid), dim3(NWAVES * 64), args, LDS_BYTES, stream);
    if (e != hipSuccess) fprintf(stderr, "kernel_launch: cooperative launch failed: %s (grid %d)\n", hipGetErrorString(e), grid);
}
```

```cpp
#include <hip/hip_runtime.h>
#include <hip/hip_cooperative_groups.h>
#include <cstdio>
#include <cstdint>
namespace cg = cooperative_groups;

#define LAS __attribute__((address_space(3)))
typedef unsigned short bf16_t;
typedef short bf16x8 __attribute__((ext_vector_type(8)));
typedef float f32x4 __attribute__((ext_vector_type(4)));
typedef float f32x2 __attribute__((ext_vector_type(2)));
typedef unsigned u32x4 __attribute__((ext_vector_type(4)));
typedef unsigned u32x2 __attribute__((ext_vector_type(2)));
typedef __bf16 bf16x2_t __attribute__((ext_vector_type(2)));
#define DI __device__ __forceinline__

constexpr int D = 2048, NBATCH = 8, TSEQ = 4096, MP = NBATCH * TSEQ, SBATCH = 32, STOK = 16, MS = SBATCH * STOK, MT = MP + MS;
constexpr int FF = 5632, NU = 9216, NWAVES = 8;
constexpr int OQ = 0, OKK = 1024, OV = 2048, OXR = 3072, OGR = 4096, OGA = 5120, OGB = 7168;
constexpr int SKEYS = 544;
constexpr float EPS = 1e-6f, LOG2E = 1.4426950408889634f;
constexpr int NSEQ = NBATCH + SBATCH;

constexpr size_t O_YP = 0, O_YS = (size_t)MP * D, O_KP = O_YS + (size_t)MS * D, O_VP = O_KP + (size_t)NBATCH * 512 * 1024,
                 O_CP = O_VP + (size_t)NBATCH * 512 * 1024, O_LP = O_CP + (size_t)NBATCH * 3 * 1024, O_MK = O_LP + (size_t)NBATCH * 1024,
                 O_MV = O_MK + (size_t)NBATCH * 256 * 512, O_KS = O_MV + (size_t)NBATCH * 256 * 512, O_VS = O_KS + (size_t)MS * 1024,
                 O_CS = O_VS + (size_t)MS * 1024, O_LS = O_CS + (size_t)SBATCH * 3 * 1024, O_END = O_LS + (size_t)SBATCH * 1024;

constexpr size_t al256(size_t x) { return (x + 255) & ~(size_t)255; }
constexpr size_t W_GU1 = 0, W_D1 = W_GU1 + (size_t)2 * FF * D * 2, W_IN = W_D1 + (size_t)D * FF * 2, W_PA = W_IN + (size_t)NU * D * 2,
                 W_PB = W_PA + (size_t)D * 1024 * 2, W_OUT = W_PB + (size_t)D * 1024 * 2, W_MQ = W_OUT + (size_t)D * D * 2, W_MKV = W_MQ + (size_t)512 * D * 2,
                 W_MO = W_MKV + (size_t)1024 * D * 2, W_GU2 = W_MO + (size_t)D * 512 * 2, W_D2 = W_GU2 + (size_t)2 * FF * D * 2, W_LRU = W_D2 + (size_t)D * FF * 2,
                 W_C8 = W_LRU + (size_t)2 * 16 * 64 * 64 * 2, W_XN = al256(W_C8 + 1024 * 4), W_U = W_XN + (size_t)MT * D * 2, W_VT = W_U + (size_t)MT * NU * 2,
                 W_KS = W_VT + (size_t)NBATCH * 8 * 128 * TSEQ * 2, W_VTS = W_KS + (size_t)SBATCH * SKEYS * 1024 * 2, W_KM = W_VTS + (size_t)SBATCH * 8 * 128 * SKEYS * 2,
                 W_VTM = W_KM + (size_t)NSEQ * 256 * 512 * 2, W_CA = W_VTM + (size_t)NSEQ * 4 * 128 * 256 * 2, W_CB = W_CA + (size_t)NBATCH * 64 * 1024 * 4,
                 W_SS = W_CB + (size_t)NBATCH * 64 * 1024 * 4, W_BAR = al256(W_SS + (size_t)3 * MT * 4), W_END = W_BAR + 16384;
constexpr size_t W_H = W_U, W_MQB = W_U, W_MN = W_U + (size_t)MT * FF * 2, W_MKVF = W_MN + (size_t)2048 * D * 2;

#ifndef STAG
#define STAG 0
#endif
#ifndef REPM
#define REPM 0
#endif
constexpr int RING_BYTES = 131072, LDS_BYTES = 147456;

struct Params { const float* in[41]; float* out; unsigned char* ws; };

DI unsigned pk2(float a, float b) { f32x2 v = {a, b}; bf16x2_t r = __builtin_convertvector(v, bf16x2_t); return __builtin_bit_cast(unsigned, r); }
DI float bf_lo(unsigned w) { return __builtin_bit_cast(float, w << 16); }
DI float bf_hi(unsigned w) { return __builtin_bit_cast(float, w & 0xffff0000u); }
DI void unpack8(const u32x4 w, float (&f)[8]) { f[0] = bf_lo(w.x); f[1] = bf_hi(w.x); f[2] = bf_lo(w.y); f[3] = bf_hi(w.y); f[4] = bf_lo(w.z); f[5] = bf_hi(w.z); f[6] = bf_lo(w.w); f[7] = bf_hi(w.w); }
DI u32x4 pack8(const float (&f)[8]) { u32x4 w; w.x = pk2(f[0], f[1]); w.y = pk2(f[2], f[3]); w.z = pk2(f[4], f[5]); w.w = pk2(f[6], f[7]); return w; }
DI float wave_sum(float v) {
#pragma unroll
    for (int o = 1; o < 64; o <<= 1) v += __shfl_xor(v, o);
    return v;
}
DI float fast_exp2(float x) { return __builtin_amdgcn_exp2f(x); }
DI float fast_rcp(float x) { return __builtin_amdgcn_rcpf(x); }
DI float sigmoidf_(float x) { return fast_rcp(1.0f + fast_exp2(-x * LOG2E)); }
template <int S> DI float dpp_shr(float old, float v) {
    return __builtin_bit_cast(float, __builtin_amdgcn_update_dpp(__builtin_bit_cast(int, old), __builtin_bit_cast(int, v), 0x110 + S, 0xf, 0xf, false));
}
#define LDS_WAIT() asm volatile("s_waitcnt lgkmcnt(0)" ::: "memory")

namespace pg8 {
constexpr int BM = 256, BK = 64, HALF = 128, HTB = HALF * BK * 2, STAGE_BYTES = 8 * HTB, NXCD = 8, WGM = 8;
DI int lds_byte(int r, int c) { const int st = (r >> 4) * 2 + (c >> 5), rr = r & 15, cc = c & 31, ob = rr * 64 + cc * 2; return st * 1024 + (ob ^ (((ob >> 9) & 1) << 5)); }
DI void stage_rc(int b, int& R, int& C) { const int st = b / 1024, sb = b % 1024, swz = sb ^ (((sb >> 9) & 1) << 5); R = (st >> 1) * 16 + swz / 64; C = (st & 1) * 32 + (swz % 64) / 2; }
DI int perm32(int rho) { const int n = rho >> 4, i = rho & 15; return 8 * (i >> 2) + 4 * n + (i & 3); }
struct Unit { int pm, pn, ks; };
struct Gemm { const bf16_t* A; const bf16_t* Bt; int M, N, K, lda, kloop; };
struct StaticOrder {
    int nM, nN, nwg, G, c;
    DI void init(int M, int N, int G_, int c_) { nM = M / BM; nN = N / BM; nwg = nM * nN; G = G_; c = c_; }
    DI bool next(int i, Unit& u) const {
        const long L = (long)i * G + c; if (L >= nwg) return false;
        int wgid = (int)L; { const int q = nwg / NXCD, r = nwg % NXCD, xcd = wgid % NXCD, off = wgid / NXCD; wgid = (xcd < r ? xcd * (q + 1) : r * (q + 1) + (xcd - r) * q) + off; }
        const int nig = WGM * nN, gid = wgid / nig, fm = gid * WGM, gsz = (nM - fm) < WGM ? (nM - fm) : WGM;
        u.pm = fm + ((wgid % nig) % gsz); u.pn = (wgid % nig) / gsz; u.ks = 0; return true;
    }
};
struct SplitOrder {
    int nM, nN, ntot, G, c;
    DI void init(int M, int N, int nsplit, int G_, int c_) { nM = M / BM; nN = N / BM; ntot = nM * nN * nsplit; G = G_; c = c_; }
    DI bool next(int i, Unit& u) const {
        const int L = i * G + c; if (L >= ntot) return false;
        u.pm = L % nM; const int r = L / nM; u.pn = r % nN; u.ks = r / nN; return true;
    }
};
typedef f32x4 Acc[2][2][4][2];

struct EpiBf16 {
    static constexpr bool PERM = true;
    bf16_t* O; int ldc; const float* ss;
    DI void operator()(const Acc& acc, const Unit& u, int wr, int wc, int fr, int fq) const {
        const int row0 = u.pm * BM + wr * 64 + fr, col0 = u.pn * BM + wc * 32 + 8 * fq;
#pragma unroll
        for (int ai = 0; ai < 2; ++ai)
#pragma unroll
            for (int m = 0; m < 4; ++m) { bf16_t* rowp = O + (size_t)(row0 + ai * HALF + m * 16) * ldc + col0;
                const float rs = ss ? rsqrtf(ss[row0 + ai * HALF + m * 16] * (1.f / D) + EPS) : 1.f;
#pragma unroll
                for (int bj = 0; bj < 2; ++bj) { const f32x4 v0 = acc[ai][bj][m][0] * rs, v1 = acc[ai][bj][m][1] * rs;
                    u32x4 w; w.x = pk2(v0[0], v0[1]); w.y = pk2(v0[2], v0[3]); w.z = pk2(v1[0], v1[1]); w.w = pk2(v1[2], v1[3]);
                    *(u32x4*)(rowp + bj * HALF) = w; } }
    }
};
struct EpiSwiglu {
    static constexpr bool PERM = true;
    bf16_t* O; int ldc; const float* ss;
    DI void operator()(const Acc& acc, const Unit& u, int wr, int wc, int fr, int fq) const {
        const int row0 = u.pm * BM + wr * 64 + fr, col0 = u.pn * HALF + wc * 32 + 8 * fq;
#pragma unroll
        for (int ai = 0; ai < 2; ++ai)
#pragma unroll
            for (int m = 0; m < 4; ++m) {
                const float rs = ss ? rsqrtf(ss[row0 + ai * HALF + m * 16] * (1.f / D) + EPS) : 1.f;
                float h[8];
#pragma unroll
                for (int n = 0; n < 2; ++n)
#pragma unroll
                    for (int j = 0; j < 4; ++j) { const float g = acc[ai][0][m][n][j] * rs, up = acc[ai][1][m][n][j] * rs; h[n * 4 + j] = g * sigmoidf_(g) * up; }
                *(u32x4*)(O + (size_t)(row0 + ai * HALF + m * 16) * ldc + col0) = pack8(h); }
    }
};
struct EpiGate {
    static constexpr bool PERM = true;
    bf16_t* O; const bf16_t* G; int ld; int accum;
    DI void operator()(const Acc& acc, const Unit& u, int wr, int wc, int fr, int fq) const {
        const int row0 = u.pm * BM + wr * 64 + fr, col0 = u.pn * BM + wc * 32 + 8 * fq;
#pragma unroll
        for (int ai = 0; ai < 2; ++ai)
#pragma unroll
            for (int m = 0; m < 4; ++m)
#pragma unroll
                for (int bj = 0; bj < 2; ++bj) {
                    const size_t off = (size_t)(row0 + ai * HALF + m * 16) * ld + col0 + bj * HALF;
                    float gv[8], o[8]; unpack8(*(const u32x4*)(G + off), gv);
                    if (accum) unpack8(*(const u32x4*)(O + off), o);
                    else {
#pragma unroll
                        for (int i = 0; i < 8; ++i) o[i] = 0.f; }
#pragma unroll
                    for (int n = 0; n < 2; ++n)
#pragma unroll
                        for (int j = 0; j < 4; ++j) o[n * 4 + j] += sigmoidf_(gv[n * 4 + j]) * acc[ai][bj][m][n][j];
                    *(u32x4*)(O + off) = pack8(o); }
    }
};
struct EpiResid {
    static constexpr bool PERM = false;
    float* R; const float* xp; const float* xs; bf16_t* Xb; float* ss; float alpha;
    DI void operator()(const Acc& acc, const Unit& u, int wr, int wc, int fr, int fq) const {
        const float al = alpha; bf16_t* const xb = Xb; float* const ssp = ss;
        const int row0 = u.pm * BM + wr * 64 + fr, col0 = u.pn * BM + wc * 32 + 4 * fq;
#pragma unroll
        for (int ai = 0; ai < 2; ++ai)
#pragma unroll
            for (int m = 0; m < 4; ++m) { const int row = row0 + ai * HALF + m * 16;
                float* rp = R + (size_t)row * D + col0;
                const float* bp = xp ? (row < MP ? xp + (size_t)row * D + col0 : xs + (size_t)(row - MP) * D + col0) : rp;
                float sq = 0.f;
#pragma unroll
                for (int bj = 0; bj < 2; ++bj)
#pragma unroll
                    for (int n = 0; n < 2; ++n) { const f32x4 b = *(const f32x4*)(bp + bj * HALF + n * 16); const f32x4 a4 = acc[ai][bj][m][n];
                        f32x4 v; v[0] = b[0] + al * a4[0]; v[1] = b[1] + al * a4[1]; v[2] = b[2] + al * a4[2]; v[3] = b[3] + al * a4[3];
                        *(f32x4*)(rp + bj * HALF + n * 16) = v;
                        if (xb) { u32x2 w; w.x = pk2(v[0], v[1]); w.y = pk2(v[2], v[3]); *(u32x2*)(xb + (size_t)row * D + col0 + bj * HALF + n * 16) = w;
                            sq += (v[0] * v[0] + v[1] * v[1]) + (v[2] * v[2] + v[3] * v[3]); } }
                if (xb) { sq += __shfl_xor(sq, 16); sq += __shfl_xor(sq, 32); if (fq == 0) unsafeAtomicAdd(ssp + row, sq); } }
    }
};
struct EpiResidAtomic {
    static constexpr bool PERM = false;
    float* R; float alpha;
    DI void operator()(const Acc& acc, const Unit& u, int wr, int wc, int fr, int fq) const {
        const int row0 = u.pm * BM + wr * 64 + fr, col0 = u.pn * BM + wc * 32 + 4 * fq;
#pragma unroll
        for (int ai = 0; ai < 2; ++ai)
#pragma unroll
            for (int m = 0; m < 4; ++m) { float* rp = R + (size_t)(row0 + ai * HALF + m * 16) * D + col0;
#pragma unroll
                for (int bj = 0; bj < 2; ++bj)
#pragma unroll
                    for (int n = 0; n < 2; ++n)
#pragma unroll
                        for (int j = 0; j < 4; ++j) unsafeAtomicAdd(rp + bj * HALF + n * 16 + j, alpha * acc[ai][bj][m][n][j]); }
    }
};
struct EpiF32 {
    static constexpr bool PERM = false;
    float* C; int ldc;
    DI void operator()(const Acc& acc, const Unit& u, int wr, int wc, int fr, int fq) const {
        const int row0 = u.pm * BM + wr * 64 + fr, col0 = u.pn * BM + wc * 32 + 4 * fq;
#pragma unroll
        for (int ai = 0; ai < 2; ++ai)
#pragma unroll
            for (int m = 0; m < 4; ++m) { float* rp = C + (size_t)(row0 + ai * HALF + m * 16) * ldc + col0;
#pragma unroll
                for (int bj = 0; bj < 2; ++bj)
#pragma unroll
                    for (int n = 0; n < 2; ++n) *(f32x4*)(rp + bj * HALF + n * 16) = acc[ai][bj][m][n]; }
    }
};

template <class Epi, bool ALIGN_EPI, class Sched>
DI void gemm_phase(LAS unsigned char* lds, const Gemm g, const Sched& S, const Epi& E, int stag = 0) {
    int tid = threadIdx.x; asm volatile("" : "+v"(tid));
    const int wid = __builtin_amdgcn_readfirstlane(tid >> 6), lane = tid & 63, wr = wid >> 2, wc = wid & 3, fr = lane & 15, fq = lane >> 4;
    const int K = g.K, nt = g.kloop / BK;
    const size_t ksl = (size_t)g.kloop * 2;
    unsigned voffA[2], voffB[2];
#pragma unroll
    for (int i = 0; i < 2; ++i) { int R, C; stage_rc(tid * 16 + i * 8192, R, C); const int Rb = Epi::PERM ? ((R & ~31) + perm32(R & 31)) : R;
        voffA[i] = (unsigned)(R * g.lda + C) * 2u; voffB[i] = (unsigned)(Rb * K + C) * 2u; }
    const size_t kstep = (size_t)(BK * 2);
    const size_t hstepA = (size_t)HALF * g.lda * 2, hstepB = (size_t)HALF * K * 2;
    const size_t tstepA = 2 * hstepA, tstepB = 2 * hstepB;
    const unsigned ldsw = (unsigned)wid * 1024u;
    const int aoff = lds_byte(wr * 64 + fr, fq * 8), boff = lds_byte(wc * 32 + fr, fq * 8);
#define PG8_SA(b, h) (((b) * 2 + (h)) * HTB)
#define PG8_SB(b, h) ((4 + (b) * 2 + (h)) * HTB)
#define PG8_STAGE(bufoff, gbase, voff) do { _Pragma("unroll") for (int _i = 0; _i < 2; ++_i) \
        __builtin_amdgcn_global_load_lds((const unsigned*)((const char*)(gbase) + (voff)[_i]), (LAS unsigned*)(lds + (bufoff) + ldsw + _i * 8192), 16, 0, 0); } while (0)
#define PG8_LDA(dst, b, h) do { _Pragma("unroll") for (int m = 0; m < 4; ++m) _Pragma("unroll") for (int k = 0; k < 2; ++k) dst[m][k] = *(const LAS bf16x8*)(lds + PG8_SA(b, h) + aoff + m * 2048 + k * 1024); } while (0)
#define PG8_LDB(dst, b, h) do { _Pragma("unroll") for (int n = 0; n < 2; ++n) _Pragma("unroll") for (int k = 0; k < 2; ++k) dst[n][k] = *(const LAS bf16x8*)(lds + PG8_SB(b, h) + boff + n * 2048 + k * 1024); } while (0)
#define PG8_MMA(ai, bj, At, Bt) do { __builtin_amdgcn_s_setprio(1); _Pragma("unroll") for (int m = 0; m < 4; ++m) _Pragma("unroll") for (int n = 0; n < 2; ++n) _Pragma("unroll") for (int k = 0; k < 2; ++k) \
        acc[ai][bj][m][n] = __builtin_amdgcn_mfma_f32_16x16x32_bf16(Bt[n][k], At[m][k], acc[ai][bj][m][n], 0, 0, 0); __builtin_amdgcn_s_setprio(0); } while (0)
#define PG8_WAIT_V(n) asm volatile("s_waitcnt vmcnt(" #n ")" ::: "memory")
#define PG8_WAIT_L(n) asm volatile("s_waitcnt lgkmcnt(" #n ")" ::: "memory")
#define PG8_BAR __builtin_amdgcn_s_barrier()
#define PG8_SCHED __builtin_amdgcn_sched_barrier(0)
    Unit cur, nxt; int ui = 0;
    if (!S.next(0, cur)) return;
    if (stag) {
        const unsigned long long t0 = __builtin_amdgcn_s_memrealtime(), dl = (unsigned long long)((blockIdx.x >> 5) & 7) * (unsigned)stag;
        while (__builtin_amdgcn_s_memrealtime() - t0 < dl) __builtin_amdgcn_s_sleep(8);
    }
    Acc acc;
#pragma unroll
    for (int a = 0; a < 2; ++a)
#pragma unroll
        for (int b = 0; b < 2; ++b)
#pragma unroll
            for (int m = 0; m < 4; ++m)
#pragma unroll
                for (int n = 0; n < 2; ++n) acc[a][b][m][n] = (f32x4){0.f, 0.f, 0.f, 0.f};
    bf16x8 At[4][2], B0[2][2], B1[2][2];
    const char* cA = (const char*)g.A + (size_t)cur.pm * tstepA + (size_t)cur.ks * ksl; const char* cB = (const char*)g.Bt + (size_t)cur.pn * tstepB + (size_t)cur.ks * ksl;
    PG8_STAGE(PG8_SB(0, 0), cB, voffB); PG8_STAGE(PG8_SB(0, 1), cB + hstepB, voffB); PG8_STAGE(PG8_SA(0, 0), cA, voffA); PG8_STAGE(PG8_SA(0, 1), cA + hstepA, voffA);
    if (wr == 1) PG8_BAR;
    PG8_WAIT_V(2); PG8_BAR;
    PG8_STAGE(PG8_SB(1, 0), cB + kstep, voffB); PG8_STAGE(PG8_SA(1, 0), cA + kstep, voffA); PG8_STAGE(PG8_SB(1, 1), cB + hstepB + kstep, voffB);
    PG8_WAIT_V(6); PG8_BAR;
    for (;;) {
        const bool has_next = S.next(ui + 1, nxt);
        const char* nA = has_next ? (const char*)g.A + (size_t)nxt.pm * tstepA + (size_t)nxt.ks * ksl : cA; const char* nB = has_next ? (const char*)g.Bt + (size_t)nxt.pn * tstepB + (size_t)nxt.ks * ksl : cB;
        for (int t = 0; t < nt; t += 2) {
            const bool last = (t == nt - 2);
            const char* a1 = cA + (size_t)(t + 1) * kstep;
            const char* a2 = last ? nA : cA + (size_t)(t + 2) * kstep; const char* b2 = last ? nB : cB + (size_t)(t + 2) * kstep;
            const char* a3 = a2 + kstep; const char* b3 = b2 + kstep;
            PG8_LDB(B0, 0, 0); PG8_LDB(B1, 0, 1); PG8_SCHED; PG8_LDA(At, 0, 0); PG8_STAGE(PG8_SA(1, 1), a1 + hstepA, voffA);
            PG8_WAIT_V(8); PG8_WAIT_L(0); PG8_BAR; PG8_MMA(0, 0, At, B0); PG8_MMA(0, 1, At, B1); PG8_BAR; PG8_SCHED;
            PG8_LDA(At, 0, 1); PG8_STAGE(PG8_SB(0, 0), b2, voffB); PG8_STAGE(PG8_SB(0, 1), b2 + hstepB, voffB); PG8_STAGE(PG8_SA(0, 0), a2, voffA);
            PG8_WAIT_V(8); PG8_WAIT_L(0); PG8_BAR; PG8_MMA(1, 0, At, B0); PG8_MMA(1, 1, At, B1); PG8_BAR; PG8_SCHED;
            PG8_LDB(B0, 1, 0); PG8_LDB(B1, 1, 1); PG8_SCHED; PG8_LDA(At, 1, 0); PG8_STAGE(PG8_SA(0, 1), a2 + hstepA, voffA);
            PG8_WAIT_V(8); PG8_WAIT_L(0); PG8_BAR; PG8_MMA(0, 0, At, B0); PG8_MMA(0, 1, At, B1); PG8_BAR; PG8_SCHED;
            PG8_LDA(At, 1, 1); PG8_STAGE(PG8_SB(1, 0), b3, voffB); PG8_STAGE(PG8_SB(1, 1), b3 + hstepB, voffB); PG8_STAGE(PG8_SA(1, 0), a3, voffA);
            PG8_WAIT_V(8); PG8_WAIT_L(0); PG8_BAR; PG8_MMA(1, 0, At, B0); PG8_MMA(1, 1, At, B1); PG8_BAR; PG8_SCHED;
        }
        if constexpr (ALIGN_EPI) { if (wr == 0) PG8_BAR; }
        E(acc, cur, wr, wc, fr, fq);
        if (!has_next) break;
#pragma unroll
        for (int a = 0; a < 2; ++a)
#pragma unroll
            for (int b = 0; b < 2; ++b)
#pragma unroll
                for (int m = 0; m < 4; ++m)
#pragma unroll
                    for (int n = 0; n < 2; ++n) acc[a][b][m][n] = (f32x4){0.f, 0.f, 0.f, 0.f};
        cur = nxt; cA = nA; cB = nB; ++ui;
        if constexpr (ALIGN_EPI) { if (wr == 1) PG8_BAR; }
    }
    PG8_WAIT_V(0);
    if constexpr (!ALIGN_EPI) { if (wr == 0) PG8_BAR; }
    PG8_BAR;
#undef PG8_SA
#undef PG8_SB
#undef PG8_STAGE
#undef PG8_LDA
#undef PG8_LDB
#undef PG8_MMA
#undef PG8_WAIT_V
#undef PG8_WAIT_L
#undef PG8_BAR
#undef PG8_SCHED
}
}

DI void transpose_item(const float* W, int K, int N, bf16_t* WT, int sh, int add, LAS float* scr, int item, int lane, const float* gain) {
    const int nblk = N / 32, kb = item / nblk, nb = item % nblk, k0 = 64 * kb, n0 = 32 * nb;
#pragma unroll 8
    for (int i = 0; i < 32; ++i) { const int kk = 2 * i + (lane >> 5); const float gk = gain ? gain[k0 + kk] : 1.f; scr[kk * 33 + (lane & 31)] = W[(size_t)(k0 + kk) * N + n0 + (lane & 31)] * gk; }
    LDS_WAIT();
    const int c = lane & 7;
#pragma unroll
    for (int j = 0; j < 4; ++j) { const int n = (lane >> 3) + 8 * j; const LAS float* s = scr + (8 * c) * 33 + n;
        u32x4 o; o.x = pk2(s[0 * 33], s[1 * 33]); o.y = pk2(s[2 * 33], s[3 * 33]); o.z = pk2(s[4 * 33], s[5 * 33]); o.w = pk2(s[6 * 33], s[7 * 33]);
        const int cc = n0 + n, drow = ((cc >> 7) << sh) + add + (cc & 127);
        *(u32x4*)(WT + (size_t)drow * K + k0 + 8 * c) = o; }
    LDS_WAIT();
}
DI void norm_row_bf16(const float* xrow, const float* gain, bf16_t* orow, int lane) {
    const f32x4* xr = (const f32x4*)xrow + lane;
    f32x4 v[8]; float s = 0.f;
#pragma unroll
    for (int j = 0; j < 8; ++j) { v[j] = xr[64 * j]; s += (v[j].x * v[j].x + v[j].y * v[j].y) + (v[j].z * v[j].z + v[j].w * v[j].w); }
    const float rstd = rsqrtf(wave_sum(s) * (1.f / D) + EPS);
    u32x2* o8 = (u32x2*)orow + lane;
#pragma unroll
    for (int j = 0; j < 8; ++j) { const f32x4 gg = ((const f32x4*)gain)[lane + 64 * j]; u32x2 w; w.x = pk2(v[j].x * rstd * gg.x, v[j].y * rstd * gg.y); w.y = pk2(v[j].z * rstd * gg.z, v[j].w * rstd * gg.w); o8[64 * j] = w; }
}
DI void norm_row_f32(float* xrow, const float* gain, int lane) {
    f32x4* xr = (f32x4*)xrow + lane;
    f32x4 v[8]; float s = 0.f;
#pragma unroll
    for (int j = 0; j < 8; ++j) { v[j] = xr[64 * j]; s += (v[j].x * v[j].x + v[j].y * v[j].y) + (v[j].z * v[j].z + v[j].w * v[j].w); }
    const float rstd = rsqrtf(wave_sum(s) * (1.f / D) + EPS);
#pragma unroll
    for (int j = 0; j < 8; ++j) { const f32x4 gg = ((const f32x4*)gain)[lane + 64 * j]; xr[64 * j] = v[j] * rstd * gg; }
}

DI void feed_row(const float* xrow, bf16_t* orow, float* ssp, int lane) {
    const f32x4* xr = (const f32x4*)xrow + lane;
    f32x4 v[8]; float s = 0.f;
#pragma unroll
    for (int j = 0; j < 8; ++j) { v[j] = xr[64 * j]; s += (v[j].x * v[j].x + v[j].y * v[j].y) + (v[j].z * v[j].z + v[j].w * v[j].w); }
    s = wave_sum(s);
    u32x2* o8 = (u32x2*)orow + lane;
#pragma unroll
    for (int j = 0; j < 8; ++j) { u32x2 w; w.x = pk2(v[j].x, v[j].y); w.y = pk2(v[j].z, v[j].w); o8[64 * j] = w; }
    if (lane == 0) *ssp = s;
}

DI void attn_load_q(bf16x8 (&qf)[2][4], const bf16_t* Qp, int ldq, int nqg, const float* qgain, int fr, int fq) {
#pragma unroll
    for (int g = 0; g < 2; ++g) {
        if (g < nqg) {
            const bf16_t* qrow = Qp + (size_t)(g * 16 + fr) * ldq + fq * 8;
            float qv[4][8]; float ss = 0.f;
#pragma unroll
            for (int s = 0; s < 4; ++s) { unpack8(*(const u32x4*)(qrow + s * 32), qv[s]);
#pragma unroll
                for (int e = 0; e < 8; ++e) ss += qv[s][e] * qv[s][e]; }
            ss += __shfl_xor(ss, 16); ss += __shfl_xor(ss, 32);
            const float rs = rsqrtf(ss * (1.f / 128.f) + EPS) * (0.08838834764831845f * LOG2E);
#pragma unroll
            for (int s = 0; s < 4; ++s) { const f32x4 g0 = *(const f32x4*)(qgain + s * 32 + fq * 8), g1 = *(const f32x4*)(qgain + s * 32 + fq * 8 + 4);
                float t[8];
#pragma unroll
                for (int e = 0; e < 4; ++e) { t[e] = qv[s][e] * rs * g0[e]; t[4 + e] = qv[s][4 + e] * rs * g1[e]; }
                qf[g][s] = __builtin_bit_cast(bf16x8, pack8(t)); }
        } else {
#pragma unroll
            for (int s = 0; s < 4; ++s) qf[g][s] = (bf16x8){0, 0, 0, 0, 0, 0, 0, 0};
        }
    }
}
template <bool BIAS>
DI void attn_tile(const bf16x8 (&kf)[2][4], const bf16x8 (&vf)[8], const bf16x8 (&qf)[2][4], f32x4 (&o)[2][8], float (&mrun)[2], float (&lrun)[2],
                  int nqg, const LAS float* tbl, int idx0, bool tail, int kpos0, int nvalid) {
    f32x4 st[2][2];
#pragma unroll
    for (int g = 0; g < 2; ++g)
#pragma unroll
        for (int hh = 0; hh < 2; ++hh) { st[g][hh] = (f32x4){0.f, 0.f, 0.f, 0.f};
#pragma unroll
            for (int s = 0; s < 4; ++s) st[g][hh] = __builtin_amdgcn_mfma_f32_16x16x32_bf16(kf[hh][s], qf[g][s], st[g][hh], 0, 0, 0); }
#pragma unroll
    for (int g = 0; g < 2; ++g) {
        if (g < nqg) {
            float sv[8];
#pragma unroll
            for (int e = 0; e < 4; ++e) { sv[e] = st[g][0][e]; sv[4 + e] = st[g][1][e]; }
            if (BIAS) {
#pragma unroll
                for (int e = 0; e < 8; ++e) sv[e] += tbl[idx0 + g * 16 - e]; }
            if (tail) {
#pragma unroll
                for (int e = 0; e < 8; ++e) if (kpos0 + e >= nvalid) sv[e] = -1e30f; }
            float tmax = fmaxf(fmaxf(fmaxf(sv[0], sv[1]), fmaxf(sv[2], sv[3])), fmaxf(fmaxf(sv[4], sv[5]), fmaxf(sv[6], sv[7])));
            tmax = fmaxf(tmax, __shfl_xor(tmax, 16)); tmax = fmaxf(tmax, __shfl_xor(tmax, 32));
            const float mn = fmaxf(mrun[g], tmax), alpha = fast_exp2(mrun[g] - mn); mrun[g] = mn;
            float pv[8], ps = 0.f;
#pragma unroll
            for (int e = 0; e < 8; ++e) { pv[e] = fast_exp2(sv[e] - mn); ps += pv[e]; }
            lrun[g] = lrun[g] * alpha + ps;
            const bf16x8 pf = __builtin_bit_cast(bf16x8, pack8(pv));
#pragma unroll
            for (int dt = 0; dt < 8; ++dt) { o[g][dt] = o[g][dt] * alpha; o[g][dt] = __builtin_amdgcn_mfma_f32_16x16x32_bf16(vf[dt], pf, o[g][dt], 0, 0, 0); }
        }
    }
}
DI void attn_store_o(const f32x4 (&o)[2][8], const float (&lrun)[2], bf16_t* Op, int ldo, int nqg, int fr, int fq) {
#pragma unroll
    for (int g = 0; g < 2; ++g) {
        if (g < nqg) {
            float lt = lrun[g]; lt += __shfl_xor(lt, 16); lt += __shfl_xor(lt, 32);
            const float inv = 1.0f / lt;
            bf16_t* orow = Op + (size_t)(g * 16 + fr) * ldo + fq * 4;
#pragma unroll
            for (int dt = 0; dt < 8; ++dt) { u32x2 w; w.x = pk2(o[g][dt][0] * inv, o[g][dt][1] * inv); w.y = pk2(o[g][dt][2] * inv, o[g][dt][3] * inv); *(u32x2*)(orow + dt * 16) = w; }
        }
    }
}
template <bool BIAS>
DI void attn_task(const bf16_t* Qp, int ldq, bf16_t* Op, int ldo, const bf16_t* Kp, int ldk, const bf16_t* Vtp, int ldv,
                  int nkt, int nvalid, int nqg, const float* qgain, const LAS float* tbl, int dbase, int lane) {
    const int fr = lane & 15, fq = lane >> 4;
    bf16x8 qf[2][4];
    attn_load_q(qf, Qp, ldq, nqg, qgain, fr, fq);
    f32x4 o[2][8];
#pragma unroll
    for (int g = 0; g < 2; ++g)
#pragma unroll
        for (int dt = 0; dt < 8; ++dt) o[g][dt] = (f32x4){0.f, 0.f, 0.f, 0.f};
    float mrun[2] = {-1e30f, -1e30f}, lrun[2] = {0.f, 0.f};
    const bf16_t* kb0 = Kp + (size_t)((fr >> 2) * 8 + (fr & 3)) * ldk + fq * 8;
    const bf16_t* vb0 = Vtp + (size_t)fr * ldv + fq * 8;
#pragma unroll 1
    for (int kt = 0; kt < nkt; ++kt) {
        const bf16_t* kb = kb0 + (size_t)kt * 32 * ldk;
        bf16x8 kf[2][4];
#pragma unroll
        for (int hh = 0; hh < 2; ++hh)
#pragma unroll
            for (int s = 0; s < 4; ++s) kf[hh][s] = *(const bf16x8*)(kb + (size_t)hh * 4 * ldk + s * 32);
        bf16x8 vf[8];
#pragma unroll
        for (int dt = 0; dt < 8; ++dt) vf[dt] = *(const bf16x8*)(vb0 + (size_t)dt * 16 * ldv + kt * 32);
        attn_tile<BIAS>(kf, vf, qf, o, mrun, lrun, nqg, tbl, dbase + fr - kt * 32 - fq * 8, kt * 32 + 32 > nvalid, kt * 32 + fq * 8, nvalid);
    }
    attn_store_o(o, lrun, Op, ldo, nqg, fr, fq);
}
constexpr int AT_TBL = 0, AT_K = 4096, AT_KB = 32 * 272, AT_V = AT_K + 2 * AT_KB, AT_VB = 128 * 80;
DI void attn_wg_prompt(const Params& p, LAS unsigned char* lds, int b, int h, int cg, bf16_t* obase, int ldo, int ocol, int tid) {
    const int lane = tid & 63, wave = __builtin_amdgcn_readfirstlane(tid >> 6), fr = lane & 15, fq = lane >> 4;
    const int c = cg * 4 + (wave >> 1), half = wave & 1;
    const bf16_t* Ub = (const bf16_t*)(p.ws + W_U); const bf16_t* Vtg = (const bf16_t*)(p.ws + W_VT);
    LAS float* tbl = (LAS float*)(lds + AT_TBL);
    __syncthreads();
    for (int i = tid; i < 640; i += NWAVES * 64) { int d = i - 63; d = d < -256 ? -256 : (d > 256 ? 256 : d); tbl[i] = p.in[17][h * 513 + d + 256] * LOG2E; }
    const size_t qrow0 = (size_t)b * TSEQ + c * 64 + half * 32;
    bf16x8 qf[2][4];
    attn_load_q(qf, Ub + qrow0 * NU + OQ + h * 128, NU, 2, p.in[15], fr, fq);
    f32x4 o[2][8];
#pragma unroll
    for (int g = 0; g < 2; ++g)
#pragma unroll
        for (int dt = 0; dt < 8; ++dt) o[g][dt] = (f32x4){0.f, 0.f, 0.f, 0.f};
    float mrun[2] = {-1e30f, -1e30f}, lrun[2] = {0.f, 0.f};
    const int key_lo = (cg * 4 - 8) * 64 > 0 ? (cg * 4 - 8) * 64 : 0, nkt = ((cg * 4 + 4) * 64 - key_lo) / 32;
    const bf16_t* kg = Ub + ((size_t)b * TSEQ + key_lo + (tid >> 4)) * NU + OKK + h * 128 + (tid & 15) * 8;
    const bf16_t* vg = Vtg + ((size_t)(b * 8 + h) * 128 + (tid >> 2)) * TSEQ + key_lo + (tid & 3) * 8;
    const unsigned kw = (unsigned)(tid >> 4) * 272u + (unsigned)(tid & 15) * 16u, vw = (unsigned)(tid >> 2) * 80u + (unsigned)(tid & 3) * 16u;
    const unsigned kroff = (unsigned)((fr >> 2) * 8 + (fr & 3)) * 272u + (unsigned)fq * 16u, vroff = (unsigned)fr * 80u + (unsigned)fq * 16u;
    const int dbase = c * 64 + half * 32 - key_lo + 63;
    u32x4 kr = *(const u32x4*)kg, vr = *(const u32x4*)vg;
#pragma unroll 1
    for (int kt = 0; kt < nkt; ++kt) {
        const int buf = kt & 1;
        *(LAS u32x4*)(lds + AT_K + buf * AT_KB + kw) = kr; *(LAS u32x4*)(lds + AT_V + buf * AT_VB + vw) = vr;
        if (kt + 1 < nkt) { kr = *(const u32x4*)(kg + (size_t)(kt + 1) * 32 * NU); vr = *(const u32x4*)(vg + (kt + 1) * 32); }
        __syncthreads();
        const int kc = (key_lo + kt * 32) >> 6;
        if (kc >= c - 8 && kc <= c) {
            bf16x8 kf[2][4], vf[8];
#pragma unroll
            for (int hh = 0; hh < 2; ++hh)
#pragma unroll
                for (int s = 0; s < 4; ++s) kf[hh][s] = *(const LAS bf16x8*)(lds + AT_K + buf * AT_KB + kroff + hh * (4 * 272) + s * 64);
#pragma unroll
            for (int dt = 0; dt < 8; ++dt) vf[dt] = *(const LAS bf16x8*)(lds + AT_V + buf * AT_VB + vroff + dt * (16 * 80));
            attn_tile<true>(kf, vf, qf, o, mrun, lrun, 2, tbl, dbase + fr - kt * 32 - fq * 8, false, 0, 0);
        }
    }
    attn_store_o(o, lrun, obase + qrow0 * ldo + ocol + h * 128, ldo, 2, fr, fq);
}

constexpr int LT_OFF = 98304, LT_WG = 64 * 144, LT_PAR = 2 * LT_WG;
DI void lru_tables_to_lds(const Params& p, LAS unsigned char* lt, int nblk, int tid) {
    const bf16_t* Wt = (const bf16_t*)(p.ws + W_LRU);
    for (int i = tid; i < 2 * 64 * 8; i += NWAVES * 64) { const int g = i >> 9, row = (i >> 3) & 63, seg = i & 7;
        *(LAS u32x4*)(lt + g * LT_WG + row * 144 + seg * 16) = *(const u32x4*)(Wt + (size_t)g * 65536 + (size_t)(nblk * 64 + row) * 64 + seg * 8); }
    for (int i = tid; i < 512; i += NWAVES * 64) { const int k = i >> 6, ch = nblk * 64 + (i & 63);
        const float v = k < 4 ? p.in[18][k * 1024 + ch] : (k == 4 ? p.in[19][ch] : (k == 5 ? p.in[21][ch] : (k == 6 ? p.in[23][ch] : ((const float*)(p.ws + W_C8))[ch])));
        ((LAS float*)(lt + LT_PAR))[i] = v; }
    __syncthreads();
}
template <int PASS>
DI void lru_unit(const Params& p, int seq, int chunk, int nblk, int lane, bf16_t* obase, unsigned opitch, unsigned ocol, const LAS unsigned char* lt) {
    unsigned char* ws = p.ws;
    const char* Ub = (const char*)(ws + W_U);
    const LAS float* par = (const LAS float*)(lt + LT_PAR);
    float* cA = (float*)(ws + W_CA); float* cB = (float*)(ws + W_CB);
    const bool is_s = seq >= NBATCH;
    const int sb = seq - NBATCH;
    const unsigned row0 = is_s ? (unsigned)MP + (unsigned)sb * STOK : (unsigned)seq * TSEQ;
    const int t0 = is_s ? 0 : chunk * 64, ntt = is_s ? 1 : 4;
    float hc[2][8], arun[2][8];
#pragma unroll
    for (int ks = 0; ks < 2; ++ks)
#pragma unroll
        for (int e = 0; e < 8; ++e) { hc[ks][e] = 0.f; arun[ks][e] = 1.f; }
    if (PASS == 1) {
        float H;
        if (is_s) H = p.in[5][(size_t)sb * 1024 + nblk * 64 + lane];
        else { H = 0.f;
            const float* pa = cA + (size_t)seq * 64 * 1024 + nblk * 64 + lane; const float* pb = cB + (size_t)seq * 64 * 1024 + nblk * 64 + lane;
            for (int c2 = 0; c2 < chunk; c2 += 8) {
                float ta[8], tb[8];
#pragma unroll
                for (int j = 0; j < 8; ++j) { const int cc = (c2 + j < chunk) ? c2 + j : chunk - 1; ta[j] = pa[(size_t)cc * 1024]; tb[j] = pb[(size_t)cc * 1024]; }
#pragma unroll
                for (int j = 0; j < 8; ++j) if (c2 + j < chunk) H = ta[j] * H + tb[j];
            } }
        const int fq0 = lane >> 4;
#pragma unroll
        for (int ks = 0; ks < 2; ++ks)
#pragma unroll
            for (int e = 0; e < 8; ++e) hc[ks][e] = __shfl(H, ks * 32 + fq0 * 8 + e);
    }
#pragma unroll 1
    for (int tt = 0; tt < ntt; ++tt) {
        int lo = lane; asm volatile("" : "+v"(lo) :: "memory");
        const int fr = lo & 15, fq = lo >> 4;
        const int t = t0 + tt * 16 + fr;
        const unsigned chb0 = (unsigned)(nblk * 64 + fq * 8);
        float xc[2][8]; bf16x8 xf[2];
#pragma unroll
        for (int ks = 0; ks < 2; ++ks) {
            const unsigned chb = chb0 + ks * 32;
            const int chl = ks * 32 + fq * 8;
            const f32x4 b0 = *(const LAS f32x4*)(par + 4 * 64 + chl), b1 = *(const LAS f32x4*)(par + 4 * 64 + chl + 4);
#pragma unroll
            for (int e = 0; e < 4; ++e) { xc[ks][e] = b0[e]; xc[ks][4 + e] = b1[e]; }
#pragma unroll
            for (int j = 0; j < 4; ++j) {
                const int tj = t - 3 + j;
                float xv[8];
                if (tj >= 0) unpack8(*(const u32x4*)(Ub + ((row0 + (unsigned)tj) * (unsigned)NU + OXR + chb) * 2u), xv);
                else if (is_s) { const char* sp = (const char*)p.in[4] + (((unsigned)sb * 3u + (unsigned)(3 + tj)) * 1024u + chb) * 4u; const f32x4 s0 = *(const f32x4*)sp, s1 = *(const f32x4*)(sp + 16);
#pragma unroll
                    for (int e = 0; e < 4; ++e) { xv[e] = s0[e]; xv[4 + e] = s1[e]; } }
                else {
#pragma unroll
                    for (int e = 0; e < 8; ++e) xv[e] = 0.f; }
                const f32x4 w0 = *(const LAS f32x4*)(par + j * 64 + chl), w1 = *(const LAS f32x4*)(par + j * 64 + chl + 4);
#pragma unroll
                for (int e = 0; e < 4; ++e) { xc[ks][e] += w0[e] * xv[e]; xc[ks][4 + e] += w1[e] * xv[4 + e]; }
            }
            xf[ks] = __builtin_bit_cast(bf16x8, pack8(xc[ks]));
        }
        float av[2][8], bv[2][8];
        const unsigned wbase = (unsigned)((fr >> 2) * 8 + (fr & 3)) * 144u + (unsigned)fq * 16u;
#pragma unroll
        for (int ct = 0; ct < 4; ++ct) {
            const int ks = ct >> 1, hq = ct & 1;
            const unsigned woff = wbase + (unsigned)((ks * 32 + hq * 4) * 144);
            f32x4 aa = (f32x4){0.f, 0.f, 0.f, 0.f}, ax = (f32x4){0.f, 0.f, 0.f, 0.f};
#pragma unroll
            for (int k2 = 0; k2 < 2; ++k2) {
                const bf16x8 wa = *(const LAS bf16x8*)(lt + woff + k2 * 64u), wx = *(const LAS bf16x8*)(lt + LT_WG + woff + k2 * 64u);
                aa = __builtin_amdgcn_mfma_f32_16x16x32_bf16(wa, xf[k2], aa, 0, 0, 0);
                ax = __builtin_amdgcn_mfma_f32_16x16x32_bf16(wx, xf[k2], ax, 0, 0, 0); }
            const int chq = ks * 32 + fq * 8 + hq * 4;
            const f32x4 ba4 = *(const LAS f32x4*)(par + 5 * 64 + chq), bx4 = *(const LAS f32x4*)(par + 6 * 64 + chq), c84 = *(const LAS f32x4*)(par + 7 * 64 + chq);
#pragma unroll
            for (int j = 0; j < 4; ++j) {
                const int e = hq * 4 + j;
                const float r = sigmoidf_(aa[j] + ba4[j]), ig = sigmoidf_(ax[j] + bx4[j]);
                const float a = fast_exp2(c84[j] * r);
                av[ks][e] = a; bv[ks][e] = sqrtf(fmaxf(1.0f - a * a, 0.f)) * ig * xc[ks][e];
            }
        }
#pragma unroll
        for (int ks = 0; ks < 2; ++ks)
#pragma unroll
            for (int e = 0; e < 8; ++e) {
                float a = av[ks][e], b = bv[ks][e], pa, pb;
                pa = dpp_shr<1>(1.f, a); pb = dpp_shr<1>(0.f, b); b = a * pb + b; a = a * pa;
                pa = dpp_shr<2>(1.f, a); pb = dpp_shr<2>(0.f, b); b = a * pb + b; a = a * pa;
                pa = dpp_shr<4>(1.f, a); pb = dpp_shr<4>(0.f, b); b = a * pb + b; a = a * pa;
                pa = dpp_shr<8>(1.f, a); pb = dpp_shr<8>(0.f, b); b = a * pb + b; a = a * pa;
                const float h = a * hc[ks][e] + b;
                bv[ks][e] = h; av[ks][e] = a;
            }
        const int l15 = (lo & 48) | 15;
        if (PASS == 1) {
#pragma unroll
            for (int ks = 0; ks < 2; ++ks) {
                const unsigned chb = chb0 + ks * 32;
                const char* gp = Ub + ((row0 + (unsigned)t) * (unsigned)NU + OGR + chb) * 2u;
                char* op = (char*)obase + ((row0 + (unsigned)t) * opitch + ocol + chb) * 2u;
                float gv[8], ov[8]; unpack8(*(const u32x4*)gp, gv);
#pragma unroll
                for (int e = 0; e < 8; ++e) { const float x = gv[e]; const float u2 = 1.5957691216057308f * (x + 0.044715f * x * x * x); ov[e] = x * fast_rcp(1.0f + fast_exp2(-u2 * LOG2E)) * bv[ks][e]; }
                *(u32x4*)op = pack8(ov);
                if (fr == 15 && tt == ntt - 1 && (is_s || chunk == 63)) {
                    float* lo2 = p.out + (is_s ? O_LS + (size_t)sb * 1024 : O_LP + (size_t)seq * 1024) + chb;
                    *(f32x4*)lo2 = (f32x4){bv[ks][0], bv[ks][1], bv[ks][2], bv[ks][3]}; *(f32x4*)(lo2 + 4) = (f32x4){bv[ks][4], bv[ks][5], bv[ks][6], bv[ks][7]};
                }
#pragma unroll
                for (int e = 0; e < 8; ++e) hc[ks][e] = __shfl(bv[ks][e], l15);
            }
        } else {
#pragma unroll
            for (int ks = 0; ks < 2; ++ks)
#pragma unroll
                for (int e = 0; e < 8; ++e) { hc[ks][e] = __shfl(bv[ks][e], l15); arun[ks][e] *= __shfl(av[ks][e], l15); }
        }
    }
    if (PASS == 0 && (lane & 15) == 0) {
        const int fq = lane >> 4;
#pragma unroll
        for (int ks = 0; ks < 2; ++ks) { const size_t o = ((size_t)seq * 64 + chunk) * 1024 + nblk * 64 + ks * 32 + fq * 8;
            *(f32x4*)(cA + o) = (f32x4){arun[ks][0], arun[ks][1], arun[ks][2], arun[ks][3]}; *(f32x4*)(cA + o + 4) = (f32x4){arun[ks][4], arun[ks][5], arun[ks][6], arun[ks][7]};
            *(f32x4*)(cB + o) = (f32x4){hc[ks][0], hc[ks][1], hc[ks][2], hc[ks][3]}; *(f32x4*)(cB + o + 4) = (f32x4){hc[ks][4], hc[ks][5], hc[ks][6], hc[ks][7]}; }
    }
}


#define XB_TMO      128
#define XB_XCNT(j)  (256  + 64 * (j))
#define XB_XSUB(j)  (1280 + 64 * (j))
#define XB_XGEN(j)  (2304 + 64 * (j))
#define XB_TOP      3328
#define XB_TOPGEN   3392
#define XCD_BAR_WORDS 3456
#define XB_SPIN_CAP (1u << 18)
DI unsigned xb_ld(unsigned* p)              { return __hip_atomic_load(p, __ATOMIC_RELAXED, __HIP_MEMORY_SCOPE_AGENT); }
DI unsigned xb_add(unsigned* p, unsigned v) { return __hip_atomic_fetch_add(p, v, __ATOMIC_RELAXED, __HIP_MEMORY_SCOPE_AGENT); }
DI unsigned xb_xcc_id() { return (unsigned)__builtin_amdgcn_s_getreg((3 << 11) | 20) & 0xFu; }
#define XB_SPIN(cond, bar) do { unsigned _sp = 0; while (cond) { __builtin_amdgcn_s_sleep(1); \
    if ((++_sp & 255u) == 0u) { if (xb_ld(&(bar)[XB_TMO])) break; if (_sp > XB_SPIN_CAP) { atomicAdd(&(bar)[XB_TMO], 1u); break; } } } } while (0)
struct XcdBarrier { unsigned* bar; unsigned x; volatile LAS unsigned* st; };
DI XcdBarrier xcd_barrier_post(unsigned* bar, volatile LAS unsigned* st) {
    XcdBarrier b; b.bar = bar; b.x = xb_xcc_id(); b.st = st;
    if (threadIdx.x == 0) (void)xb_add(&bar[XB_XCNT(b.x)], 1u);
    return b;
}
DI void xcd_barrier_complete(unsigned* bar, unsigned x, unsigned& nloc, unsigned& nx) {
    const unsigned G = gridDim.x * gridDim.y * gridDim.z;
    unsigned sum, cnt, mine, sp = 0u;
    for (;;) {
        sum = 0u; cnt = 0u; mine = 0u;
#pragma unroll
        for (unsigned j = 0; j < 16; ++j) { const unsigned c = xb_ld(&bar[XB_XCNT(j)]); sum += c; cnt += (c > 0u) ? 1u : 0u; mine = (j == x) ? c : mine; }
        if (sum == G) break;
        __builtin_amdgcn_s_sleep(1);
        if ((++sp & 255u) == 0u) { if (xb_ld(&bar[XB_TMO])) break; if (sp > XB_SPIN_CAP) { atomicAdd(&bar[XB_TMO], 1u); break; } }
    }
    nloc = mine > 0u ? mine : 1u; nx = cnt > 0u ? cnt : 1u;
}
DI void xcd_barrier(const XcdBarrier& b) {
    asm volatile("s_waitcnt vmcnt(0)" ::: "memory");
    __syncthreads();
    if (threadIdx.x == 0) {
        unsigned* bar = b.bar;
        __builtin_amdgcn_s_waitcnt(0);
        unsigned nloc = b.st[0], nx = b.st[1];
        if (nloc == 0u) { xcd_barrier_complete(bar, b.x, nloc, nx); b.st[0] = nloc; b.st[1] = nx; }
        const unsigned old = xb_add(&bar[XB_XSUB(b.x)], 1u);
        const unsigned gen = old / nloc;
        if (old + 1u == (gen + 1u) * nloc) {
            __builtin_amdgcn_fence(__ATOMIC_RELEASE, "agent");
            asm volatile("s_waitcnt vmcnt(0)" ::: "memory");
            const unsigned og = xb_add(&bar[XB_TOP], 1u);
            const unsigned tg = og / nx;
            if (og + 1u == (tg + 1u) * nx) xb_add(&bar[XB_TOPGEN], 1u);
            else XB_SPIN(xb_ld(&bar[XB_TOPGEN]) == tg, bar);
            __builtin_amdgcn_fence(__ATOMIC_ACQUIRE, "agent");
            xb_add(&bar[XB_XGEN(b.x)], 1u);
            asm volatile("s_waitcnt vmcnt(0)" ::: "memory");
        } else {
            XB_SPIN(xb_ld(&bar[XB_XGEN(b.x)]) == gen, bar);
            __builtin_amdgcn_fence(__ATOMIC_ACQUIRE, "agent");
            asm volatile("s_waitcnt vmcnt(0)" ::: "memory");
        }
    }
    __syncthreads();
}

__global__ void __launch_bounds__(NWAVES * 64, 2) fwd_megakernel(Params p) {
    extern __shared__ __attribute__((aligned(16))) unsigned char lds_raw[];
    cg::grid_group grid = cg::this_grid();
    LAS unsigned char* lds = (LAS unsigned char*)lds_raw;
#define PH_IDS int tid = threadIdx.x; asm volatile("" : "+v"(tid)); const int lane = tid & 63, wave = __builtin_amdgcn_readfirstlane(tid >> 6); \
    const int G = gridDim.x, gw = blockIdx.x * NWAVES + wave, NGW = G * NWAVES; (void)lane; (void)gw; (void)NGW; (void)G
    unsigned char* ws = p.ws;
    float* R = p.out;
    bf16_t* XN = (bf16_t*)(ws + W_XN); bf16_t* U = (bf16_t*)(ws + W_U); bf16_t* H = (bf16_t*)(ws + W_H);
    bf16_t* Vt = (bf16_t*)(ws + W_VT); bf16_t* Ks = (bf16_t*)(ws + W_KS); bf16_t* Vts = (bf16_t*)(ws + W_VTS);
    bf16_t* Km = (bf16_t*)(ws + W_KM); bf16_t* Vtm = (bf16_t*)(ws + W_VTM);
    bf16_t* MN = (bf16_t*)(ws + W_MN); float* MKVF = (float*)(ws + W_MKVF); bf16_t* MQ = (bf16_t*)(ws + W_MQB);

    for (int rep_ = 0; rep_ < 1 + ((REPM >> 0) & 1); ++rep_) { if (rep_) grid.sync(); PH_IDS;
        if (blockIdx.x == 0) for (int i = tid; i < 4096; i += NWAVES * 64) ((unsigned*)(ws + W_BAR))[i] = 0u;
        if (tid < 2) ((volatile LAS unsigned*)(lds + 131072 + 64))[tid] = 0u;
        LAS float* scr = (LAS float*)(lds + wave * 16384);
        constexpr int I_FU = (D / 64) * (FF / 32), I_FD = (FF / 64) * (D / 32), I_IN = (D / 64) * (NU / 32), I_P = (1024 / 64) * (D / 32), I_O = (D / 64) * (D / 32),
                      I_M = (D / 64) * (512 / 32), I_MO = (512 / 64) * (D / 32);
        constexpr int NITEMS = 4 * I_FU + 2 * I_FD + I_IN + 2 * I_P + I_O + 3 * I_M + I_MO;
        for (int it = gw; it < NITEMS; it += NGW) {
            int r = it;
#define TJ(IDX, KK, NN, OFF, SH, ADD, NI, GN) if (r < (NI)) { transpose_item(p.in[IDX], KK, NN, (bf16_t*)(ws + (OFF)), SH, ADD, scr, r, lane, GN); continue; } r -= (NI);
            TJ(10, D, FF, W_GU1, 8, 0, I_FU, nullptr) TJ(11, D, FF, W_GU1, 8, 128, I_FU, nullptr) TJ(12, FF, D, W_D1, 7, 0, I_FD, nullptr)
            TJ(37, D, FF, W_GU2, 8, 0, I_FU, p.in[36]) TJ(38, D, FF, W_GU2, 8, 128, I_FU, p.in[36]) TJ(39, FF, D, W_D2, 7, 0, I_FD, nullptr)
            TJ(14, D, NU, W_IN, 7, 0, I_IN, p.in[13]) TJ(25, 1024, D, W_PA, 7, 0, I_P, nullptr) TJ(26, 1024, D, W_PB, 7, 0, I_P, nullptr) TJ(27, D, D, W_OUT, 7, 0, I_O, nullptr)
            TJ(30, D, 512, W_MQ, 7, 0, I_M, p.in[28]) TJ(31, D, 512, W_MKV, 7, 0, I_M, nullptr) TJ(32, D, 512, W_MKV, 7, 512, I_M, nullptr)
            transpose_item(p.in[35], 512, D, (bf16_t*)(ws + W_MO), 7, 0, scr, r, lane, nullptr);
#undef TJ
        }
        for (int m = gw; m < MT; m += NGW) norm_row_bf16(m < MP ? p.in[0] + (size_t)m * D : p.in[1] + (size_t)(m - MP) * D, p.in[9], XN + (size_t)m * D, lane);
        for (int m = gw; m < 2048; m += NGW) norm_row_bf16(p.in[8] + (size_t)m * D, p.in[29], MN + (size_t)m * D, lane);
        {
            bf16_t* Wt = (bf16_t*)(ws + W_LRU); float* c8 = (float*)(ws + W_C8);
            for (int i = blockIdx.x * 512 + tid; i < 2 * 65536; i += G * 512) { const int gsel = i >> 16, n = (i >> 12) & 15, c = (i >> 6) & 63, k = i & 63;
                const float v = p.in[gsel ? 22 : 20][n * 4096 + k * 64 + c]; Wt[i] = (bf16_t)(pk2(v, 0.f) & 0xffffu); }
            for (int i = blockIdx.x * 512 + tid; i < 1024; i += G * 512) c8[i] = -8.0f * log1pf(expf(-p.in[24][i])) * LOG2E;
            float* ssz = (float*)(ws + W_SS);
            for (int i = blockIdx.x * 512 + tid; i < 3 * MT; i += G * 512) ssz[i] = 0.f;
            for (int i = blockIdx.x * 512 + tid; i < MS * D / 4; i += G * 512) ((f32x4*)(R + (size_t)MP * D))[i] = ((const f32x4*)p.in[1])[i];
        }
    }
    grid.sync();
    XcdBarrier xbar = xcd_barrier_post((unsigned*)(p.ws + W_BAR), (volatile LAS unsigned*)(lds + 131072 + 64));

    for (int rr = 0; rr < ((REPM >> 18) & 1) * 20; ++rr) grid.sync();
    for (int rep_ = 0; rep_ < 1 + ((REPM >> 1) & 1); ++rep_) { if (rep_) grid.sync(); PH_IDS;
        pg8::Gemm g{XN, (const bf16_t*)(ws + W_GU1), MT, 2 * FF, D, D, D}; pg8::StaticOrder S; S.init(MT, 2 * FF, G, (int)blockIdx.x);
        pg8::EpiSwiglu E{H, FF, nullptr};
        pg8::gemm_phase<pg8::EpiSwiglu, true>(lds, g, S, E, STAG);
        pg8::Gemm g2{MN, (const bf16_t*)(ws + W_MKV), 2048, 1024, D, D, D}; pg8::StaticOrder S2; S2.init(2048, 1024, G, (int)((blockIdx.x + 128) % G));
        pg8::EpiF32 E2{MKVF, 1024};
        pg8::gemm_phase<pg8::EpiF32, true>(lds, g2, S2, E2);
    }
    xcd_barrier(xbar);

    for (int rep_ = 0; rep_ < 1 + ((REPM >> 2) & 1); ++rep_) { if (rep_) grid.sync(); PH_IDS;
        pg8::Gemm g{H, (const bf16_t*)(ws + W_D1), MP, D, FF, FF, FF}; pg8::StaticOrder S; S.init(MP, D, G, (int)blockIdx.x);
        pg8::EpiResid E{R, p.in[0], p.in[1], XN, (float*)(ws + W_SS), 0.5f};
        pg8::gemm_phase<pg8::EpiResid, true>(lds, g, S, E, STAG);
        pg8::Gemm gs{H + (size_t)MP * FF, (const bf16_t*)(ws + W_D1), MS, D, FF, FF, FF / 4}; pg8::SplitOrder Ss; Ss.init(MS, D, 4, G, (int)blockIdx.x);
        pg8::EpiResidAtomic Es{R + (size_t)MP * D, 0.5f};
        pg8::gemm_phase<pg8::EpiResidAtomic, true>(lds, gs, Ss, Es);
    }
    xcd_barrier(xbar);

    for (int rep_ = 0; rep_ < 1 + ((REPM >> 3) & 1); ++rep_) { if (rep_) grid.sync(); PH_IDS;
        for (int m = MP + gw; m < MT; m += NGW) feed_row(R + (size_t)m * D, XN + (size_t)m * D, (float*)(ws + W_SS) + m, lane);
        for (int r = gw; r < 2048; r += NGW) {
            const float* src = MKVF + (size_t)r * 1024 + lane * 8;
            const f32x4 k0 = *(const f32x4*)src, k1 = *(const f32x4*)(src + 4), v0 = *(const f32x4*)(src + 512), v1 = *(const f32x4*)(src + 516);
            float ss = (k0.x * k0.x + k0.y * k0.y + k0.z * k0.z + k0.w * k0.w) + (k1.x * k1.x + k1.y * k1.y + k1.z * k1.z + k1.w * k1.w);
            ss += __shfl_xor(ss, 1); ss += __shfl_xor(ss, 2); ss += __shfl_xor(ss, 4); ss += __shfl_xor(ss, 8);
            const float rs = rsqrtf(ss * (1.f / 128.f) + EPS);
            const f32x4 g0 = *(const f32x4*)(p.in[34] + (lane * 8) % 128), g1 = *(const f32x4*)(p.in[34] + (lane * 8) % 128 + 4);
            const f32x4 n0 = k0 * rs * g0, n1 = k1 * rs * g1;
            float* ko = p.out + O_MK + (size_t)r * 512 + lane * 8; *(f32x4*)ko = n0; *(f32x4*)(ko + 4) = n1;
            float* vo = p.out + O_MV + (size_t)r * 512 + lane * 8; *(f32x4*)vo = v0; *(f32x4*)(vo + 4) = v1;
            u32x4 w; w.x = pk2(n0.x, n0.y); w.y = pk2(n0.z, n0.w); w.z = pk2(n1.x, n1.y); w.w = pk2(n1.z, n1.w);
            *(u32x4*)(Km + (size_t)r * 512 + lane * 8) = w;
        }
        for (int r = gw; r < SBATCH * 256; r += NGW) {
            const float* src = p.in[6] + (size_t)r * 512 + lane * 8; const f32x4 k0 = *(const f32x4*)src, k1 = *(const f32x4*)(src + 4);
            u32x4 w; w.x = pk2(k0.x, k0.y); w.y = pk2(k0.z, k0.w); w.z = pk2(k1.x, k1.y); w.w = pk2(k1.z, k1.w);
            *(u32x4*)(Km + ((size_t)NBATCH * 256 + r) * 512 + lane * 8) = w;
        }
        for (int it = gw; it < NSEQ * 4 * 4; it += NGW) {
            const int seq = it >> 4, h = (it >> 2) & 3, j = (it & 3) * 64 + lane;
            const float* src = seq < NBATCH ? MKVF + ((size_t)seq * 256 + j) * 1024 + 512 + h * 128 : p.in[7] + (((size_t)(seq - NBATCH) * 256 + j) * 4 + h) * 128;
            bf16_t* dst = Vtm + ((size_t)(seq * 4 + h) * 128) * 256 + j;
#pragma unroll 4
            for (int dc = 0; dc < 32; ++dc) { const f32x4 v = *(const f32x4*)(src + dc * 4);
                dst[(size_t)(dc * 4 + 0) * 256] = (bf16_t)(pk2(v.x, 0.f)); dst[(size_t)(dc * 4 + 1) * 256] = (bf16_t)(pk2(v.y, 0.f));
                dst[(size_t)(dc * 4 + 2) * 256] = (bf16_t)(pk2(v.z, 0.f)); dst[(size_t)(dc * 4 + 3) * 256] = (bf16_t)(pk2(v.w, 0.f)); }
        }
    }
    xcd_barrier(xbar);

    for (int rep_ = 0; rep_ < 1 + ((REPM >> 4) & 1); ++rep_) { if (rep_) grid.sync(); PH_IDS;
        pg8::Gemm g{XN, (const bf16_t*)(ws + W_IN), MT, NU, D, D, D}; pg8::StaticOrder S; S.init(MT, NU, G, (int)blockIdx.x);
        pg8::EpiBf16 E{U, NU, (const float*)(ws + W_SS)};
        pg8::gemm_phase<pg8::EpiBf16, true>(lds, g, S, E, STAG);
    }
    xcd_barrier(xbar);

    for (int rep_ = 0; rep_ < 1 + ((REPM >> 5) & 1); ++rep_) { if (rep_) grid.sync(); PH_IDS;
        const bool dummy5 = ((REPM >> 5) & 1) && rep_ == 0;
        constexpr int T_ROWS = MT, T_VT = NBATCH * 64 * 8, T_KS = SBATCH * 512, T_VTS = SBATCH * 8 * 8, T_LRU = NBATCH * 64 * 16;
        for (int r = gw; r < T_ROWS; r += NGW) {
                const bool is_s = r >= MP; const int rs_ = r - MP;
                const int b = is_s ? (rs_ >> 4) : (r >> 12), t = is_s ? (rs_ & 15) : (r & 4095);
                bf16_t* urow = U + (size_t)r * NU;
                float kv[16], vv[16];
                { const u32x4 a = *(const u32x4*)(urow + OKK + lane * 16), c = *(const u32x4*)(urow + OKK + lane * 16 + 8);
                  float t0[8], t1[8]; unpack8(a, t0); unpack8(c, t1);
#pragma unroll
                  for (int i = 0; i < 8; ++i) { kv[i] = t0[i]; kv[8 + i] = t1[i]; } }
                { const u32x4 a = *(const u32x4*)(urow + OV + lane * 16), c = *(const u32x4*)(urow + OV + lane * 16 + 8);
                  float t0[8], t1[8]; unpack8(a, t0); unpack8(c, t1);
#pragma unroll
                  for (int i = 0; i < 8; ++i) { vv[i] = t0[i]; vv[8 + i] = t1[i]; } }
                float ss = 0.f;
#pragma unroll
                for (int i = 0; i < 16; ++i) ss += kv[i] * kv[i];
                ss += __shfl_xor(ss, 1); ss += __shfl_xor(ss, 2); ss += __shfl_xor(ss, 4);
                const float rstd = rsqrtf(ss * (1.f / 128.f) + EPS);
                const float* gp = p.in[16] + (lane * 16) % 128;
#pragma unroll
                for (int i = 0; i < 4; ++i) { const f32x4 gg = *(const f32x4*)(gp + 4 * i);
#pragma unroll
                    for (int j = 0; j < 4; ++j) kv[4 * i + j] *= rstd * gg[j]; }
                bf16_t* kd = is_s ? Ks + ((size_t)b * SKEYS + 512 + t) * 1024 + lane * 16 : (dummy5 ? XN + (size_t)r * 1024 + lane * 16 : urow + OKK + lane * 16);
                { float t0[8], t1[8];
#pragma unroll
                  for (int i = 0; i < 8; ++i) { t0[i] = kv[i]; t1[i] = kv[8 + i]; }
                  *(u32x4*)kd = pack8(t0); *(u32x4*)(kd + 8) = pack8(t1); }
                const bool wr_kv = is_s || t >= TSEQ - 512;
                if (wr_kv) {
                    const size_t ro = is_s ? (size_t)rs_ * 1024 : ((size_t)b * 512 + (t - (TSEQ - 512))) * 1024;
                    float* ko = p.out + (is_s ? O_KS : O_KP) + ro + lane * 16; float* vo = p.out + (is_s ? O_VS : O_VP) + ro + lane * 16;
#pragma unroll
                    for (int i = 0; i < 4; ++i) { *(f32x4*)(ko + 4 * i) = (f32x4){kv[4 * i], kv[4 * i + 1], kv[4 * i + 2], kv[4 * i + 3]}; *(f32x4*)(vo + 4 * i) = (f32x4){vv[4 * i], vv[4 * i + 1], vv[4 * i + 2], vv[4 * i + 3]}; }
                }
                const int tl = is_s ? STOK : TSEQ;
                if (t >= tl - 3) {
                    float xv[16];
                    { const u32x4 a = *(const u32x4*)(urow + OXR + lane * 16), c = *(const u32x4*)(urow + OXR + lane * 16 + 8);
                      float t0[8], t1[8]; unpack8(a, t0); unpack8(c, t1);
#pragma unroll
                      for (int i = 0; i < 8; ++i) { xv[i] = t0[i]; xv[8 + i] = t1[i]; } }
                    float* co = p.out + (is_s ? O_CS : O_CP) + ((size_t)b * 3 + (t - (tl - 3))) * 1024 + lane * 16;
#pragma unroll
                    for (int i = 0; i < 4; ++i) *(f32x4*)(co + 4 * i) = (f32x4){xv[4 * i], xv[4 * i + 1], xv[4 * i + 2], xv[4 * i + 3]};
                }
                if (is_s) {
                    const int h = lane >> 3, d0 = (lane & 7) * 16;
                    bf16_t* dst = Vts + ((size_t)(b * 8 + h) * 128 + d0) * SKEYS + 512 + t;
#pragma unroll
                    for (int i = 0; i < 16; ++i) dst[(size_t)i * SKEYS] = (bf16_t)pk2(vv[i], 0.f);
                }


        }
        for (int r = gw; r < T_VT; r += NGW) {
                const int b = r >> 9, c = (r >> 3) & 63, h = r & 7, t = c * 64 + lane;
                const bf16_t* src = U + ((size_t)b * TSEQ + t) * NU + OV + h * 128;
                bf16_t* dst = Vt + ((size_t)(b * 8 + h) * 128) * TSEQ + t;
#pragma unroll 4
                for (int dc = 0; dc < 16; ++dc) { const u32x4 w = *(const u32x4*)(src + dc * 8);
                    dst[(size_t)(dc * 8 + 0) * TSEQ] = (bf16_t)(w.x & 0xffffu); dst[(size_t)(dc * 8 + 1) * TSEQ] = (bf16_t)(w.x >> 16);
                    dst[(size_t)(dc * 8 + 2) * TSEQ] = (bf16_t)(w.y & 0xffffu); dst[(size_t)(dc * 8 + 3) * TSEQ] = (bf16_t)(w.y >> 16);
                    dst[(size_t)(dc * 8 + 4) * TSEQ] = (bf16_t)(w.z & 0xffffu); dst[(size_t)(dc * 8 + 5) * TSEQ] = (bf16_t)(w.z >> 16);
                    dst[(size_t)(dc * 8 + 6) * TSEQ] = (bf16_t)(w.w & 0xffffu); dst[(size_t)(dc * 8 + 7) * TSEQ] = (bf16_t)(w.w >> 16); }


        }
        for (int r = gw; r < T_KS; r += NGW) {
                const int b = r >> 9, j = r & 511;
                const float* src = p.in[2] + (size_t)r * 1024 + lane * 16;
                float t0[8], t1[8];
                { const f32x4 a = *(const f32x4*)src, c = *(const f32x4*)(src + 4), d = *(const f32x4*)(src + 8), e = *(const f32x4*)(src + 12);
                  t0[0] = a.x; t0[1] = a.y; t0[2] = a.z; t0[3] = a.w; t0[4] = c.x; t0[5] = c.y; t0[6] = c.z; t0[7] = c.w;
                  t1[0] = d.x; t1[1] = d.y; t1[2] = d.z; t1[3] = d.w; t1[4] = e.x; t1[5] = e.y; t1[6] = e.z; t1[7] = e.w; }
                bf16_t* kd = Ks + ((size_t)b * SKEYS + j) * 1024 + lane * 16;
                *(u32x4*)kd = pack8(t0); *(u32x4*)(kd + 8) = pack8(t1);


        }
        for (int r = gw; r < T_VTS; r += NGW) {
                const int b = r >> 6, h = (r >> 3) & 7, jg = r & 7, j = jg * 64 + lane;
                const float* src = p.in[3] + (((size_t)b * 512 + j) * 8 + h) * 128;
                bf16_t* dst = Vts + ((size_t)(b * 8 + h) * 128) * SKEYS + j;
#pragma unroll 4
                for (int dc = 0; dc < 32; ++dc) { const f32x4 v = *(const f32x4*)(src + dc * 4);
                    dst[(size_t)(dc * 4 + 0) * SKEYS] = (bf16_t)pk2(v.x, 0.f); dst[(size_t)(dc * 4 + 1) * SKEYS] = (bf16_t)pk2(v.y, 0.f);
                    dst[(size_t)(dc * 4 + 2) * SKEYS] = (bf16_t)pk2(v.z, 0.f); dst[(size_t)(dc * 4 + 3) * SKEYS] = (bf16_t)pk2(v.w, 0.f); }
                if (jg == 7 && lane < 16) { bf16_t* pz = Vts + ((size_t)(b * 8 + h) * 128) * SKEYS + 528 + lane;
                    for (int d = 0; d < 128; ++d) pz[(size_t)d * SKEYS] = 0; }


        }
        {
            const int nblk = blockIdx.x & 15, slot = (blockIdx.x >> 4) * NWAVES + wave, nslot = (G >> 4) * NWAVES;
            __syncthreads();
            lru_tables_to_lds(p, lds + LT_OFF, nblk, tid);
            for (int rr = 0; rr < 1 + ((REPM >> 17) & 1) * 3; ++rr)
            for (int u = slot; u < NBATCH * 64; u += nslot) lru_unit<0>(p, u >> 6, u & 63, nblk, lane, nullptr, 0u, 0u, lds + LT_OFF);
            (void)T_LRU;
        }
    }
    xcd_barrier(xbar);

    for (int rep_ = 0; rep_ < 1 + ((REPM >> 6) & 1); ++rep_) { if (rep_) grid.sync(); PH_IDS;
        const bool dummy = ((REPM >> 6) & 1) && rep_ == 0;
        LAS float* tbl = (LAS float*)(lds + 65536);
        constexpr int T_AP = NBATCH * 64 * 8 * 2, T_AS = SBATCH * 8, T_LP = NBATCH * 64 * 16, T_LS = SBATCH * 16;
        for (int wt = blockIdx.x; wt < NBATCH * 8 * 16; wt += G) {
            int pair, cg4;
            if (G == 256) { const int itp = wt >> 8, x = blockIdx.x & 7, j = blockIdx.x >> 3; pair = x * 8 + itp * 2 + (j >> 4); cg4 = (j + itp * 4) & 15; }
            else { pair = wt >> 4; cg4 = wt & 15; }
            attn_wg_prompt(p, lds, pair >> 3, pair & 7, cg4, dummy ? XN : U, dummy ? 1024 : NU, dummy ? 0 : OQ, tid);
        }
        __syncthreads();
        for (int q = blockIdx.x; q < T_AS; q += G) if (wave == 0) {
            const int b = q >> 3, h = q & 7;
            for (int i = lane; i < 640; i += 64) { int d = i - 63; d = d < -256 ? -256 : (d > 256 ? 256 : d); tbl[i] = p.in[17][h * 513 + d + 256] * LOG2E; }
            asm volatile("s_waitcnt lgkmcnt(0)" ::: "memory");
            __builtin_amdgcn_wave_barrier();
            bf16_t* qp = U + ((size_t)MP + (size_t)b * STOK) * NU + OQ + h * 128;
            attn_task<true>(qp, NU, dummy ? XN + ((size_t)MP + (size_t)b * STOK) * 1024 + h * 128 : qp, dummy ? 1024 : NU, Ks + (size_t)b * SKEYS * 1024 + h * 128, 1024, Vts + ((size_t)(b * 8 + h) * 128) * SKEYS, SKEYS,
                            17, 528, 1, p.in[15], tbl, 1024 - 512 + 63, lane);
            asm volatile("s_waitcnt lgkmcnt(0)" ::: "memory");
            __builtin_amdgcn_wave_barrier();
        }
        {
            const int nblk = blockIdx.x & 15, slot = (blockIdx.x >> 4) * NWAVES + wave, nslot = (G >> 4) * NWAVES;
            __syncthreads();
            lru_tables_to_lds(p, lds + LT_OFF, nblk, tid);
            for (int u = slot; u < NBATCH * 64 + SBATCH; u += nslot) { const bool pr = u < NBATCH * 64;
                lru_unit<1>(p, pr ? (u >> 6) : NBATCH + (u - NBATCH * 64), pr ? (u & 63) : 0, nblk, lane, dummy ? XN + (size_t)MT * 1024 : U, dummy ? 1024u : (unsigned)NU, dummy ? 0u : (unsigned)OGR, lds + LT_OFF); }
            (void)T_LP; (void)T_LS;
        }
    }
    xcd_barrier(xbar);

    for (int rep_ = 0; rep_ < 1 + ((REPM >> 7) & 1); ++rep_) { if (rep_) grid.sync(); PH_IDS;
        pg8::StaticOrder S; S.init(MT, D, G, (int)blockIdx.x);
        pg8::Gemm g1{U + OQ, (const bf16_t*)(ws + W_PA), MT, D, 1024, NU, 1024};
        pg8::EpiGate E1{U + OGA, U + OGA, NU, 0};
        pg8::gemm_phase<pg8::EpiGate, true>(lds, g1, S, E1, STAG);
        pg8::Gemm g2{U + OGR, (const bf16_t*)(ws + W_PB), MT, D, 1024, NU, 1024};
        pg8::EpiGate E2{U + OGA, U + OGB, NU, 1};
        pg8::gemm_phase<pg8::EpiGate, true>(lds, g2, S, E2, 0);
    }
    xcd_barrier(xbar);

    for (int rep_ = 0; rep_ < 1 + ((REPM >> 8) & 1); ++rep_) { if (rep_) grid.sync(); PH_IDS;
        pg8::Gemm g{U + OGA, (const bf16_t*)(ws + W_OUT), MP, D, D, NU, D}; pg8::StaticOrder S; S.init(MP, D, G, (int)blockIdx.x);
        pg8::EpiResid E{R, nullptr, nullptr, XN, (float*)(ws + W_SS) + MT, 1.0f};
        pg8::gemm_phase<pg8::EpiResid, true>(lds, g, S, E, STAG);
        pg8::Gemm gs{U + (size_t)MP * NU + OGA, (const bf16_t*)(ws + W_OUT), MS, D, D, NU, D / 4}; pg8::SplitOrder Ss; Ss.init(MS, D, 4, G, (int)blockIdx.x);
        pg8::EpiResidAtomic Es{R + (size_t)MP * D, 1.0f};
        pg8::gemm_phase<pg8::EpiResidAtomic, true>(lds, gs, Ss, Es);
    }
    xcd_barrier(xbar);

    for (int rep_ = 0; rep_ < 1 + ((REPM >> 9) & 1); ++rep_) { PH_IDS;
    for (int m = MP + gw; m < MT; m += NGW) feed_row(R + (size_t)m * D, XN + (size_t)m * D, (float*)(ws + W_SS) + MT + m, lane); }
    xcd_barrier(xbar);

    for (int rep_ = 0; rep_ < 1 + ((REPM >> 10) & 1); ++rep_) { if (rep_) grid.sync(); PH_IDS;
        pg8::Gemm g{XN, (const bf16_t*)(ws + W_MQ), MT, 512, D, D, D}; pg8::StaticOrder S; S.init(MT, 512, G, (int)blockIdx.x);
        pg8::EpiBf16 E{MQ, 512, (const float*)(ws + W_SS) + MT};
        pg8::gemm_phase<pg8::EpiBf16, true>(lds, g, S, E, 0);
    }
    xcd_barrier(xbar);

    for (int rep_ = 0; rep_ < 1 + ((REPM >> 11) & 1); ++rep_) { if (rep_) grid.sync(); PH_IDS;
        constexpr int T_P = (MP / 32) * 4, T_S = SBATCH * 4;
        for (int it = gw; it < T_P + T_S; it += NGW) {
            if (it < T_P) { const int rt = it >> 2, h = it & 3, seq = rt >> 7;
                bf16_t* qp = MQ + (size_t)rt * 32 * 512 + h * 128;
                attn_task<false>(qp, 512, qp, 512, Km + (size_t)seq * 256 * 512 + h * 128, 512, Vtm + ((size_t)(seq * 4 + h) * 128) * 256, 256, 8, 256, 2, p.in[33], nullptr, 0, lane);
            } else { const int q = it - T_P, b = q >> 2, h = q & 3, seq = NBATCH + b;
                bf16_t* qp = MQ + ((size_t)MP + (size_t)b * STOK) * 512 + h * 128;
                attn_task<false>(qp, 512, qp, 512, Km + (size_t)seq * 256 * 512 + h * 128, 512, Vtm + ((size_t)(seq * 4 + h) * 128) * 256, 256, 8, 256, 1, p.in[33], nullptr, 0, lane);
            }
        }
    }
    xcd_barrier(xbar);

    for (int rep_ = 0; rep_ < 1 + ((REPM >> 12) & 1); ++rep_) { if (rep_) grid.sync(); PH_IDS;
        pg8::Gemm g{MQ, (const bf16_t*)(ws + W_MO), MT, D, 512, 512, 512}; pg8::StaticOrder S; S.init(MT, D, G, (int)blockIdx.x);
        pg8::EpiResid E{R, nullptr, nullptr, XN, (float*)(ws + W_SS) + 2 * MT, 1.0f};
        pg8::gemm_phase<pg8::EpiResid, true>(lds, g, S, E, 0);
    }
    xcd_barrier(xbar);

    for (int rep_ = 0; rep_ < 1 + ((REPM >> 14) & 1); ++rep_) { if (rep_) grid.sync(); PH_IDS;
        pg8::Gemm g{XN, (const bf16_t*)(ws + W_GU2), MT, 2 * FF, D, D, D}; pg8::StaticOrder S; S.init(MT, 2 * FF, G, (int)blockIdx.x);
        pg8::EpiSwiglu E{H, FF, (const float*)(ws + W_SS) + 2 * MT};
        pg8::gemm_phase<pg8::EpiSwiglu, true>(lds, g, S, E, STAG);
    }
    xcd_barrier(xbar);

    for (int rep_ = 0; rep_ < 1 + ((REPM >> 15) & 1); ++rep_) { if (rep_) grid.sync(); PH_IDS;
        pg8::Gemm g{H, (const bf16_t*)(ws + W_D2), MP, D, FF, FF, FF}; pg8::StaticOrder S; S.init(MP, D, G, (int)blockIdx.x);
        pg8::EpiResid E{R, nullptr, nullptr, nullptr, nullptr, 0.5f};
        pg8::gemm_phase<pg8::EpiResid, true>(lds, g, S, E, STAG);
        pg8::Gemm gs{H + (size_t)MP * FF, (const bf16_t*)(ws + W_D2), MS, D, FF, FF, FF / 4}; pg8::SplitOrder Ss; Ss.init(MS, D, 4, G, (int)blockIdx.x);
        pg8::EpiResidAtomic Es{R + (size_t)MP * D, 0.5f};
        pg8::gemm_phase<pg8::EpiResidAtomic, true>(lds, gs, Ss, Es);
    }
    xcd_barrier(xbar);

    for (int rep_ = 0; rep_ < 1 + ((REPM >> 16) & 1); ++rep_) { PH_IDS;
    for (int m = gw; m < MT; m += NGW) norm_row_f32(R + (size_t)m * D, p.in[40], lane); }
}

extern "C" void kernel_launch(void* const* d_in, const int* in_sizes, int n_in, void* d_out, int out_size, void* d_ws, size_t ws_size, hipStream_t stream) {
    static int grid = 0;
    if (grid == 0) {
        if (n_in != 41 || (size_t)out_size != O_END || ws_size < W_END) {
            fprintf(stderr, "kernel_launch: unexpected sizes: n_in %d out %d (want %zu) ws %zu (want >= %zu)\n", n_in, out_size, (size_t)O_END, ws_size, (size_t)W_END); grid = -1; return; }
        int dev = 0, cus = 0, per_cu = 0;
        hipGetDevice(&dev); hipDeviceGetAttribute(&cus, hipDeviceAttributeMultiprocessorCount, dev);
        hipFuncSetAttribute((const void*)fwd_megakernel, hipFuncAttributeMaxDynamicSharedMemorySize, LDS_BYTES);
        hipOccupancyMaxActiveBlocksPerMultiprocessor(&per_cu, (const void*)fwd_megakernel, NWAVES * 64, LDS_BYTES);
        if (per_cu < 1) { fprintf(stderr, "kernel_launch: occupancy query says %d blocks per CU\n", per_cu); per_cu = 1; }
        (void)hipGetLastError();
        grid = cus * 1;
    }
    if (grid < 0) return;
    Params p{};
    for (int i = 0; i < 41; ++i) p.in[i] = (const float*)d_in[i];
    p.out = (float*)d_out; p.ws = (unsigned char*)d_ws;
    void* args[] = {&p};
    hipError_t e = hipLaunchCooperativeKernel((const void*)fwd_megakernel, dim3(grid), dim3(NWAVES * 64), args, LDS_BYTES, stream);
    if (e != hipSuccess) fprintf(stderr, "kernel_launch: cooperative launch failed: %s (grid %d)\n", hipGetErrorString(e), grid);
}
```

```cpp
#include <hip/hip_runtime.h>
#include <hip/hip_cooperative_groups.h>
#include <cstdio>
#include <cstdint>
namespace cg = cooperative_groups;

#define LAS __attribute__((address_space(3)))
typedef unsigned short bf16_t;
typedef short bf16x8 __attribute__((ext_vector_type(8)));
typedef float f32x4 __attribute__((ext_vector_type(4)));
typedef float f32x2 __attribute__((ext_vector_type(2)));
typedef unsigned u32x4 __attribute__((ext_vector_type(4)));
typedef unsigned u32x2 __attribute__((ext_vector_type(2)));
typedef __bf16 bf16x2_t __attribute__((ext_vector_type(2)));
#define DI __device__ __forceinline__

constexpr int D = 2048, NBATCH = 8, TSEQ = 4096, MP = NBATCH * TSEQ, SBATCH = 32, STOK = 16, MS = SBATCH * STOK, MT = MP + MS;
constexpr int FF = 5632, NU = 9216, NWAVES = 8;
constexpr int OQ = 0, OKK = 1024, OV = 2048, OXR = 3072, OGR = 4096, OGA = 5120, OGB = 7168;
constexpr int SKEYS = 544;
constexpr float EPS = 1e-6f, LOG2E = 1.4426950408889634f;
constexpr int NSEQ = NBATCH + SBATCH;

constexpr size_t O_YP = 0, O_YS = (size_t)MP * D, O_KP = O_YS + (size_t)MS * D, O_VP = O_KP + (size_t)NBATCH * 512 * 1024,
                 O_CP = O_VP + (size_t)NBATCH * 512 * 1024, O_LP = O_CP + (size_t)NBATCH * 3 * 1024, O_MK = O_LP + (size_t)NBATCH * 1024,
                 O_MV = O_MK + (size_t)NBATCH * 256 * 512, O_KS = O_MV + (size_t)NBATCH * 256 * 512, O_VS = O_KS + (size_t)MS * 1024,
                 O_CS = O_VS + (size_t)MS * 1024, O_LS = O_CS + (size_t)SBATCH * 3 * 1024, O_END = O_LS + (size_t)SBATCH * 1024;

constexpr size_t al256(size_t x) { return (x + 255) & ~(size_t)255; }
constexpr size_t W_GU1 = 0, W_D1 = W_GU1 + (size_t)2 * FF * D * 2, W_IN = W_D1 + (size_t)D * FF * 2, W_PA = W_IN + (size_t)NU * D * 2,
                 W_PB = W_PA + (size_t)D * 1024 * 2, W_OUT = W_PB + (size_t)D * 1024 * 2, W_MQ = W_OUT + (size_t)D * D * 2, W_MKV = W_MQ + (size_t)512 * D * 2,
                 W_MO = W_MKV + (size_t)1024 * D * 2, W_GU2 = W_MO + (size_t)D * 512 * 2, W_D2 = W_GU2 + (size_t)2 * FF * D * 2, W_LRU = W_D2 + (size_t)D * FF * 2,
                 W_C8 = W_LRU + (size_t)2 * 16 * 64 * 64 * 2, W_XN = al256(W_C8 + 1024 * 4), W_U = W_XN + (size_t)MT * D * 2, W_VT = W_U + (size_t)MT * NU * 2,
                 W_KS = W_VT + (size_t)NBATCH * 8 * 128 * TSEQ * 2, W_VTS = W_KS + (size_t)SBATCH * SKEYS * 1024 * 2, W_KM = W_VTS + (size_t)SBATCH * 8 * 128 * SKEYS * 2,
                 W_VTM = W_KM + (size_t)NSEQ * 256 * 512 * 2, W_CA = W_VTM + (size_t)NSEQ * 4 * 128 * 256 * 2, W_CB = W_CA + (size_t)NBATCH * 64 * 1024 * 4,
                 W_SS = W_CB + (size_t)NBATCH * 64 * 1024 * 4, W_BAR = al256(W_SS + (size_t)3 * MT * 4), W_END = W_BAR + 16384;
constexpr size_t W_H = W_U, W_MQB = W_U, W_MN = W_VT, W_MKVF = W_MN + (size_t)2048 * D * 2;

#ifndef STAG
#define STAG 0
#endif
#ifndef REPM
#define REPM 0
#endif
constexpr int RING_BYTES = 131072, LDS_BYTES = 147456;

struct Params { const float* in[41]; float* out; unsigned char* ws; };

DI unsigned pk2(float a, float b) { f32x2 v = {a, b}; bf16x2_t r = __builtin_convertvector(v, bf16x2_t); return __builtin_bit_cast(unsigned, r); }
DI float bf_lo(unsigned w) { return __builtin_bit_cast(float, w << 16); }
DI float bf_hi(unsigned w) { return __builtin_bit_cast(float, w & 0xffff0000u); }
DI void unpack8(const u32x4 w, float (&f)[8]) { f[0] = bf_lo(w.x); f[1] = bf_hi(w.x); f[2] = bf_lo(w.y); f[3] = bf_hi(w.y); f[4] = bf_lo(w.z); f[5] = bf_hi(w.z); f[6] = bf_lo(w.w); f[7] = bf_hi(w.w); }
DI u32x4 pack8(const float (&f)[8]) { u32x4 w; w.x = pk2(f[0], f[1]); w.y = pk2(f[2], f[3]); w.z = pk2(f[4], f[5]); w.w = pk2(f[6], f[7]); return w; }
DI float wave_sum(float v) {
#pragma unroll
    for (int o = 1; o < 64; o <<= 1) v += __shfl_xor(v, o);
    return v;
}
DI float fast_exp2(float x) { return __builtin_amdgcn_exp2f(x); }
DI float fast_rcp(float x) { return __builtin_amdgcn_rcpf(x); }
DI float sigmoidf_(float x) { return fast_rcp(1.0f + fast_exp2(-x * LOG2E)); }
template <int S> DI float dpp_shr(float old, float v) {
    return __builtin_bit_cast(float, __builtin_amdgcn_update_dpp(__builtin_bit_cast(int, old), __builtin_bit_cast(int, v), 0x110 + S, 0xf, 0xf, false));
}
#define LDS_WAIT() asm volatile("s_waitcnt lgkmcnt(0)" ::: "memory")

namespace pg8 {
constexpr int BM = 256, BK = 64, HALF = 128, HTB = HALF * BK * 2, STAGE_BYTES = 8 * HTB, NXCD = 8, WGM = 8;
DI int lds_byte(int r, int c) { const int st = (r >> 4) * 2 + (c >> 5), rr = r & 15, cc = c & 31, ob = rr * 64 + cc * 2; return st * 1024 + (ob ^ (((ob >> 9) & 1) << 5)); }
DI void stage_rc(int b, int& R, int& C) { const int st = b / 1024, sb = b % 1024, swz = sb ^ (((sb >> 9) & 1) << 5); R = (st >> 1) * 16 + swz / 64; C = (st & 1) * 32 + (swz % 64) / 2; }
DI int perm32(int rho) { const int n = rho >> 4, i = rho & 15; return 8 * (i >> 2) + 4 * n + (i & 3); }
struct Unit { int pm, pn, ks; };
struct Gemm { const bf16_t* A; const bf16_t* Bt; int M, N, K, lda, kloop; };
struct StaticOrder {
    int nM, nN, nwg, G, c;
    DI void init(int M, int N, int G_, int c_) { nM = M / BM; nN = N / BM; nwg = nM * nN; G = G_; c = c_; }
    DI bool next(int i, Unit& u) const {
        const long L = (long)i * G + c; if (L >= nwg) return false;
        int wgid = (int)L; { const int q = nwg / NXCD, r = nwg % NXCD, xcd = wgid % NXCD, off = wgid / NXCD; wgid = (xcd < r ? xcd * (q + 1) : r * (q + 1) + (xcd - r) * q) + off; }
        const int nig = WGM * nN, gid = wgid / nig, fm = gid * WGM, gsz = (nM - fm) < WGM ? (nM - fm) : WGM;
        u.pm = fm + ((wgid % nig) % gsz); u.pn = (wgid % nig) / gsz; u.ks = 0; return true;
    }
};
struct SplitOrder {
    int nM, nN, ntot, G, c;
    DI void init(int M, int N, int nsplit, int G_, int c_) { nM = M / BM; nN = N / BM; ntot = nM * nN * nsplit; G = G_; c = c_; }
    DI bool next(int i, Unit& u) const {
        const int L = i * G + c; if (L >= ntot) return false;
        u.pm = L % nM; const int r = L / nM; u.pn = r % nN; u.ks = r / nN; return true;
    }
};
typedef f32x4 Acc[2][2][4][2];

struct EpiBf16 {
    static constexpr bool PERM = true;
    bf16_t* O; int ldc; const float* ss;
    DI void operator()(const Acc& acc, const Unit& u, int wr, int wc, int fr, int fq) const {
        const int row0 = u.pm * BM + wr * 64 + fr, col0 = u.pn * BM + wc * 32 + 8 * fq;
#pragma unroll
        for (int ai = 0; ai < 2; ++ai)
#pragma unroll
            for (int m = 0; m < 4; ++m) { bf16_t* rowp = O + (size_t)(row0 + ai * HALF + m * 16) * ldc + col0;
                const float rs = ss ? rsqrtf(ss[row0 + ai * HALF + m * 16] * (1.f / D) + EPS) : 1.f;
#pragma unroll
                for (int bj = 0; bj < 2; ++bj) { const f32x4 v0 = acc[ai][bj][m][0] * rs, v1 = acc[ai][bj][m][1] * rs;
                    u32x4 w; w.x = pk2(v0[0], v0[1]); w.y = pk2(v0[2], v0[3]); w.z = pk2(v1[0], v1[1]); w.w = pk2(v1[2], v1[3]);
                    *(u32x4*)(rowp + bj * HALF) = w; } }
    }
};
struct EpiSwiglu {
    static constexpr bool PERM = true;
    bf16_t* O; int ldc; const float* ss;
    DI void operator()(const Acc& acc, const Unit& u, int wr, int wc, int fr, int fq) const {
        const int row0 = u.pm * BM + wr * 64 + fr, col0 = u.pn * HALF + wc * 32 + 8 * fq;
#pragma unroll
        for (int ai = 0; ai < 2; ++ai)
#pragma unroll
            for (int m = 0; m < 4; ++m) {
                const float rs = ss ? rsqrtf(ss[row0 + ai * HALF + m * 16] * (1.f / D) + EPS) : 1.f;
                float h[8];
#pragma unroll
                for (int n = 0; n < 2; ++n)
#pragma unroll
                    for (int j = 0; j < 4; ++j) { const float g = acc[ai][0][m][n][j] * rs, up = acc[ai][1][m][n][j] * rs; h[n * 4 + j] = g * sigmoidf_(g) * up; }
                *(u32x4*)(O + (size_t)(row0 + ai * HALF + m * 16) * ldc + col0) = pack8(h); }
    }
};
struct EpiGate {
    static constexpr bool PERM = true;
    bf16_t* O; const bf16_t* G; int ld; int accum;
    DI void operator()(const Acc& acc, const Unit& u, int wr, int wc, int fr, int fq) const {
        const int row0 = u.pm * BM + wr * 64 + fr, col0 = u.pn * BM + wc * 32 + 8 * fq;
#pragma unroll
        for (int ai = 0; ai < 2; ++ai)
#pragma unroll
            for (int m = 0; m < 4; ++m)
#pragma unroll
                for (int bj = 0; bj < 2; ++bj) {
                    const size_t off = (size_t)(row0 + ai * HALF + m * 16) * ld + col0 + bj * HALF;
                    float gv[8], o[8]; unpack8(*(const u32x4*)(G + off), gv);
                    if (accum) unpack8(*(const u32x4*)(O + off), o);
                    else {
#pragma unroll
                        for (int i = 0; i < 8; ++i) o[i] = 0.f; }
#pragma unroll
                    for (int n = 0; n < 2; ++n)
#pragma unroll
                        for (int j = 0; j < 4; ++j) o[n * 4 + j] += sigmoidf_(gv[n * 4 + j]) * acc[ai][bj][m][n][j];
                    *(u32x4*)(O + off) = pack8(o); }
    }
};
struct EpiResid {
    static constexpr bool PERM = false;
    float* R; const float* xp; const float* xs; bf16_t* Xb; float* ss; float alpha; int wr_f32;
    DI void operator()(const Acc& acc, const Unit& u, int wr, int wc, int fr, int fq) const {
        const float al = alpha; bf16_t* const xb = Xb; float* const ssp = ss;
        const int row0 = u.pm * BM + wr * 64 + fr, col0 = u.pn * BM + wc * 32 + 4 * fq;
#pragma unroll
        for (int ai = 0; ai < 2; ++ai)
#pragma unroll
            for (int m = 0; m < 4; ++m) { const int row = row0 + ai * HALF + m * 16;
                float* rp = R + (size_t)row * D + col0;
                const float* bp = xp ? (row < MP ? xp + (size_t)row * D + col0 : xs + (size_t)(row - MP) * D + col0) : rp;
                float sq = 0.f;
#pragma unroll
                for (int bj = 0; bj < 2; ++bj)
#pragma unroll
                    for (int n = 0; n < 2; ++n) { const f32x4 b = *(const f32x4*)(bp + bj * HALF + n * 16); const f32x4 a4 = acc[ai][bj][m][n];
                        f32x4 v; v[0] = b[0] + al * a4[0]; v[1] = b[1] + al * a4[1]; v[2] = b[2] + al * a4[2]; v[3] = b[3] + al * a4[3];
                        if (wr_f32) *(f32x4*)(rp + bj * HALF + n * 16) = v;
                        if (xb) { u32x2 w; w.x = pk2(v[0], v[1]); w.y = pk2(v[2], v[3]); *(u32x2*)(xb + (size_t)row * D + col0 + bj * HALF + n * 16) = w;
                            sq += (v[0] * v[0] + v[1] * v[1]) + (v[2] * v[2] + v[3] * v[3]); } }
                if (xb) { sq += __shfl_xor(sq, 16); sq += __shfl_xor(sq, 32); if (fq == 0) unsafeAtomicAdd(ssp + row, sq); } }
    }
};
struct EpiResidAtomic {
    static constexpr bool PERM = false;
    float* R; float alpha;
    DI void operator()(const Acc& acc, const Unit& u, int wr, int wc, int fr, int fq) const {
        const int row0 = u.pm * BM + wr * 64 + fr, col0 = u.pn * BM + wc * 32 + 4 * fq;
#pragma unroll
        for (int ai = 0; ai < 2; ++ai)
#pragma unroll
            for (int m = 0; m < 4; ++m) { float* rp = R + (size_t)(row0 + ai * HALF + m * 16) * D + col0;
#pragma unroll
                for (int bj = 0; bj < 2; ++bj)
#pragma unroll
                    for (int n = 0; n < 2; ++n)
#pragma unroll
                        for (int j = 0; j < 4; ++j) unsafeAtomicAdd(rp + bj * HALF + n * 16 + j, alpha * acc[ai][bj][m][n][j]); }
    }
};
struct EpiF32 {
    static constexpr bool PERM = false;
    float* C; int ldc;
    DI void operator()(const Acc& acc, const Unit& u, int wr, int wc, int fr, int fq) const {
        const int row0 = u.pm * BM + wr * 64 + fr, col0 = u.pn * BM + wc * 32 + 4 * fq;
#pragma unroll
        for (int ai = 0; ai < 2; ++ai)
#pragma unroll
            for (int m = 0; m < 4; ++m) { float* rp = C + (size_t)(row0 + ai * HALF + m * 16) * ldc + col0;
#pragma unroll
                for (int bj = 0; bj < 2; ++bj)
#pragma unroll
                    for (int n = 0; n < 2; ++n) *(f32x4*)(rp + bj * HALF + n * 16) = acc[ai][bj][m][n]; }
    }
};

template <class Epi, bool ALIGN_EPI, class Sched>
DI void gemm_phase(LAS unsigned char* lds, const Gemm g, const Sched& S, const Epi& E, int stag = 0) {
    int tid = threadIdx.x; asm volatile("" : "+v"(tid));
    const int wid = __builtin_amdgcn_readfirstlane(tid >> 6), lane = tid & 63, wr = wid >> 2, wc = wid & 3, fr = lane & 15, fq = lane >> 4;
    const int K = g.K, nt = g.kloop / BK;
    const size_t ksl = (size_t)g.kloop * 2;
    unsigned voffA[2], voffB[2];
#pragma unroll
    for (int i = 0; i < 2; ++i) { int R, C; stage_rc(tid * 16 + i * 8192, R, C); const int Rb = Epi::PERM ? ((R & ~31) + perm32(R & 31)) : R;
        voffA[i] = (unsigned)(R * g.lda + C) * 2u; voffB[i] = (unsigned)(Rb * K + C) * 2u; }
    const size_t kstep = (size_t)(BK * 2);
    const size_t hstepA = (size_t)HALF * g.lda * 2, hstepB = (size_t)HALF * K * 2;
    const size_t tstepA = 2 * hstepA, tstepB = 2 * hstepB;
    const unsigned ldsw = (unsigned)wid * 1024u;
    const int aoff = lds_byte(wr * 64 + fr, fq * 8), boff = lds_byte(wc * 32 + fr, fq * 8);
#define PG8_SA(b, h) (((b) * 2 + (h)) * HTB)
#define PG8_SB(b, h) ((4 + (b) * 2 + (h)) * HTB)
#define PG8_STAGE(bufoff, gbase, voff) do { _Pragma("unroll") for (int _i = 0; _i < 2; ++_i) \
        __builtin_amdgcn_global_load_lds((const unsigned*)((const char*)(gbase) + (voff)[_i]), (LAS unsigned*)(lds + (bufoff) + ldsw + _i * 8192), 16, 0, 0); } while (0)
#define PG8_LDA(dst, b, h) do { _Pragma("unroll") for (int m = 0; m < 4; ++m) _Pragma("unroll") for (int k = 0; k < 2; ++k) dst[m][k] = *(const LAS bf16x8*)(lds + PG8_SA(b, h) + aoff + m * 2048 + k * 1024); } while (0)
#define PG8_LDB(dst, b, h) do { _Pragma("unroll") for (int n = 0; n < 2; ++n) _Pragma("unroll") for (int k = 0; k < 2; ++k) dst[n][k] = *(const LAS bf16x8*)(lds + PG8_SB(b, h) + boff + n * 2048 + k * 1024); } while (0)
#define PG8_MMA(ai, bj, At, Bt) do { __builtin_amdgcn_s_setprio(1); _Pragma("unroll") for (int m = 0; m < 4; ++m) _Pragma("unroll") for (int n = 0; n < 2; ++n) _Pragma("unroll") for (int k = 0; k < 2; ++k) \
        acc[ai][bj][m][n] = __builtin_amdgcn_mfma_f32_16x16x32_bf16(Bt[n][k], At[m][k], acc[ai][bj][m][n], 0, 0, 0); __builtin_amdgcn_s_setprio(0); } while (0)
#define PG8_WAIT_V(n) asm volatile("s_waitcnt vmcnt(" #n ")" ::: "memory")
#define PG8_WAIT_L(n) asm volatile("s_waitcnt lgkmcnt(" #n ")" ::: "memory")
#define PG8_BAR __builtin_amdgcn_s_barrier()
#define PG8_SCHED __builtin_amdgcn_sched_barrier(0)
    Unit cur, nxt; int ui = 0;
    if (!S.next(0, cur)) return;
    if (stag) {
        const unsigned long long t0 = __builtin_amdgcn_s_memrealtime(), dl = (unsigned long long)((blockIdx.x >> 5) & 7) * (unsigned)stag;
        while (__builtin_amdgcn_s_memrealtime() - t0 < dl) __builtin_amdgcn_s_sleep(8);
    }
    Acc acc;
#pragma unroll
    for (int a = 0; a < 2; ++a)
#pragma unroll
        for (int b = 0; b < 2; ++b)
#pragma unroll
            for (int m = 0; m < 4; ++m)
#pragma unroll
                for (int n = 0; n < 2; ++n) acc[a][b][m][n] = (f32x4){0.f, 0.f, 0.f, 0.f};
    bf16x8 At[4][2], B0[2][2], B1[2][2];
    const char* cA = (const char*)g.A + (size_t)cur.pm * tstepA + (size_t)cur.ks * ksl; const char* cB = (const char*)g.Bt + (size_t)cur.pn * tstepB + (size_t)cur.ks * ksl;
    PG8_STAGE(PG8_SB(0, 0), cB, voffB); PG8_STAGE(PG8_SB(0, 1), cB + hstepB, voffB); PG8_STAGE(PG8_SA(0, 0), cA, voffA); PG8_STAGE(PG8_SA(0, 1), cA + hstepA, voffA);
    if (wr == 1) PG8_BAR;
    PG8_WAIT_V(2); PG8_BAR;
    PG8_STAGE(PG8_SB(1, 0), cB + kstep, voffB); PG8_STAGE(PG8_SA(1, 0), cA + kstep, voffA); PG8_STAGE(PG8_SB(1, 1), cB + hstepB + kstep, voffB);
    PG8_WAIT_V(6); PG8_BAR;
    for (;;) {
        const bool has_next = S.next(ui + 1, nxt);
        const char* nA = has_next ? (const char*)g.A + (size_t)nxt.pm * tstepA + (size_t)nxt.ks * ksl : cA; const char* nB = has_next ? (const char*)g.Bt + (size_t)nxt.pn * tstepB + (size_t)nxt.ks * ksl : cB;
        for (int t = 0; t < nt; t += 2) {
            const bool last = (t == nt - 2);
            const char* a1 = cA + (size_t)(t + 1) * kstep;
            const char* a2 = last ? nA : cA + (size_t)(t + 2) * kstep; const char* b2 = last ? nB : cB + (size_t)(t + 2) * kstep;
            const char* a3 = a2 + kstep; const char* b3 = b2 + kstep;
            PG8_LDB(B0, 0, 0); PG8_LDB(B1, 0, 1); PG8_SCHED; PG8_LDA(At, 0, 0); PG8_STAGE(PG8_SA(1, 1), a1 + hstepA, voffA);
            PG8_WAIT_V(8); PG8_WAIT_L(0); PG8_BAR; PG8_MMA(0, 0, At, B0); PG8_MMA(0, 1, At, B1); PG8_BAR; PG8_SCHED;
            PG8_LDA(At, 0, 1); PG8_STAGE(PG8_SB(0, 0), b2, voffB); PG8_STAGE(PG8_SB(0, 1), b2 + hstepB, voffB); PG8_STAGE(PG8_SA(0, 0), a2, voffA);
            PG8_WAIT_V(8); PG8_WAIT_L(0); PG8_BAR; PG8_MMA(1, 0, At, B0); PG8_MMA(1, 1, At, B1); PG8_BAR; PG8_SCHED;
            PG8_LDB(B0, 1, 0); PG8_LDB(B1, 1, 1); PG8_SCHED; PG8_LDA(At, 1, 0); PG8_STAGE(PG8_SA(0, 1), a2 + hstepA, voffA);
            PG8_WAIT_V(8); PG8_WAIT_L(0); PG8_BAR; PG8_MMA(0, 0, At, B0); PG8_MMA(0, 1, At, B1); PG8_BAR; PG8_SCHED;
            PG8_LDA(At, 1, 1); PG8_STAGE(PG8_SB(1, 0), b3, voffB); PG8_STAGE(PG8_SB(1, 1), b3 + hstepB, voffB); PG8_STAGE(PG8_SA(1, 0), a3, voffA);
            PG8_WAIT_V(8); PG8_WAIT_L(0); PG8_BAR; PG8_MMA(1, 0, At, B0); PG8_MMA(1, 1, At, B1); PG8_BAR; PG8_SCHED;
        }
        if constexpr (ALIGN_EPI) { if (wr == 0) PG8_BAR; }
        E(acc, cur, wr, wc, fr, fq);
        if (!has_next) break;
#pragma unroll
        for (int a = 0; a < 2; ++a)
#pragma unroll
            for (int b = 0; b < 2; ++b)
#pragma unroll
                for (int m = 0; m < 4; ++m)
#pragma unroll
                    for (int n = 0; n < 2; ++n) acc[a][b][m][n] = (f32x4){0.f, 0.f, 0.f, 0.f};
        cur = nxt; cA = nA; cB = nB; ++ui;
        if constexpr (ALIGN_EPI) { if (wr == 1) PG8_BAR; }
    }
    PG8_WAIT_V(0);
    if constexpr (!ALIGN_EPI) { if (wr == 0) PG8_BAR; }
    PG8_BAR;
#undef PG8_SA
#undef PG8_SB
#undef PG8_STAGE
#undef PG8_LDA
#undef PG8_LDB
#undef PG8_MMA
#undef PG8_WAIT_V
#undef PG8_WAIT_L
#undef PG8_BAR
#undef PG8_SCHED
}
}

DI void transpose_item(const float* W, int K, int N, bf16_t* WT, int sh, int add, LAS float* scr, int item, int lane, const float* gain) {
    const int nblk = N / 32, kb = item / nblk, nb = item % nblk, k0 = 64 * kb, n0 = 32 * nb;
#pragma unroll 8
    for (int i = 0; i < 32; ++i) { const int kk = 2 * i + (lane >> 5); const float gk = gain ? gain[k0 + kk] : 1.f; scr[kk * 33 + (lane & 31)] = W[(size_t)(k0 + kk) * N + n0 + (lane & 31)] * gk; }
    LDS_WAIT();
    const int c = lane & 7;
#pragma unroll
    for (int j = 0; j < 4; ++j) { const int n = (lane >> 3) + 8 * j; const LAS float* s = scr + (8 * c) * 33 + n;
        u32x4 o; o.x = pk2(s[0 * 33], s[1 * 33]); o.y = pk2(s[2 * 33], s[3 * 33]); o.z = pk2(s[4 * 33], s[5 * 33]); o.w = pk2(s[6 * 33], s[7 * 33]);
        const int cc = n0 + n, drow = ((cc >> 7) << sh) + add + (cc & 127);
        *(u32x4*)(WT + (size_t)drow * K + k0 + 8 * c) = o; }
    LDS_WAIT();
}
DI void norm_row_bf16(const float* xrow, const float* gain, bf16_t* orow, int lane) {
    const f32x4* xr = (const f32x4*)xrow + lane;
    f32x4 v[8]; float s = 0.f;
#pragma unroll
    for (int j = 0; j < 8; ++j) { v[j] = xr[64 * j]; s += (v[j].x * v[j].x + v[j].y * v[j].y) + (v[j].z * v[j].z + v[j].w * v[j].w); }
    const float rstd = rsqrtf(wave_sum(s) * (1.f / D) + EPS);
    u32x2* o8 = (u32x2*)orow + lane;
#pragma unroll
    for (int j = 0; j < 8; ++j) { const f32x4 gg = ((const f32x4*)gain)[lane + 64 * j]; u32x2 w; w.x = pk2(v[j].x * rstd * gg.x, v[j].y * rstd * gg.y); w.y = pk2(v[j].z * rstd * gg.z, v[j].w * rstd * gg.w); o8[64 * j] = w; }
}
DI void norm_row_f32(float* xrow, const float* gain, int lane) {
    f32x4* xr = (f32x4*)xrow + lane;
    f32x4 v[8]; float s = 0.f;
#pragma unroll
    for (int j = 0; j < 8; ++j) { v[j] = xr[64 * j]; s += (v[j].x * v[j].x + v[j].y * v[j].y) + (v[j].z * v[j].z + v[j].w * v[j].w); }
    const float rstd = rsqrtf(wave_sum(s) * (1.f / D) + EPS);
#pragma unroll
    for (int j = 0; j < 8; ++j) { const f32x4 gg = ((const f32x4*)gain)[lane + 64 * j]; xr[64 * j] = v[j] * rstd * gg; }
}

DI void feed_row(const float* xrow, bf16_t* orow, float* ssp, int lane) {
    const f32x4* xr = (const f32x4*)xrow + lane;
    f32x4 v[8]; float s = 0.f;
#pragma unroll
    for (int j = 0; j < 8; ++j) { v[j] = xr[64 * j]; s += (v[j].x * v[j].x + v[j].y * v[j].y) + (v[j].z * v[j].z + v[j].w * v[j].w); }
    s = wave_sum(s);
    u32x2* o8 = (u32x2*)orow + lane;
#pragma unroll
    for (int j = 0; j < 8; ++j) { u32x2 w; w.x = pk2(v[j].x, v[j].y); w.y = pk2(v[j].z, v[j].w); o8[64 * j] = w; }
    if (lane == 0) *ssp = s;
}

DI void attn_load_q(bf16x8 (&qf)[2][4], const bf16_t* Qp, int ldq, int nqg, const float* qgain, int fr, int fq) {
#pragma unroll
    for (int g = 0; g < 2; ++g) {
        if (g < nqg) {
            const bf16_t* qrow = Qp + (size_t)(g * 16 + fr) * ldq + fq * 8;
            float qv[4][8]; float ss = 0.f;
#pragma unroll
            for (int s = 0; s < 4; ++s) { unpack8(*(const u32x4*)(qrow + s * 32), qv[s]);
#pragma unroll
                for (int e = 0; e < 8; ++e) ss += qv[s][e] * qv[s][e]; }
            ss += __shfl_xor(ss, 16); ss += __shfl_xor(ss, 32);
            const float rs = rsqrtf(ss * (1.f / 128.f) + EPS) * (0.08838834764831845f * LOG2E);
#pragma unroll
            for (int s = 0; s < 4; ++s) { const f32x4 g0 = *(const f32x4*)(qgain + s * 32 + fq * 8), g1 = *(const f32x4*)(qgain + s * 32 + fq * 8 + 4);
                float t[8];
#pragma unroll
                for (int e = 0; e < 4; ++e) { t[e] = qv[s][e] * rs * g0[e]; t[4 + e] = qv[s][4 + e] * rs * g1[e]; }
                qf[g][s] = __builtin_bit_cast(bf16x8, pack8(t)); }
        } else {
#pragma unroll
            for (int s = 0; s < 4; ++s) qf[g][s] = (bf16x8){0, 0, 0, 0, 0, 0, 0, 0};
        }
    }
}
template <bool BIAS>
DI void attn_tile(const bf16x8 (&kf)[2][4], const bf16x8 (&vf)[8], const bf16x8 (&qf)[2][4], f32x4 (&o)[2][8], float (&mrun)[2], float (&lrun)[2],
                  int nqg, const LAS float* tbl, int idx0, bool tail, int kpos0, int nvalid) {
    f32x4 st[2][2];
#pragma unroll
    for (int g = 0; g < 2; ++g)
#pragma unroll
        for (int hh = 0; hh < 2; ++hh) { st[g][hh] = (f32x4){0.f, 0.f, 0.f, 0.f};
#pragma unroll
            for (int s = 0; s < 4; ++s) st[g][hh] = __builtin_amdgcn_mfma_f32_16x16x32_bf16(kf[hh][s], qf[g][s], st[g][hh], 0, 0, 0); }
#pragma unroll
    for (int g = 0; g < 2; ++g) {
        if (g < nqg) {
            float sv[8];
#pragma unroll
            for (int e = 0; e < 4; ++e) { sv[e] = st[g][0][e]; sv[4 + e] = st[g][1][e]; }
            if (BIAS) {
#pragma unroll
                for (int e = 0; e < 8; ++e) sv[e] += tbl[idx0 + g * 16 - e]; }
            if (tail) {
#pragma unroll
                for (int e = 0; e < 8; ++e) if (kpos0 + e >= nvalid) sv[e] = -1e30f; }
            float tmax = fmaxf(fmaxf(fmaxf(sv[0], sv[1]), fmaxf(sv[2], sv[3])), fmaxf(fmaxf(sv[4], sv[5]), fmaxf(sv[6], sv[7])));
            tmax = fmaxf(tmax, __shfl_xor(tmax, 16)); tmax = fmaxf(tmax, __shfl_xor(tmax, 32));
            const float mn = fmaxf(mrun[g], tmax), alpha = fast_exp2(mrun[g] - mn); mrun[g] = mn;
            float pv[8], ps = 0.f;
#pragma unroll
            for (int e = 0; e < 8; ++e) { pv[e] = fast_exp2(sv[e] - mn); ps += pv[e]; }
            lrun[g] = lrun[g] * alpha + ps;
            const bf16x8 pf = __builtin_bit_cast(bf16x8, pack8(pv));
#pragma unroll
            for (int dt = 0; dt < 8; ++dt) { o[g][dt] = o[g][dt] * alpha; o[g][dt] = __builtin_amdgcn_mfma_f32_16x16x32_bf16(vf[dt], pf, o[g][dt], 0, 0, 0); }
        }
    }
}
DI void attn_store_o(const f32x4 (&o)[2][8], const float (&lrun)[2], bf16_t* Op, int ldo, int nqg, int fr, int fq) {
#pragma unroll
    for (int g = 0; g < 2; ++g) {
        if (g < nqg) {
            float lt = lrun[g]; lt += __shfl_xor(lt, 16); lt += __shfl_xor(lt, 32);
            const float inv = 1.0f / lt;
            bf16_t* orow = Op + (size_t)(g * 16 + fr) * ldo + fq * 4;
#pragma unroll
            for (int dt = 0; dt < 8; ++dt) { u32x2 w; w.x = pk2(o[g][dt][0] * inv, o[g][dt][1] * inv); w.y = pk2(o[g][dt][2] * inv, o[g][dt][3] * inv); *(u32x2*)(orow + dt * 16) = w; }
        }
    }
}
template <bool BIAS>
DI void attn_task(const bf16_t* Qp, int ldq, bf16_t* Op, int ldo, const bf16_t* Kp, int ldk, const bf16_t* Vtp, int ldv,
                  int nkt, int nvalid, int nqg, const float* qgain, const LAS float* tbl, int dbase, int lane) {
    const int fr = lane & 15, fq = lane >> 4;
    bf16x8 qf[2][4];
    attn_load_q(qf, Qp, ldq, nqg, qgain, fr, fq);
    f32x4 o[2][8];
#pragma unroll
    for (int g = 0; g < 2; ++g)
#pragma unroll
        for (int dt = 0; dt < 8; ++dt) o[g][dt] = (f32x4){0.f, 0.f, 0.f, 0.f};
    float mrun[2] = {-1e30f, -1e30f}, lrun[2] = {0.f, 0.f};
    const bf16_t* kb0 = Kp + (size_t)((fr >> 2) * 8 + (fr & 3)) * ldk + fq * 8;
    const bf16_t* vb0 = Vtp + (size_t)fr * ldv + fq * 8;
#pragma unroll 1
    for (int kt = 0; kt < nkt; ++kt) {
        const bf16_t* kb = kb0 + (size_t)kt * 32 * ldk;
        bf16x8 kf[2][4];
#pragma unroll
        for (int hh = 0; hh < 2; ++hh)
#pragma unroll
            for (int s = 0; s < 4; ++s) kf[hh][s] = *(const bf16x8*)(kb + (size_t)hh * 4 * ldk + s * 32);
        bf16x8 vf[8];
#pragma unroll
        for (int dt = 0; dt < 8; ++dt) vf[dt] = *(const bf16x8*)(vb0 + (size_t)dt * 16 * ldv + kt * 32);
        attn_tile<BIAS>(kf, vf, qf, o, mrun, lrun, nqg, tbl, dbase + fr - kt * 32 - fq * 8, kt * 32 + 32 > nvalid, kt * 32 + fq * 8, nvalid);
    }
    attn_store_o(o, lrun, Op, ldo, nqg, fr, fq);
}
constexpr int AT_TBL = 0, AT_K = 4096, AT_KB = 32 * 272, AT_V = AT_K + 2 * AT_KB, AT_VB = 128 * 80;
DI void attn_wg_prompt(const Params& p, LAS unsigned char* lds, int b, int h, int cg, bf16_t* obase, int ldo, int ocol, int tid) {
    const int lane = tid & 63, wave = __builtin_amdgcn_readfirstlane(tid >> 6), fr = lane & 15, fq = lane >> 4;
    const int c = cg * 4 + (wave >> 1), half = wave & 1;
    const bf16_t* Ub = (const bf16_t*)(p.ws + W_U); const bf16_t* Vtg = (const bf16_t*)(p.ws + W_VT);
    LAS float* tbl = (LAS float*)(lds + AT_TBL);
    __syncthreads();
    for (int i = tid; i < 640; i += NWAVES * 64) { int d = i - 63; d = d < -256 ? -256 : (d > 256 ? 256 : d); tbl[i] = p.in[17][h * 513 + d + 256] * LOG2E; }
    const size_t qrow0 = (size_t)b * TSEQ + c * 64 + half * 32;
    bf16x8 qf[2][4];
    attn_load_q(qf, Ub + qrow0 * NU + OQ + h * 128, NU, 2, p.in[15], fr, fq);
    f32x4 o[2][8];
#pragma unroll
    for (int g = 0; g < 2; ++g)
#pragma unroll
        for (int dt = 0; dt < 8; ++dt) o[g][dt] = (f32x4){0.f, 0.f, 0.f, 0.f};
    float mrun[2] = {-1e30f, -1e30f}, lrun[2] = {0.f, 0.f};
    const int key_lo = (cg * 4 - 8) * 64 > 0 ? (cg * 4 - 8) * 64 : 0, nkt = ((cg * 4 + 4) * 64 - key_lo) / 32;
    const bf16_t* kg = Ub + ((size_t)b * TSEQ + key_lo + (tid >> 4)) * NU + OKK + h * 128 + (tid & 15) * 8;
    const bf16_t* vg = Vtg + ((size_t)(b * 8 + h) * 128 + (tid >> 2)) * TSEQ + key_lo + (tid & 3) * 8;
    const unsigned kw = (unsigned)(tid >> 4) * 272u + (unsigned)(tid & 15) * 16u, vw = (unsigned)(tid >> 2) * 80u + (unsigned)(tid & 3) * 16u;
    const unsigned kroff = (unsigned)((fr >> 2) * 8 + (fr & 3)) * 272u + (unsigned)fq * 16u, vroff = (unsigned)fr * 80u + (unsigned)fq * 16u;
    const int dbase = c * 64 + half * 32 - key_lo + 63;
    u32x4 kr = *(const u32x4*)kg, vr = *(const u32x4*)vg;
#pragma unroll 1
    for (int kt = 0; kt < nkt; ++kt) {
        const int buf = kt & 1;
        *(LAS u32x4*)(lds + AT_K + buf * AT_KB + kw) = kr; *(LAS u32x4*)(lds + AT_V + buf * AT_VB + vw) = vr;
        if (kt + 1 < nkt) { kr = *(const u32x4*)(kg + (size_t)(kt + 1) * 32 * NU); vr = *(const u32x4*)(vg + (kt + 1) * 32); }
        __syncthreads();
        const int kc = (key_lo + kt * 32) >> 6;
        if (kc >= c - 8 && kc <= c) {
            bf16x8 kf[2][4], vf[8];
#pragma unroll
            for (int hh = 0; hh < 2; ++hh)
#pragma unroll
                for (int s = 0; s < 4; ++s) kf[hh][s] = *(const LAS bf16x8*)(lds + AT_K + buf * AT_KB + kroff + hh * (4 * 272) + s * 64);
#pragma unroll
            for (int dt = 0; dt < 8; ++dt) vf[dt] = *(const LAS bf16x8*)(lds + AT_V + buf * AT_VB + vroff + dt * (16 * 80));
            attn_tile<true>(kf, vf, qf, o, mrun, lrun, 2, tbl, dbase + fr - kt * 32 - fq * 8, false, 0, 0);
        }
    }
    attn_store_o(o, lrun, obase + qrow0 * ldo + ocol + h * 128, ldo, 2, fr, fq);
}

constexpr int LT_OFF = 98304, LT_WG = 64 * 144, LT_PAR = 2 * LT_WG;
DI void lru_tables_to_lds(const Params& p, LAS unsigned char* lt, int nblk, int tid) {
    const bf16_t* Wt = (const bf16_t*)(p.ws + W_LRU);
    for (int i = tid; i < 2 * 64 * 8; i += NWAVES * 64) { const int g = i >> 9, row = (i >> 3) & 63, seg = i & 7;
        *(LAS u32x4*)(lt + g * LT_WG + row * 144 + seg * 16) = *(const u32x4*)(Wt + (size_t)g * 65536 + (size_t)(nblk * 64 + row) * 64 + seg * 8); }
    for (int i = tid; i < 512; i += NWAVES * 64) { const int k = i >> 6, ch = nblk * 64 + (i & 63);
        const float v = k < 4 ? p.in[18][k * 1024 + ch] : (k == 4 ? p.in[19][ch] : (k == 5 ? p.in[21][ch] : (k == 6 ? p.in[23][ch] : ((const float*)(p.ws + W_C8))[ch])));
        ((LAS float*)(lt + LT_PAR))[i] = v; }
    __syncthreads();
}
template <int PASS>
DI void lru_unit(const Params& p, int seq, int chunk, int nblk, int lane, bf16_t* obase, unsigned opitch, unsigned ocol, const LAS unsigned char* lt) {
    unsigned char* ws = p.ws;
    const char* Ub = (const char*)(ws + W_U);
    const LAS float* par = (const LAS float*)(lt + LT_PAR);
    float* cA = (float*)(ws + W_CA); float* cB = (float*)(ws + W_CB);
    const bool is_s = seq >= NBATCH;
    const int sb = seq - NBATCH;
    const unsigned row0 = is_s ? (unsigned)MP + (unsigned)sb * STOK : (unsigned)seq * TSEQ;
    const int t0 = is_s ? 0 : chunk * 64, ntt = is_s ? 1 : 4;
    float hc[2][8], arun[2][8];
#pragma unroll
    for (int ks = 0; ks < 2; ++ks)
#pragma unroll
        for (int e = 0; e < 8; ++e) { hc[ks][e] = 0.f; arun[ks][e] = 1.f; }
    if (PASS == 1) {
        float H;
        if (is_s) H = p.in[5][(size_t)sb * 1024 + nblk * 64 + lane];
        else { H = 0.f;
            const float* pa = cA + (size_t)seq * 64 * 1024 + nblk * 64 + lane; const float* pb = cB + (size_t)seq * 64 * 1024 + nblk * 64 + lane;
            for (int c2 = 0; c2 < chunk; c2 += 8) {
                float ta[8], tb[8];
#pragma unroll
                for (int j = 0; j < 8; ++j) { const int cc = (c2 + j < chunk) ? c2 + j : chunk - 1; ta[j] = pa[(size_t)cc * 1024]; tb[j] = pb[(size_t)cc * 1024]; }
#pragma unroll
                for (int j = 0; j < 8; ++j) if (c2 + j < chunk) H = ta[j] * H + tb[j];
            } }
        const int fq0 = lane >> 4;
#pragma unroll
        for (int ks = 0; ks < 2; ++ks)
#pragma unroll
            for (int e = 0; e < 8; ++e) hc[ks][e] = __shfl(H, ks * 32 + fq0 * 8 + e);
    }
#pragma unroll 1
    for (int tt = 0; tt < ntt; ++tt) {
        int lo = lane; asm volatile("" : "+v"(lo) :: "memory");
        const int fr = lo & 15, fq = lo >> 4;
        const int t = t0 + tt * 16 + fr;
        const unsigned chb0 = (unsigned)(nblk * 64 + fq * 8);
        float xc[2][8]; bf16x8 xf[2];
#pragma unroll
        for (int ks = 0; ks < 2; ++ks) {
            const unsigned chb = chb0 + ks * 32;
            const int chl = ks * 32 + fq * 8;
            const f32x4 b0 = *(const LAS f32x4*)(par + 4 * 64 + chl), b1 = *(const LAS f32x4*)(par + 4 * 64 + chl + 4);
#pragma unroll
            for (int e = 0; e < 4; ++e) { xc[ks][e] = b0[e]; xc[ks][4 + e] = b1[e]; }
#pragma unroll
            for (int j = 0; j < 4; ++j) {
                const int tj = t - 3 + j;
                float xv[8];
                if (tj >= 0) unpack8(*(const u32x4*)(Ub + ((row0 + (unsigned)tj) * (unsigned)NU + OXR + chb) * 2u), xv);
                else if (is_s) { const char* sp = (const char*)p.in[4] + (((unsigned)sb * 3u + (unsigned)(3 + tj)) * 1024u + chb) * 4u; const f32x4 s0 = *(const f32x4*)sp, s1 = *(const f32x4*)(sp + 16);
#pragma unroll
                    for (int e = 0; e < 4; ++e) { xv[e] = s0[e]; xv[4 + e] = s1[e]; } }
                else {
#pragma unroll
                    for (int e = 0; e < 8; ++e) xv[e] = 0.f; }
                const f32x4 w0 = *(const LAS f32x4*)(par + j * 64 + chl), w1 = *(const LAS f32x4*)(par + j * 64 + chl + 4);
#pragma unroll
                for (int e = 0; e < 4; ++e) { xc[ks][e] += w0[e] * xv[e]; xc[ks][4 + e] += w1[e] * xv[4 + e]; }
            }
            xf[ks] = __builtin_bit_cast(bf16x8, pack8(xc[ks]));
        }
        float av[2][8], bv[2][8];
        const unsigned wbase = (unsigned)((fr >> 2) * 8 + (fr & 3)) * 144u + (unsigned)fq * 16u;
#pragma unroll
        for (int ct = 0; ct < 4; ++ct) {
            const int ks = ct >> 1, hq = ct & 1;
            const unsigned woff = wbase + (unsigned)((ks * 32 + hq * 4) * 144);
            f32x4 aa = (f32x4){0.f, 0.f, 0.f, 0.f}, ax = (f32x4){0.f, 0.f, 0.f, 0.f};
#pragma unroll
            for (int k2 = 0; k2 < 2; ++k2) {
                const bf16x8 wa = *(const LAS bf16x8*)(lt + woff + k2 * 64u), wx = *(const LAS bf16x8*)(lt + LT_WG + woff + k2 * 64u);
                aa = __builtin_amdgcn_mfma_f32_16x16x32_bf16(wa, xf[k2], aa, 0, 0, 0);
                ax = __builtin_amdgcn_mfma_f32_16x16x32_bf16(wx, xf[k2], ax, 0, 0, 0); }
            const int chq = ks * 32 + fq * 8 + hq * 4;
            const f32x4 ba4 = *(const LAS f32x4*)(par + 5 * 64 + chq), bx4 = *(const LAS f32x4*)(par + 6 * 64 + chq), c84 = *(const LAS f32x4*)(par + 7 * 64 + chq);
#pragma unroll
            for (int j = 0; j < 4; ++j) {
                const int e = hq * 4 + j;
                const float r = sigmoidf_(aa[j] + ba4[j]), ig = sigmoidf_(ax[j] + bx4[j]);
                const float a = fast_exp2(c84[j] * r);
                av[ks][e] = a; bv[ks][e] = sqrtf(fmaxf(1.0f - a * a, 0.f)) * ig * xc[ks][e];
            }
        }
#pragma unroll
        for (int ks = 0; ks < 2; ++ks)
#pragma unroll
            for (int e = 0; e < 8; ++e) {
                float a = av[ks][e], b = bv[ks][e], pa, pb;
                pa = dpp_shr<1>(1.f, a); pb = dpp_shr<1>(0.f, b); b = a * pb + b; a = a * pa;
                pa = dpp_shr<2>(1.f, a); pb = dpp_shr<2>(0.f, b); b = a * pb + b; a = a * pa;
                pa = dpp_shr<4>(1.f, a); pb = dpp_shr<4>(0.f, b); b = a * pb + b; a = a * pa;
                pa = dpp_shr<8>(1.f, a); pb = dpp_shr<8>(0.f, b); b = a * pb + b; a = a * pa;
                const float h = a * hc[ks][e] + b;
                bv[ks][e] = h; av[ks][e] = a;
            }
        const int l15 = (lo & 48) | 15;
        if (PASS == 1) {
#pragma unroll
            for (int ks = 0; ks < 2; ++ks) {
                const unsigned chb = chb0 + ks * 32;
                const char* gp = Ub + ((row0 + (unsigned)t) * (unsigned)NU + OGR + chb) * 2u;
                char* op = (char*)obase + ((row0 + (unsigned)t) * opitch + ocol + chb) * 2u;
                float gv[8], ov[8]; unpack8(*(const u32x4*)gp, gv);
#pragma unroll
                for (int e = 0; e < 8; ++e) { const float x = gv[e]; const float u2 = 1.5957691216057308f * (x + 0.044715f * x * x * x); ov[e] = x * fast_rcp(1.0f + fast_exp2(-u2 * LOG2E)) * bv[ks][e]; }
                *(u32x4*)op = pack8(ov);
                if (fr == 15 && tt == ntt - 1 && (is_s || chunk == 63)) {
                    float* lo2 = p.out + (is_s ? O_LS + (size_t)sb * 1024 : O_LP + (size_t)seq * 1024) + chb;
                    *(f32x4*)lo2 = (f32x4){bv[ks][0], bv[ks][1], bv[ks][2], bv[ks][3]}; *(f32x4*)(lo2 + 4) = (f32x4){bv[ks][4], bv[ks][5], bv[ks][6], bv[ks][7]};
                }
#pragma unroll
                for (int e = 0; e < 8; ++e) hc[ks][e] = __shfl(bv[ks][e], l15);
            }
        } else {
#pragma unroll
            for (int ks = 0; ks < 2; ++ks)
#pragma unroll
                for (int e = 0; e < 8; ++e) { hc[ks][e] = __shfl(bv[ks][e], l15); arun[ks][e] *= __shfl(av[ks][e], l15); }
        }
    }
    if (PASS == 0 && (lane & 15) == 0) {
        const int fq = lane >> 4;
#pragma unroll
        for (int ks = 0; ks < 2; ++ks) { const size_t o = ((size_t)seq * 64 + chunk) * 1024 + nblk * 64 + ks * 32 + fq * 8;
            *(f32x4*)(cA + o) = (f32x4){arun[ks][0], arun[ks][1], arun[ks][2], arun[ks][3]}; *(f32x4*)(cA + o + 4) = (f32x4){arun[ks][4], arun[ks][5], arun[ks][6], arun[ks][7]};
            *(f32x4*)(cB + o) = (f32x4){hc[ks][0], hc[ks][1], hc[ks][2], hc[ks][3]}; *(f32x4*)(cB + o + 4) = (f32x4){hc[ks][4], hc[ks][5], hc[ks][6], hc[ks][7]}; }
    }
}


DI void sample_cache_tasks(const Params& p, int first, int stride, int lane) {
    constexpr int T_KS = SBATCH * 512, T_VTS = SBATCH * 8 * 8;
    bf16_t* Ks = (bf16_t*)(p.ws + W_KS); bf16_t* Vts = (bf16_t*)(p.ws + W_VTS);
        for (int r = first; r < T_KS; r += stride) {
                const int b = r >> 9, j = r & 511;
                const float* src = p.in[2] + (size_t)r * 1024 + lane * 16;
                float t0[8], t1[8];
                { const f32x4 a = *(const f32x4*)src, c = *(const f32x4*)(src + 4), d = *(const f32x4*)(src + 8), e = *(const f32x4*)(src + 12);
                  t0[0] = a.x; t0[1] = a.y; t0[2] = a.z; t0[3] = a.w; t0[4] = c.x; t0[5] = c.y; t0[6] = c.z; t0[7] = c.w;
                  t1[0] = d.x; t1[1] = d.y; t1[2] = d.z; t1[3] = d.w; t1[4] = e.x; t1[5] = e.y; t1[6] = e.z; t1[7] = e.w; }
                bf16_t* kd = Ks + ((size_t)b * SKEYS + j) * 1024 + lane * 16;
                *(u32x4*)kd = pack8(t0); *(u32x4*)(kd + 8) = pack8(t1);


        }
        for (int r = first; r < T_VTS; r += stride) {
                const int b = r >> 6, h = (r >> 3) & 7, jg = r & 7, j = jg * 64 + lane;
                const float* src = p.in[3] + (((size_t)b * 512 + j) * 8 + h) * 128;
                bf16_t* dst = Vts + ((size_t)(b * 8 + h) * 128) * SKEYS + j;
#pragma unroll 4
                for (int dc = 0; dc < 32; ++dc) { const f32x4 v = *(const f32x4*)(src + dc * 4);
                    dst[(size_t)(dc * 4 + 0) * SKEYS] = (bf16_t)pk2(v.x, 0.f); dst[(size_t)(dc * 4 + 1) * SKEYS] = (bf16_t)pk2(v.y, 0.f);
                    dst[(size_t)(dc * 4 + 2) * SKEYS] = (bf16_t)pk2(v.z, 0.f); dst[(size_t)(dc * 4 + 3) * SKEYS] = (bf16_t)pk2(v.w, 0.f); }
                if (jg == 7 && lane < 16) { bf16_t* pz = Vts + ((size_t)(b * 8 + h) * 128) * SKEYS + 528 + lane;
                    for (int d = 0; d < 128; ++d) pz[(size_t)d * SKEYS] = 0; }


        }
}

DI void mem_tasks(const Params& p, int first, int stride, int lane) {
    const float* MKVF = (const float*)(p.ws + W_MKVF); bf16_t* Km = (bf16_t*)(p.ws + W_KM); bf16_t* Vtm = (bf16_t*)(p.ws + W_VTM);
        for (int r = first; r < 2048; r += stride) {
            const float* src = MKVF + (size_t)r * 1024 + lane * 8;
            const f32x4 k0 = *(const f32x4*)src, k1 = *(const f32x4*)(src + 4), v0 = *(const f32x4*)(src + 512), v1 = *(const f32x4*)(src + 516);
            float ss = (k0.x * k0.x + k0.y * k0.y + k0.z * k0.z + k0.w * k0.w) + (k1.x * k1.x + k1.y * k1.y + k1.z * k1.z + k1.w * k1.w);
            ss += __shfl_xor(ss, 1); ss += __shfl_xor(ss, 2); ss += __shfl_xor(ss, 4); ss += __shfl_xor(ss, 8);
            const float rs = rsqrtf(ss * (1.f / 128.f) + EPS);
            const f32x4 g0 = *(const f32x4*)(p.in[34] + (lane * 8) % 128), g1 = *(const f32x4*)(p.in[34] + (lane * 8) % 128 + 4);
            const f32x4 n0 = k0 * rs * g0, n1 = k1 * rs * g1;
            float* ko = p.out + O_MK + (size_t)r * 512 + lane * 8; *(f32x4*)ko = n0; *(f32x4*)(ko + 4) = n1;
            float* vo = p.out + O_MV + (size_t)r * 512 + lane * 8; *(f32x4*)vo = v0; *(f32x4*)(vo + 4) = v1;
            u32x4 w; w.x = pk2(n0.x, n0.y); w.y = pk2(n0.z, n0.w); w.z = pk2(n1.x, n1.y); w.w = pk2(n1.z, n1.w);
            *(u32x4*)(Km + (size_t)r * 512 + lane * 8) = w;
        }
        for (int r = first; r < SBATCH * 256; r += stride) {
            const float* src = p.in[6] + (size_t)r * 512 + lane * 8; const f32x4 k0 = *(const f32x4*)src, k1 = *(const f32x4*)(src + 4);
            u32x4 w; w.x = pk2(k0.x, k0.y); w.y = pk2(k0.z, k0.w); w.z = pk2(k1.x, k1.y); w.w = pk2(k1.z, k1.w);
            *(u32x4*)(Km + ((size_t)NBATCH * 256 + r) * 512 + lane * 8) = w;
        }
        for (int it = first; it < NSEQ * 4 * 4; it += stride) {
            const int seq = it >> 4, h = (it >> 2) & 3, j = (it & 3) * 64 + lane;
            const float* src = seq < NBATCH ? MKVF + ((size_t)seq * 256 + j) * 1024 + 512 + h * 128 : p.in[7] + (((size_t)(seq - NBATCH) * 256 + j) * 4 + h) * 128;
            bf16_t* dst = Vtm + ((size_t)(seq * 4 + h) * 128) * 256 + j;
#pragma unroll 4
            for (int dc = 0; dc < 32; ++dc) { const f32x4 v = *(const f32x4*)(src + dc * 4);
                dst[(size_t)(dc * 4 + 0) * 256] = (bf16_t)(pk2(v.x, 0.f)); dst[(size_t)(dc * 4 + 1) * 256] = (bf16_t)(pk2(v.y, 0.f));
                dst[(size_t)(dc * 4 + 2) * 256] = (bf16_t)(pk2(v.z, 0.f)); dst[(size_t)(dc * 4 + 3) * 256] = (bf16_t)(pk2(v.w, 0.f)); }
        }
}

#define XB_TMO      128
#define XB_XCNT(j)  (256  + 64 * (j))
#define XB_XSUB(j)  (1280 + 64 * (j))
#define XB_XGEN(j)  (2304 + 64 * (j))
#define XB_TOP      3328
#define XB_TOPGEN   3392
#define XCD_BAR_WORDS 3456
#define XB_SPIN_CAP (1u << 18)
DI unsigned xb_ld(unsigned* p)              { return __hip_atomic_load(p, __ATOMIC_RELAXED, __HIP_MEMORY_SCOPE_AGENT); }
DI unsigned xb_add(unsigned* p, unsigned v) { return __hip_atomic_fetch_add(p, v, __ATOMIC_RELAXED, __HIP_MEMORY_SCOPE_AGENT); }
DI unsigned xb_xcc_id() { return (unsigned)__builtin_amdgcn_s_getreg((3 << 11) | 20) & 0xFu; }
#define XB_SPIN(cond, bar) do { unsigned _sp = 0; while (cond) { __builtin_amdgcn_s_sleep(1); \
    if ((++_sp & 255u) == 0u) { if (xb_ld(&(bar)[XB_TMO])) break; if (_sp > XB_SPIN_CAP) { atomicAdd(&(bar)[XB_TMO], 1u); break; } } } } while (0)
struct XcdBarrier { unsigned* bar; unsigned x; volatile LAS unsigned* st; };
DI XcdBarrier xcd_barrier_post(unsigned* bar, volatile LAS unsigned* st) {
    XcdBarrier b; b.bar = bar; b.x = xb_xcc_id(); b.st = st;
    if (threadIdx.x == 0) (void)xb_add(&bar[XB_XCNT(b.x)], 1u);
    return b;
}
DI void xcd_barrier_complete(unsigned* bar, unsigned x, unsigned& nloc, unsigned& nx) {
    const unsigned G = gridDim.x * gridDim.y * gridDim.z;
    unsigned sum, cnt, mine, sp = 0u;
    for (;;) {
        sum = 0u; cnt = 0u; mine = 0u;
#pragma unroll
        for (unsigned j = 0; j < 16; ++j) { const unsigned c = xb_ld(&bar[XB_XCNT(j)]); sum += c; cnt += (c > 0u) ? 1u : 0u; mine = (j == x) ? c : mine; }
        if (sum == G) break;
        __builtin_amdgcn_s_sleep(1);
        if ((++sp & 255u) == 0u) { if (xb_ld(&bar[XB_TMO])) break; if (sp > XB_SPIN_CAP) { atomicAdd(&bar[XB_TMO], 1u); break; } }
    }
    nloc = mine > 0u ? mine : 1u; nx = cnt > 0u ? cnt : 1u;
}
DI void xcd_barrier(const XcdBarrier& b) {
    asm volatile("s_waitcnt vmcnt(0)" ::: "memory");
    __syncthreads();
    if (threadIdx.x == 0) {
        unsigned* bar = b.bar;
        __builtin_amdgcn_s_waitcnt(0);
        unsigned nloc = b.st[0], nx = b.st[1];
        if (nloc == 0u) { xcd_barrier_complete(bar, b.x, nloc, nx); b.st[0] = nloc; b.st[1] = nx; }
        const unsigned old = xb_add(&bar[XB_XSUB(b.x)], 1u);
        const unsigned gen = old / nloc;
        if (old + 1u == (gen + 1u) * nloc) {
            __builtin_amdgcn_fence(__ATOMIC_RELEASE, "agent");
            asm volatile("s_waitcnt vmcnt(0)" ::: "memory");
            const unsigned og = xb_add(&bar[XB_TOP], 1u);
            const unsigned tg = og / nx;
            if (og + 1u == (tg + 1u) * nx) xb_add(&bar[XB_TOPGEN], 1u);
            else XB_SPIN(xb_ld(&bar[XB_TOPGEN]) == tg, bar);
            __builtin_amdgcn_fence(__ATOMIC_ACQUIRE, "agent");
            xb_add(&bar[XB_XGEN(b.x)], 1u);
            asm volatile("s_waitcnt vmcnt(0)" ::: "memory");
        } else {
            XB_SPIN(xb_ld(&bar[XB_XGEN(b.x)]) == gen, bar);
            __builtin_amdgcn_fence(__ATOMIC_ACQUIRE, "agent");
            asm volatile("s_waitcnt vmcnt(0)" ::: "memory");
        }
    }
    __syncthreads();
}

__global__ void __launch_bounds__(NWAVES * 64, 2) fwd_megakernel(Params p) {
    extern __shared__ __attribute__((aligned(16))) unsigned char lds_raw[];
    cg::grid_group grid = cg::this_grid();
    LAS unsigned char* lds = (LAS unsigned char*)lds_raw;
#define PH_IDS int tid = threadIdx.x; asm volatile("" : "+v"(tid)); const int lane = tid & 63, wave = __builtin_amdgcn_readfirstlane(tid >> 6); \
    const int G = gridDim.x, gw = blockIdx.x * NWAVES + wave, NGW = G * NWAVES; (void)lane; (void)gw; (void)NGW; (void)G
    unsigned char* ws = p.ws;
    float* R = p.out;
    bf16_t* XN = (bf16_t*)(ws + W_XN); bf16_t* U = (bf16_t*)(ws + W_U); bf16_t* H = (bf16_t*)(ws + W_H);
    bf16_t* Vt = (bf16_t*)(ws + W_VT); bf16_t* Ks = (bf16_t*)(ws + W_KS); bf16_t* Vts = (bf16_t*)(ws + W_VTS);
    bf16_t* Km = (bf16_t*)(ws + W_KM); bf16_t* Vtm = (bf16_t*)(ws + W_VTM);
    bf16_t* MN = (bf16_t*)(ws + W_MN); float* MKVF = (float*)(ws + W_MKVF); bf16_t* MQ = (bf16_t*)(ws + W_MQB);

    for (int rep_ = 0; rep_ < 1 + ((REPM >> 0) & 1); ++rep_) { if (rep_) grid.sync(); PH_IDS;
        if (blockIdx.x == 0) for (int i = tid; i < 4096; i += NWAVES * 64) ((unsigned*)(ws + W_BAR))[i] = 0u;
        if (tid < 2) ((volatile LAS unsigned*)(lds + 131072 + 64))[tid] = 0u;
        LAS float* scr = (LAS float*)(lds + wave * 16384);
        constexpr int I_FU = (D / 64) * (FF / 32), I_FD = (FF / 64) * (D / 32), I_IN = (D / 64) * (NU / 32), I_P = (1024 / 64) * (D / 32), I_O = (D / 64) * (D / 32),
                      I_M = (D / 64) * (512 / 32), I_MO = (512 / 64) * (D / 32);
        constexpr int NITEMS = 4 * I_FU + 2 * I_FD + I_IN + 2 * I_P + I_O + 3 * I_M + I_MO;
        for (int it = gw; it < NITEMS; it += NGW) {
            int r = it;
#define TJ(IDX, KK, NN, OFF, SH, ADD, NI, GN) if (r < (NI)) { transpose_item(p.in[IDX], KK, NN, (bf16_t*)(ws + (OFF)), SH, ADD, scr, r, lane, GN); continue; } r -= (NI);
            TJ(10, D, FF, W_GU1, 8, 0, I_FU, nullptr) TJ(11, D, FF, W_GU1, 8, 128, I_FU, nullptr) TJ(12, FF, D, W_D1, 7, 0, I_FD, nullptr)
            TJ(37, D, FF, W_GU2, 8, 0, I_FU, p.in[36]) TJ(38, D, FF, W_GU2, 8, 128, I_FU, p.in[36]) TJ(39, FF, D, W_D2, 7, 0, I_FD, nullptr)
            TJ(14, D, NU, W_IN, 7, 0, I_IN, p.in[13]) TJ(25, 1024, D, W_PA, 7, 0, I_P, nullptr) TJ(26, 1024, D, W_PB, 7, 0, I_P, nullptr) TJ(27, D, D, W_OUT, 7, 0, I_O, nullptr)
            TJ(30, D, 512, W_MQ, 7, 0, I_M, p.in[28]) TJ(31, D, 512, W_MKV, 7, 0, I_M, nullptr) TJ(32, D, 512, W_MKV, 7, 512, I_M, nullptr)
            transpose_item(p.in[35], 512, D, (bf16_t*)(ws + W_MO), 7, 0, scr, r, lane, nullptr);
#undef TJ
        }
        for (int m = gw; m < MT; m += NGW) norm_row_bf16(m < MP ? p.in[0] + (size_t)m * D : p.in[1] + (size_t)(m - MP) * D, p.in[9], XN + (size_t)m * D, lane);
        for (int m = gw; m < 2048; m += NGW) norm_row_bf16(p.in[8] + (size_t)m * D, p.in[29], MN + (size_t)m * D, lane);
        {
            bf16_t* Wt = (bf16_t*)(ws + W_LRU); float* c8 = (float*)(ws + W_C8);
            for (int i = blockIdx.x * 512 + tid; i < 2 * 65536; i += G * 512) { const int gsel = i >> 16, n = (i >> 12) & 15, c = (i >> 6) & 63, k = i & 63;
                const float v = p.in[gsel ? 22 : 20][n * 4096 + k * 64 + c]; Wt[i] = (bf16_t)(pk2(v, 0.f) & 0xffffu); }
            for (int i = blockIdx.x * 512 + tid; i < 1024; i += G * 512) c8[i] = -8.0f * log1pf(expf(-p.in[24][i])) * LOG2E;
            float* ssz = (float*)(ws + W_SS);
            for (int i = blockIdx.x * 512 + tid; i < 3 * MT; i += G * 512) ssz[i] = 0.f;
            for (int i = blockIdx.x * 512 + tid; i < MS * D / 4; i += G * 512) ((f32x4*)(R + (size_t)MP * D))[i] = ((const f32x4*)p.in[1])[i];
        }
    }
    grid.sync();
    XcdBarrier xbar = xcd_barrier_post((unsigned*)(p.ws + W_BAR), (volatile LAS unsigned*)(lds + 131072 + 64));

    for (int rr = 0; rr < ((REPM >> 18) & 1) * 20; ++rr) grid.sync();
    for (int rep_ = 0; rep_ < 1 + ((REPM >> 1) & 1); ++rep_) { if (rep_) grid.sync(); PH_IDS;
        pg8::Gemm g{XN, (const bf16_t*)(ws + W_GU1), MT, 2 * FF, D, D, D}; pg8::StaticOrder S; S.init(MT, 2 * FF, G, (int)blockIdx.x);
        pg8::EpiSwiglu E{H, FF, nullptr};
        pg8::gemm_phase<pg8::EpiSwiglu, true>(lds, g, S, E, STAG);
        pg8::Gemm g2{MN, (const bf16_t*)(ws + W_MKV), 2048, 1024, D, D, D}; pg8::StaticOrder S2; S2.init(2048, 1024, G, (int)((blockIdx.x + 128) % G));
        pg8::EpiF32 E2{MKVF, 1024};
        pg8::gemm_phase<pg8::EpiF32, true>(lds, g2, S2, E2);
        if (G > 160 && (int)blockIdx.x >= 160) sample_cache_tasks(p, ((int)blockIdx.x - 160) * NWAVES + wave, (G - 160) * NWAVES, lane);
    }
    xcd_barrier(xbar);

    for (int rep_ = 0; rep_ < 1 + ((REPM >> 2) & 1); ++rep_) { if (rep_) grid.sync(); PH_IDS;
        pg8::Gemm g{H, (const bf16_t*)(ws + W_D1), MP, D, FF, FF, FF}; pg8::StaticOrder S; S.init(MP, D, G, (int)blockIdx.x);
        pg8::EpiResid E{R, p.in[0], p.in[1], XN, (float*)(ws + W_SS), 0.5f, 1};
        pg8::gemm_phase<pg8::EpiResid, true>(lds, g, S, E, STAG);
        pg8::Gemm gs{H + (size_t)MP * FF, (const bf16_t*)(ws + W_D1), MS, D, FF, FF, FF / 4}; pg8::SplitOrder Ss; Ss.init(MS, D, 4, G, (int)blockIdx.x);
        pg8::EpiResidAtomic Es{R + (size_t)MP * D, 0.5f};
        pg8::gemm_phase<pg8::EpiResidAtomic, true>(lds, gs, Ss, Es);
        if (G > 64 && (int)blockIdx.x >= 64) mem_tasks(p, ((int)blockIdx.x - 64) * NWAVES + wave, (G - 64) * NWAVES, lane);
    }
    xcd_barrier(xbar);

    for (int rep_ = 0; rep_ < 1 + ((REPM >> 3) & 1); ++rep_) { if (rep_) grid.sync(); PH_IDS;
        for (int m = MP + gw; m < MT; m += NGW) feed_row(R + (size_t)m * D, XN + (size_t)m * D, (float*)(ws + W_SS) + m, lane);
        if (G <= 64) mem_tasks(p, gw, NGW, lane);
    }
    xcd_barrier(xbar);

    for (int rep_ = 0; rep_ < 1 + ((REPM >> 4) & 1); ++rep_) { if (rep_) grid.sync(); PH_IDS;
        pg8::Gemm g{XN, (const bf16_t*)(ws + W_IN), MT, NU, D, D, D}; pg8::StaticOrder S; S.init(MT, NU, G, (int)blockIdx.x);
        pg8::EpiBf16 E{U, NU, (const float*)(ws + W_SS)};
        pg8::gemm_phase<pg8::EpiBf16, true>(lds, g, S, E, STAG);
    }
    xcd_barrier(xbar);

    for (int rep_ = 0; rep_ < 1 + ((REPM >> 5) & 1); ++rep_) { if (rep_) grid.sync(); PH_IDS;
        const bool dummy5 = ((REPM >> 5) & 1) && rep_ == 0;
        constexpr int T_ROWS = MT, T_VT = NBATCH * 64 * 8, T_KS = SBATCH * 512, T_VTS = SBATCH * 8 * 8, T_LRU = NBATCH * 64 * 16;
        for (int r = gw; r < T_ROWS; r += NGW) {
                const bool is_s = r >= MP; const int rs_ = r - MP;
                const int b = is_s ? (rs_ >> 4) : (r >> 12), t = is_s ? (rs_ & 15) : (r & 4095);
                bf16_t* urow = U + (size_t)r * NU;
                float kv[16], vv[16];
                { const u32x4 a = *(const u32x4*)(urow + OKK + lane * 16), c = *(const u32x4*)(urow + OKK + lane * 16 + 8);
                  float t0[8], t1[8]; unpack8(a, t0); unpack8(c, t1);
#pragma unroll
                  for (int i = 0; i < 8; ++i) { kv[i] = t0[i]; kv[8 + i] = t1[i]; } }
                { const u32x4 a = *(const u32x4*)(urow + OV + lane * 16), c = *(const u32x4*)(urow + OV + lane * 16 + 8);
                  float t0[8], t1[8]; unpack8(a, t0); unpack8(c, t1);
#pragma unroll
                  for (int i = 0; i < 8; ++i) { vv[i] = t0[i]; vv[8 + i] = t1[i]; } }
                float ss = 0.f;
#pragma unroll
                for (int i = 0; i < 16; ++i) ss += kv[i] * kv[i];
                ss += __shfl_xor(ss, 1); ss += __shfl_xor(ss, 2); ss += __shfl_xor(ss, 4);
                const float rstd = rsqrtf(ss * (1.f / 128.f) + EPS);
                const float* gp = p.in[16] + (lane * 16) % 128;
#pragma unroll
                for (int i = 0; i < 4; ++i) { const f32x4 gg = *(const f32x4*)(gp + 4 * i);
#pragma unroll
                    for (int j = 0; j < 4; ++j) kv[4 * i + j] *= rstd * gg[j]; }
                bf16_t* kd = is_s ? Ks + ((size_t)b * SKEYS + 512 + t) * 1024 + lane * 16 : (dummy5 ? XN + (size_t)r * 1024 + lane * 16 : urow + OKK + lane * 16);
                { float t0[8], t1[8];
#pragma unroll
                  for (int i = 0; i < 8; ++i) { t0[i] = kv[i]; t1[i] = kv[8 + i]; }
                  *(u32x4*)kd = pack8(t0); *(u32x4*)(kd + 8) = pack8(t1); }
                const bool wr_kv = is_s || t >= TSEQ - 512;
                if (wr_kv) {
                    const size_t ro = is_s ? (size_t)rs_ * 1024 : ((size_t)b * 512 + (t - (TSEQ - 512))) * 1024;
                    float* ko = p.out + (is_s ? O_KS : O_KP) + ro + lane * 16; float* vo = p.out + (is_s ? O_VS : O_VP) + ro + lane * 16;
#pragma unroll
                    for (int i = 0; i < 4; ++i) { *(f32x4*)(ko + 4 * i) = (f32x4){kv[4 * i], kv[4 * i + 1], kv[4 * i + 2], kv[4 * i + 3]}; *(f32x4*)(vo + 4 * i) = (f32x4){vv[4 * i], vv[4 * i + 1], vv[4 * i + 2], vv[4 * i + 3]}; }
                }
                const int tl = is_s ? STOK : TSEQ;
                if (t >= tl - 3) {
                    float xv[16];
                    { const u32x4 a = *(const u32x4*)(urow + OXR + lane * 16), c = *(const u32x4*)(urow + OXR + lane * 16 + 8);
                      float t0[8], t1[8]; unpack8(a, t0); unpack8(c, t1);
#pragma unroll
                      for (int i = 0; i < 8; ++i) { xv[i] = t0[i]; xv[8 + i] = t1[i]; } }
                    float* co = p.out + (is_s ? O_CS : O_CP) + ((size_t)b * 3 + (t - (tl - 3))) * 1024 + lane * 16;
#pragma unroll
                    for (int i = 0; i < 4; ++i) *(f32x4*)(co + 4 * i) = (f32x4){xv[4 * i], xv[4 * i + 1], xv[4 * i + 2], xv[4 * i + 3]};
                }
                if (is_s) {
                    const int h = lane >> 3, d0 = (lane & 7) * 16;
                    bf16_t* dst = Vts + ((size_t)(b * 8 + h) * 128 + d0) * SKEYS + 512 + t;
#pragma unroll
                    for (int i = 0; i < 16; ++i) dst[(size_t)i * SKEYS] = (bf16_t)pk2(vv[i], 0.f);
                }


        }
        for (int r = gw; r < T_VT; r += NGW) {
                const int b = r >> 9, c = (r >> 3) & 63, h = r & 7, t = c * 64 + lane;
                const bf16_t* src = U + ((size_t)b * TSEQ + t) * NU + OV + h * 128;
                bf16_t* dst = Vt + ((size_t)(b * 8 + h) * 128) * TSEQ + t;
#pragma unroll 4
                for (int dc = 0; dc < 16; ++dc) { const u32x4 w = *(const u32x4*)(src + dc * 8);
                    dst[(size_t)(dc * 8 + 0) * TSEQ] = (bf16_t)(w.x & 0xffffu); dst[(size_t)(dc * 8 + 1) * TSEQ] = (bf16_t)(w.x >> 16);
                    dst[(size_t)(dc * 8 + 2) * TSEQ] = (bf16_t)(w.y & 0xffffu); dst[(size_t)(dc * 8 + 3) * TSEQ] = (bf16_t)(w.y >> 16);
                    dst[(size_t)(dc * 8 + 4) * TSEQ] = (bf16_t)(w.z & 0xffffu); dst[(size_t)(dc * 8 + 5) * TSEQ] = (bf16_t)(w.z >> 16);
                    dst[(size_t)(dc * 8 + 6) * TSEQ] = (bf16_t)(w.w & 0xffffu); dst[(size_t)(dc * 8 + 7) * TSEQ] = (bf16_t)(w.w >> 16); }


        }
        if (G <= 160) sample_cache_tasks(p, gw, NGW, lane);
        {
            const int nblk = blockIdx.x & 15, slot = (blockIdx.x >> 4) * NWAVES + wave, nslot = (G >> 4) * NWAVES;
            __syncthreads();
            lru_tables_to_lds(p, lds + LT_OFF, nblk, tid);
            for (int rr = 0; rr < 1 + ((REPM >> 17) & 1) * 3; ++rr)
            for (int u = slot; u < NBATCH * 64; u += nslot) lru_unit<0>(p, u >> 6, u & 63, nblk, lane, nullptr, 0u, 0u, lds + LT_OFF);
            (void)T_LRU;
        }
    }
    xcd_barrier(xbar);

    for (int rep_ = 0; rep_ < 1 + ((REPM >> 6) & 1); ++rep_) { if (rep_) grid.sync(); PH_IDS;
        const bool dummy = ((REPM >> 6) & 1) && rep_ == 0;
        LAS float* tbl = (LAS float*)(lds + 65536);
        constexpr int T_AP = NBATCH * 64 * 8 * 2, T_AS = SBATCH * 8, T_LP = NBATCH * 64 * 16, T_LS = SBATCH * 16;
        for (int wt = blockIdx.x; wt < NBATCH * 8 * 16; wt += G) {
            int pair, cg4;
            if (G == 256) { const int itp = wt >> 8, x = blockIdx.x & 7, j = blockIdx.x >> 3; pair = x * 8 + itp * 2 + (j >> 4); cg4 = (j + itp * 4) & 15; }
            else { pair = wt >> 4; cg4 = wt & 15; }
            attn_wg_prompt(p, lds, pair >> 3, pair & 7, cg4, dummy ? XN : U, dummy ? 1024 : NU, dummy ? 0 : OQ, tid);
        }
        __syncthreads();
        for (int q = blockIdx.x; q < T_AS; q += G) if (wave == 0) {
            const int b = q >> 3, h = q & 7;
            for (int i = lane; i < 640; i += 64) { int d = i - 63; d = d < -256 ? -256 : (d > 256 ? 256 : d); tbl[i] = p.in[17][h * 513 + d + 256] * LOG2E; }
            asm volatile("s_waitcnt lgkmcnt(0)" ::: "memory");
            __builtin_amdgcn_wave_barrier();
            bf16_t* qp = U + ((size_t)MP + (size_t)b * STOK) * NU + OQ + h * 128;
            attn_task<true>(qp, NU, dummy ? XN + ((size_t)MP + (size_t)b * STOK) * 1024 + h * 128 : qp, dummy ? 1024 : NU, Ks + (size_t)b * SKEYS * 1024 + h * 128, 1024, Vts + ((size_t)(b * 8 + h) * 128) * SKEYS, SKEYS,
                            17, 528, 1, p.in[15], tbl, 1024 - 512 + 63, lane);
            asm volatile("s_waitcnt lgkmcnt(0)" ::: "memory");
            __builtin_amdgcn_wave_barrier();
        }
        {
            const int nblk = blockIdx.x & 15, slot = (blockIdx.x >> 4) * NWAVES + wave, nslot = (G >> 4) * NWAVES;
            __syncthreads();
            lru_tables_to_lds(p, lds + LT_OFF, nblk, tid);
            for (int u = slot; u < NBATCH * 64 + SBATCH; u += nslot) { const bool pr = u < NBATCH * 64;
                lru_unit<1>(p, pr ? (u >> 6) : NBATCH + (u - NBATCH * 64), pr ? (u & 63) : 0, nblk, lane, dummy ? XN + (size_t)MT * 1024 : U, dummy ? 1024u : (unsigned)NU, dummy ? 0u : (unsigned)OGR, lds + LT_OFF); }
            (void)T_LP; (void)T_LS;
        }
    }
    xcd_barrier(xbar);

    for (int rep_ = 0; rep_ < 1 + ((REPM >> 7) & 1); ++rep_) { if (rep_) grid.sync(); PH_IDS;
        pg8::StaticOrder S; S.init(MT, D, G, (int)blockIdx.x);
        pg8::Gemm g1{U + OQ, (const bf16_t*)(ws + W_PA), MT, D, 1024, NU, 1024};
        pg8::EpiGate E1{U + OGA, U + OGA, NU, 0};
        pg8::gemm_phase<pg8::EpiGate, true>(lds, g1, S, E1, STAG);
        pg8::Gemm g2{U + OGR, (const bf16_t*)(ws + W_PB), MT, D, 1024, NU, 1024};
        pg8::EpiGate E2{U + OGA, U + OGB, NU, 1};
        pg8::gemm_phase<pg8::EpiGate, true>(lds, g2, S, E2, 0);
    }
    xcd_barrier(xbar);

    for (int rep_ = 0; rep_ < 1 + ((REPM >> 8) & 1); ++rep_) { if (rep_) grid.sync(); PH_IDS;
        pg8::Gemm g{U + OGA, (const bf16_t*)(ws + W_OUT), MP, D, D, NU, D}; pg8::StaticOrder S; S.init(MP, D, G, (int)blockIdx.x);
        pg8::EpiResid E{R, nullptr, nullptr, XN, (float*)(ws + W_SS) + MT, 1.0f, 1};
        pg8::gemm_phase<pg8::EpiResid, true>(lds, g, S, E, STAG);
        pg8::Gemm gs{U + (size_t)MP * NU + OGA, (const bf16_t*)(ws + W_OUT), MS, D, D, NU, D / 4}; pg8::SplitOrder Ss; Ss.init(MS, D, 4, G, (int)blockIdx.x);
        pg8::EpiResidAtomic Es{R + (size_t)MP * D, 1.0f};
        pg8::gemm_phase<pg8::EpiResidAtomic, true>(lds, gs, Ss, Es);
    }
    xcd_barrier(xbar);

    for (int rep_ = 0; rep_ < 1 + ((REPM >> 9) & 1); ++rep_) { PH_IDS;
    for (int m = MP + gw; m < MT; m += NGW) feed_row(R + (size_t)m * D, XN + (size_t)m * D, (float*)(ws + W_SS) + MT + m, lane);
    for (int i = blockIdx.x * 512 + tid; i < MP; i += G * 512) ((float*)(ws + W_SS))[i] = 0.f; }
    xcd_barrier(xbar);

    for (int rep_ = 0; rep_ < 1 + ((REPM >> 10) & 1); ++rep_) { if (rep_) grid.sync(); PH_IDS;
        pg8::Gemm g{XN, (const bf16_t*)(ws + W_MQ), MT, 512, D, D, D}; pg8::StaticOrder S; S.init(MT, 512, G, (int)blockIdx.x);
        pg8::EpiBf16 E{MQ, 512, (const float*)(ws + W_SS) + MT};
        pg8::gemm_phase<pg8::EpiBf16, true>(lds, g, S, E, 0);
    }
    xcd_barrier(xbar);

    for (int rep_ = 0; rep_ < 1 + ((REPM >> 11) & 1); ++rep_) { if (rep_) grid.sync(); PH_IDS;
        constexpr int T_P = (MP / 32) * 4, T_S = SBATCH * 4;
        for (int it = gw; it < T_P + T_S; it += NGW) {
            if (it < T_P) { const int rt = it >> 2, h = it & 3, seq = rt >> 7;
                bf16_t* qp = MQ + (size_t)rt * 32 * 512 + h * 128;
                attn_task<false>(qp, 512, qp, 512, Km + (size_t)seq * 256 * 512 + h * 128, 512, Vtm + ((size_t)(seq * 4 + h) * 128) * 256, 256, 8, 256, 2, p.in[33], nullptr, 0, lane);
            } else { const int q = it - T_P, b = q >> 2, h = q & 3, seq = NBATCH + b;
                bf16_t* qp = MQ + ((size_t)MP + (size_t)b * STOK) * 512 + h * 128;
                attn_task<false>(qp, 512, qp, 512, Km + (size_t)seq * 256 * 512 + h * 128, 512, Vtm + ((size_t)(seq * 4 + h) * 128) * 256, 256, 8, 256, 1, p.in[33], nullptr, 0, lane);
            }
        }
    }
    xcd_barrier(xbar);

    for (int rep_ = 0; rep_ < 1 + ((REPM >> 12) & 1); ++rep_) { if (rep_) grid.sync(); PH_IDS;
        pg8::Gemm g{MQ, (const bf16_t*)(ws + W_MO), MT, D, 512, 512, 512}; pg8::StaticOrder S; S.init(MT, D, G, (int)blockIdx.x);
        pg8::EpiResid E{R, nullptr, nullptr, XN, (float*)(ws + W_SS) + 2 * MT, 1.0f, 1};
        pg8::gemm_phase<pg8::EpiResid, true>(lds, g, S, E, 0);
    }
    xcd_barrier(xbar);

    for (int rep_ = 0; rep_ < 1 + ((REPM >> 14) & 1); ++rep_) { if (rep_) grid.sync(); PH_IDS;
        pg8::Gemm g{XN, (const bf16_t*)(ws + W_GU2), MT, 2 * FF, D, D, D}; pg8::StaticOrder S; S.init(MT, 2 * FF, G, (int)blockIdx.x);
        pg8::EpiSwiglu E{H, FF, (const float*)(ws + W_SS) + 2 * MT};
        pg8::gemm_phase<pg8::EpiSwiglu, true>(lds, g, S, E, STAG);
    }
    xcd_barrier(xbar);

    for (int rep_ = 0; rep_ < 1 + ((REPM >> 15) & 1); ++rep_) { if (rep_) grid.sync(); PH_IDS;
        pg8::Gemm g{H, (const bf16_t*)(ws + W_D2), MP, D, FF, FF, FF}; pg8::StaticOrder S; S.init(MP, D, G, (int)blockIdx.x);
        pg8::EpiResid E{R, nullptr, nullptr, XN, (float*)(ws + W_SS), 0.5f, 0};
        pg8::gemm_phase<pg8::EpiResid, true>(lds, g, S, E, STAG);
        pg8::Gemm gs{H + (size_t)MP * FF, (const bf16_t*)(ws + W_D2), MS, D, FF, FF, FF / 4}; pg8::SplitOrder Ss; Ss.init(MS, D, 4, G, (int)blockIdx.x);
        pg8::EpiResidAtomic Es{R + (size_t)MP * D, 0.5f};
        pg8::gemm_phase<pg8::EpiResidAtomic, true>(lds, gs, Ss, Es);
    }
    xcd_barrier(xbar);

    for (int rep_ = 0; rep_ < 1 + ((REPM >> 16) & 1); ++rep_) { PH_IDS;
    for (int m = gw; m < MT; m += NGW) {
        if (m >= MP) { norm_row_f32(R + (size_t)m * D, p.in[40], lane); continue; }
        const float rs = rsqrtf(((const float*)(ws + W_SS))[m] * (1.f / D) + EPS);
        const u32x2* xb = (const u32x2*)(XN + (size_t)m * D) + lane; f32x4* yo = (f32x4*)(R + (size_t)m * D) + lane;
#pragma unroll
        for (int j = 0; j < 8; ++j) { const u32x2 w = xb[64 * j]; const f32x4 gg = ((const f32x4*)p.in[40])[lane + 64 * j];
            yo[64 * j] = (f32x4){bf_lo(w.x) * rs * gg.x, bf_hi(w.x) * rs * gg.y, bf_lo(w.y) * rs * gg.z, bf_hi(w.y) * rs * gg.w}; }
    } }
}

extern "C" void kernel_launch(void* const* d_in, const int* in_sizes, int n_in, void* d_out, int out_size, void* d_ws, size_t ws_size, hipStream_t stream) {
    static int grid = 0;
    if (grid == 0) {
        if (n_in != 41 || (size_t)out_size != O_END || ws_size < W_END) {
            fprintf(stderr, "kernel_launch: unexpected sizes: n_in %d out %d (want %zu) ws %zu (want >= %zu)\n", n_in, out_size, (size_t)O_END, ws_size, (size_t)W_END); grid = -1; return; }
        int dev = 0, cus = 0, per_cu = 0;
        hipGetDevice(&dev); hipDeviceGetAttribute(&cus, hipDeviceAttributeMultiprocessorCount, dev);
        hipFuncSetAttribute((const void*)fwd_megakernel, hipFuncAttributeMaxDynamicSharedMemorySize, LDS_BYTES);
        hipOccupancyMaxActiveBlocksPerMultiprocessor(&per_cu, (const void*)fwd_megakernel, NWAVES * 64, LDS_BYTES);
        if (per_cu < 1) { fprintf(stderr, "kernel_launch: occupancy query says %d blocks per CU\n", per_cu); per_cu = 1; }
        (void)hipGetLastError();
        grid = cus * 1;
    }
    if (grid < 0) return;
    Params p{};
    for (int i = 0; i < 41; ++i) p.in[i] = (const float*)d_in[i];
    p.out = (float*)d_out; p.ws = (unsigned char*)d_ws;
    void* args[] = {&p};
    hipError_t e = hipLaunchCooperativeKernel((const void*)fwd_megakernel, dim3(grid), dim3(NWAVES * 64), args, LDS_BYTES, stream);
    if (e != hipSuccess) fprintf(stderr, "kernel_launch: cooperative launch failed: %s (grid %d)\n", hipGetErrorString(e), grid);
}
```

```cpp
#include <hip/hip_runtime.h>
#include <hip/hip_cooperative_groups.h>
#include <cstdio>
#include <cstdint>
namespace cg = cooperative_groups;

#define LAS __attribute__((address_space(3)))
typedef unsigned short bf16_t;
typedef short bf16x8 __attribute__((ext_vector_type(8)));
typedef float f32x4 __attribute__((ext_vector_type(4)));
typedef float f32x2 __attribute__((ext_vector_type(2)));
typedef unsigned u32x4 __attribute__((ext_vector_type(4)));
typedef unsigned u32x2 __attribute__((ext_vector_type(2)));
typedef __bf16 bf16x2_t __attribute__((ext_vector_type(2)));
#define DI __device__ __forceinline__

constexpr int D = 2048, NBATCH = 8, TSEQ = 4096, MP = NBATCH * TSEQ, SBATCH = 32, STOK = 16, MS = SBATCH * STOK, MT = MP + MS;
constexpr int FF = 5632, NU = 9216, NWAVES = 8;
constexpr int OQ = 0, OKK = 1024, OV = 2048, OXR = 3072, OGR = 4096, OGA = 5120, OGB = 7168;
constexpr int SKEYS = 544;
constexpr float EPS = 1e-6f, LOG2E = 1.4426950408889634f;
constexpr int NSEQ = NBATCH + SBATCH;

constexpr size_t O_YP = 0, O_YS = (size_t)MP * D, O_KP = O_YS + (size_t)MS * D, O_VP = O_KP + (size_t)NBATCH * 512 * 1024,
                 O_CP = O_VP + (size_t)NBATCH * 512 * 1024, O_LP = O_CP + (size_t)NBATCH * 3 * 1024, O_MK = O_LP + (size_t)NBATCH * 1024,
                 O_MV = O_MK + (size_t)NBATCH * 256 * 512, O_KS = O_MV + (size_t)NBATCH * 256 * 512, O_VS = O_KS + (size_t)MS * 1024,
                 O_CS = O_VS + (size_t)MS * 1024, O_LS = O_CS + (size_t)SBATCH * 3 * 1024, O_END = O_LS + (size_t)SBATCH * 1024;

constexpr size_t al256(size_t x) { return (x + 255) & ~(size_t)255; }
constexpr size_t W_GU1 = 0, W_D1 = W_GU1 + (size_t)2 * FF * D * 2, W_IN = W_D1 + (size_t)D * FF * 2, W_PA = W_IN + (size_t)NU * D * 2,
                 W_PB = W_PA + (size_t)D * 1024 * 2, W_OUT = W_PB + (size_t)D * 1024 * 2, W_MQ = W_OUT + (size_t)D * D * 2, W_MKV = W_MQ + (size_t)512 * D * 2,
                 W_MO = W_MKV + (size_t)1024 * D * 2, W_GU2 = W_MO + (size_t)D * 512 * 2, W_D2 = W_GU2 + (size_t)2 * FF * D * 2, W_LRU = W_D2 + (size_t)D * FF * 2,
                 W_C8 = W_LRU + (size_t)2 * 16 * 64 * 64 * 2, W_XN = al256(W_C8 + 1024 * 4), W_U = W_XN + (size_t)MT * D * 2, W_VT = W_U + (size_t)MT * NU * 2,
                 W_KS = W_VT + (size_t)NBATCH * 8 * 128 * TSEQ * 2, W_VTS = W_KS + (size_t)SBATCH * SKEYS * 1024 * 2, W_KM = W_VTS + (size_t)SBATCH * 8 * 128 * SKEYS * 2,
                 W_VTM = W_KM + (size_t)NSEQ * 256 * 512 * 2, W_CA = W_VTM + (size_t)NSEQ * 4 * 128 * 256 * 2, W_CB = W_CA + (size_t)NBATCH * 64 * 1024 * 4,
                 W_SS = W_CB + (size_t)NBATCH * 64 * 1024 * 4, W_BAR = al256(W_SS + (size_t)3 * MT * 4), W_END = W_BAR + 16384;
constexpr size_t W_H = W_U, W_MQB = W_U, W_MN = W_VT, W_MKVF = W_MN + (size_t)2048 * D * 2;

#ifndef STAG
#define STAG 0
#endif
#ifndef REPM
#define REPM 0
#endif
constexpr int RING_BYTES = 131072, LDS_BYTES = 147456;

struct Params { const float* in[41]; float* out; unsigned char* ws; };

DI unsigned pk2(float a, float b) { f32x2 v = {a, b}; bf16x2_t r = __builtin_convertvector(v, bf16x2_t); return __builtin_bit_cast(unsigned, r); }
DI float bf_lo(unsigned w) { return __builtin_bit_cast(float, w << 16); }
DI float bf_hi(unsigned w) { return __builtin_bit_cast(float, w & 0xffff0000u); }
DI void unpack8(const u32x4 w, float (&f)[8]) { f[0] = bf_lo(w.x); f[1] = bf_hi(w.x); f[2] = bf_lo(w.y); f[3] = bf_hi(w.y); f[4] = bf_lo(w.z); f[5] = bf_hi(w.z); f[6] = bf_lo(w.w); f[7] = bf_hi(w.w); }
DI u32x4 pack8(const float (&f)[8]) { u32x4 w; w.x = pk2(f[0], f[1]); w.y = pk2(f[2], f[3]); w.z = pk2(f[4], f[5]); w.w = pk2(f[6], f[7]); return w; }
DI float wave_sum(float v) {
#pragma unroll
    for (int o = 1; o < 64; o <<= 1) v += __shfl_xor(v, o);
    return v;
}
DI float fast_exp2(float x) { return __builtin_amdgcn_exp2f(x); }
DI float fast_rcp(float x) { return __builtin_amdgcn_rcpf(x); }
DI float sigmoidf_(float x) { return fast_rcp(1.0f + fast_exp2(-x * LOG2E)); }
template <int S> DI float dpp_shr(float old, float v) {
    return __builtin_bit_cast(float, __builtin_amdgcn_update_dpp(__builtin_bit_cast(int, old), __builtin_bit_cast(int, v), 0x110 + S, 0xf, 0xf, false));
}
#define LDS_WAIT() asm volatile("s_waitcnt lgkmcnt(0)" ::: "memory")

namespace pg8 {
constexpr int BM = 256, BK = 64, HALF = 128, HTB = HALF * BK * 2, STAGE_BYTES = 8 * HTB, NXCD = 8, WGM = 8;
DI int lds_byte(int r, int c) { const int st = (r >> 4) * 2 + (c >> 5), rr = r & 15, cc = c & 31, ob = rr * 64 + cc * 2; return st * 1024 + (ob ^ (((ob >> 9) & 1) << 5)); }
DI void stage_rc(int b, int& R, int& C) { const int st = b / 1024, sb = b % 1024, swz = sb ^ (((sb >> 9) & 1) << 5); R = (st >> 1) * 16 + swz / 64; C = (st & 1) * 32 + (swz % 64) / 2; }
DI int perm32(int rho) { const int n = rho >> 4, i = rho & 15; return 8 * (i >> 2) + 4 * n + (i & 3); }
struct Unit { int pm, pn, ks; };
struct Gemm { const bf16_t* A; const bf16_t* Bt; int M, N, K, lda, kloop; };
struct StaticOrder {
    int nM, nN, nwg, G, c;
    DI void init(int M, int N, int G_, int c_) { nM = M / BM; nN = N / BM; nwg = nM * nN; G = G_; c = c_; }
    DI bool next(int i, Unit& u) const {
        const long L = (long)i * G + c; if (L >= nwg) return false;
        int wgid = (int)L; { const int q = nwg / NXCD, r = nwg % NXCD, xcd = wgid % NXCD, off = wgid / NXCD; wgid = (xcd < r ? xcd * (q + 1) : r * (q + 1) + (xcd - r) * q) + off; }
        const int nig = WGM * nN, gid = wgid / nig, fm = gid * WGM, gsz = (nM - fm) < WGM ? (nM - fm) : WGM;
        u.pm = fm + ((wgid % nig) % gsz); u.pn = (wgid % nig) / gsz; u.ks = 0; return true;
    }
};
struct SplitOrder {
    int nM, nN, ntot, G, c;
    DI void init(int M, int N, int nsplit, int G_, int c_) { nM = M / BM; nN = N / BM; ntot = nM * nN * nsplit; G = G_; c = c_; }
    DI bool next(int i, Unit& u) const {
        const int L = i * G + c; if (L >= ntot) return false;
        u.pm = L % nM; const int r = L / nM; u.pn = r % nN; u.ks = r / nN; return true;
    }
};
typedef f32x4 Acc[2][2][4][2];

struct EpiBf16 {
    static constexpr bool PERM = true;
    bf16_t* O; int ldc; const float* ss;
    DI void operator()(const Acc& acc, const Unit& u, int wr, int wc, int fr, int fq) const {
        const int row0 = u.pm * BM + wr * 64 + fr, col0 = u.pn * BM + wc * 32 + 8 * fq;
#pragma unroll
        for (int ai = 0; ai < 2; ++ai)
#pragma unroll
            for (int m = 0; m < 4; ++m) { bf16_t* rowp = O + (size_t)(row0 + ai * HALF + m * 16) * ldc + col0;
                const float rs = ss ? rsqrtf(ss[row0 + ai * HALF + m * 16] * (1.f / D) + EPS) : 1.f;
#pragma unroll
                for (int bj = 0; bj < 2; ++bj) { const f32x4 v0 = acc[ai][bj][m][0] * rs, v1 = acc[ai][bj][m][1] * rs;
                    u32x4 w; w.x = pk2(v0[0], v0[1]); w.y = pk2(v0[2], v0[3]); w.z = pk2(v1[0], v1[1]); w.w = pk2(v1[2], v1[3]);
                    *(u32x4*)(rowp + bj * HALF) = w; } }
    }
};
struct EpiSwiglu {
    static constexpr bool PERM = true;
    bf16_t* O; int ldc; const float* ss;
    DI void operator()(const Acc& acc, const Unit& u, int wr, int wc, int fr, int fq) const {
        const int row0 = u.pm * BM + wr * 64 + fr, col0 = u.pn * HALF + wc * 32 + 8 * fq;
#pragma unroll
        for (int ai = 0; ai < 2; ++ai)
#pragma unroll
            for (int m = 0; m < 4; ++m) {
                const float rs = ss ? rsqrtf(ss[row0 + ai * HALF + m * 16] * (1.f / D) + EPS) : 1.f;
                float h[8];
#pragma unroll
                for (int n = 0; n < 2; ++n)
#pragma unroll
                    for (int j = 0; j < 4; ++j) { const float g = acc[ai][0][m][n][j] * rs, up = acc[ai][1][m][n][j] * rs; h[n * 4 + j] = g * sigmoidf_(g) * up; }
                *(u32x4*)(O + (size_t)(row0 + ai * HALF + m * 16) * ldc + col0) = pack8(h); }
    }
};
struct EpiGate {
    static constexpr bool PERM = true;
    bf16_t* O; const bf16_t* G; int ld; int accum;
    DI void operator()(const Acc& acc, const Unit& u, int wr, int wc, int fr, int fq) const {
        const int row0 = u.pm * BM + wr * 64 + fr, col0 = u.pn * BM + wc * 32 + 8 * fq;
#pragma unroll
        for (int ai = 0; ai < 2; ++ai)
#pragma unroll
            for (int m = 0; m < 4; ++m)
#pragma unroll
                for (int bj = 0; bj < 2; ++bj) {
                    const size_t off = (size_t)(row0 + ai * HALF + m * 16) * ld + col0 + bj * HALF;
                    float gv[8], o[8]; unpack8(*(const u32x4*)(G + off), gv);
                    if (accum) unpack8(*(const u32x4*)(O + off), o);
                    else {
#pragma unroll
                        for (int i = 0; i < 8; ++i) o[i] = 0.f; }
#pragma unroll
                    for (int n = 0; n < 2; ++n)
#pragma unroll
                        for (int j = 0; j < 4; ++j) o[n * 4 + j] += sigmoidf_(gv[n * 4 + j]) * acc[ai][bj][m][n][j];
                    *(u32x4*)(O + off) = pack8(o); }
    }
};
struct EpiResid {
    static constexpr bool PERM = false;
    float* R; const float* xp; bf16_t* Xb; float* ss; float alpha;
    DI void operator()(const Acc& acc, const Unit& u, int wr, int wc, int fr, int fq) const {
        const float al = alpha; bf16_t* const xb = Xb; float* const ssp = ss; const float* const xin = xp; float* const rf = R;
        const int row0 = u.pm * BM + wr * 64 + fr, col0 = u.pn * BM + wc * 32 + 4 * fq;
        const bool smp = u.pm * BM >= MP;
#pragma unroll
        for (int ai = 0; ai < 2; ++ai)
#pragma unroll
            for (int m = 0; m < 4; ++m) { const int row = row0 + ai * HALF + m * 16;
                const size_t ro = (size_t)row * D + col0;
                float sq = 0.f;
#pragma unroll
                for (int bj = 0; bj < 2; ++bj)
#pragma unroll
                    for (int n = 0; n < 2; ++n) { const size_t o = ro + bj * HALF + n * 16;
                        f32x4 b;
                        if (smp) b = *(const f32x4*)(rf + o);
                        else if (xin) b = *(const f32x4*)(xin + o);
                        else { const u32x2 w0 = *(const u32x2*)(xb + o); b = (f32x4){bf_lo(w0.x), bf_hi(w0.x), bf_lo(w0.y), bf_hi(w0.y)}; }
                        const f32x4 a4 = acc[ai][bj][m][n];
                        f32x4 v; v[0] = b[0] + al * a4[0]; v[1] = b[1] + al * a4[1]; v[2] = b[2] + al * a4[2]; v[3] = b[3] + al * a4[3];
                        if (smp) *(f32x4*)(rf + o) = v;
                        u32x2 w; w.x = pk2(v[0], v[1]); w.y = pk2(v[2], v[3]); *(u32x2*)(xb + o) = w;
                        sq += (v[0] * v[0] + v[1] * v[1]) + (v[2] * v[2] + v[3] * v[3]); }
                sq += __shfl_xor(sq, 16); sq += __shfl_xor(sq, 32); if (fq == 0) unsafeAtomicAdd(ssp + row, sq); }
    }
};
struct EpiResidAtomic {
    static constexpr bool PERM = false;
    float* R; float alpha;
    DI void operator()(const Acc& acc, const Unit& u, int wr, int wc, int fr, int fq) const {
        const int row0 = u.pm * BM + wr * 64 + fr, col0 = u.pn * BM + wc * 32 + 4 * fq;
#pragma unroll
        for (int ai = 0; ai < 2; ++ai)
#pragma unroll
            for (int m = 0; m < 4; ++m) { float* rp = R + (size_t)(row0 + ai * HALF + m * 16) * D + col0;
#pragma unroll
                for (int bj = 0; bj < 2; ++bj)
#pragma unroll
                    for (int n = 0; n < 2; ++n)
#pragma unroll
                        for (int j = 0; j < 4; ++j) unsafeAtomicAdd(rp + bj * HALF + n * 16 + j, alpha * acc[ai][bj][m][n][j]); }
    }
};
struct EpiF32 {
    static constexpr bool PERM = false;
    float* C; int ldc;
    DI void operator()(const Acc& acc, const Unit& u, int wr, int wc, int fr, int fq) const {
        const int row0 = u.pm * BM + wr * 64 + fr, col0 = u.pn * BM + wc * 32 + 4 * fq;
#pragma unroll
        for (int ai = 0; ai < 2; ++ai)
#pragma unroll
            for (int m = 0; m < 4; ++m) { float* rp = C + (size_t)(row0 + ai * HALF + m * 16) * ldc + col0;
#pragma unroll
                for (int bj = 0; bj < 2; ++bj)
#pragma unroll
                    for (int n = 0; n < 2; ++n) *(f32x4*)(rp + bj * HALF + n * 16) = acc[ai][bj][m][n]; }
    }
};

template <class Epi, bool ALIGN_EPI, class Sched>
DI void gemm_phase(LAS unsigned char* lds, const Gemm g, const Sched& S, const Epi& E, int stag = 0) {
    int tid = threadIdx.x; asm volatile("" : "+v"(tid));
    const int wid = __builtin_amdgcn_readfirstlane(tid >> 6), lane = tid & 63, wr = wid >> 2, wc = wid & 3, fr = lane & 15, fq = lane >> 4;
    const int K = g.K, nt = g.kloop / BK;
    const size_t ksl = (size_t)g.kloop * 2;
    unsigned voffA[2], voffB[2];
#pragma unroll
    for (int i = 0; i < 2; ++i) { int R, C; stage_rc(tid * 16 + i * 8192, R, C); const int Rb = Epi::PERM ? ((R & ~31) + perm32(R & 31)) : R;
        voffA[i] = (unsigned)(R * g.lda + C) * 2u; voffB[i] = (unsigned)(Rb * K + C) * 2u; }
    const size_t kstep = (size_t)(BK * 2);
    const size_t hstepA = (size_t)HALF * g.lda * 2, hstepB = (size_t)HALF * K * 2;
    const size_t tstepA = 2 * hstepA, tstepB = 2 * hstepB;
    const unsigned ldsw = (unsigned)wid * 1024u;
    const int aoff = lds_byte(wr * 64 + fr, fq * 8), boff = lds_byte(wc * 32 + fr, fq * 8);
#define PG8_SA(b, h) (((b) * 2 + (h)) * HTB)
#define PG8_SB(b, h) ((4 + (b) * 2 + (h)) * HTB)
#define PG8_STAGE(bufoff, gbase, voff) do { _Pragma("unroll") for (int _i = 0; _i < 2; ++_i) \
        __builtin_amdgcn_global_load_lds((const unsigned*)((const char*)(gbase) + (voff)[_i]), (LAS unsigned*)(lds + (bufoff) + ldsw + _i * 8192), 16, 0, 0); } while (0)
#define PG8_LDA(dst, b, h) do { _Pragma("unroll") for (int m = 0; m < 4; ++m) _Pragma("unroll") for (int k = 0; k < 2; ++k) dst[m][k] = *(const LAS bf16x8*)(lds + PG8_SA(b, h) + aoff + m * 2048 + k * 1024); } while (0)
#define PG8_LDB(dst, b, h) do { _Pragma("unroll") for (int n = 0; n < 2; ++n) _Pragma("unroll") for (int k = 0; k < 2; ++k) dst[n][k] = *(const LAS bf16x8*)(lds + PG8_SB(b, h) + boff + n * 2048 + k * 1024); } while (0)
#define PG8_MMA(ai, bj, At, Bt) do { __builtin_amdgcn_s_setprio(1); _Pragma("unroll") for (int m = 0; m < 4; ++m) _Pragma("unroll") for (int n = 0; n < 2; ++n) _Pragma("unroll") for (int k = 0; k < 2; ++k) \
        acc[ai][bj][m][n] = __builtin_amdgcn_mfma_f32_16x16x32_bf16(Bt[n][k], At[m][k], acc[ai][bj][m][n], 0, 0, 0); __builtin_amdgcn_s_setprio(0); } while (0)
#define PG8_WAIT_V(n) asm volatile("s_waitcnt vmcnt(" #n ")" ::: "memory")
#define PG8_WAIT_L(n) asm volatile("s_waitcnt lgkmcnt(" #n ")" ::: "memory")
#define PG8_BAR __builtin_amdgcn_s_barrier()
#define PG8_SCHED __builtin_amdgcn_sched_barrier(0)
    Unit cur, nxt; int ui = 0;
    if (!S.next(0, cur)) return;
    if (stag) {
        const unsigned long long t0 = __builtin_amdgcn_s_memrealtime(), dl = (unsigned long long)((blockIdx.x >> 5) & 7) * (unsigned)stag;
        while (__builtin_amdgcn_s_memrealtime() - t0 < dl) __builtin_amdgcn_s_sleep(8);
    }
    Acc acc;
#pragma unroll
    for (int a = 0; a < 2; ++a)
#pragma unroll
        for (int b = 0; b < 2; ++b)
#pragma unroll
            for (int m = 0; m < 4; ++m)
#pragma unroll
                for (int n = 0; n < 2; ++n) acc[a][b][m][n] = (f32x4){0.f, 0.f, 0.f, 0.f};
    bf16x8 At[4][2], B0[2][2], B1[2][2];
    const char* cA = (const char*)g.A + (size_t)cur.pm * tstepA + (size_t)cur.ks * ksl; const char* cB = (const char*)g.Bt + (size_t)cur.pn * tstepB + (size_t)cur.ks * ksl;
    PG8_STAGE(PG8_SB(0, 0), cB, voffB); PG8_STAGE(PG8_SB(0, 1), cB + hstepB, voffB); PG8_STAGE(PG8_SA(0, 0), cA, voffA); PG8_STAGE(PG8_SA(0, 1), cA + hstepA, voffA);
    if (wr == 1) PG8_BAR;
    PG8_WAIT_V(2); PG8_BAR;
    PG8_STAGE(PG8_SB(1, 0), cB + kstep, voffB); PG8_STAGE(PG8_SA(1, 0), cA + kstep, voffA); PG8_STAGE(PG8_SB(1, 1), cB + hstepB + kstep, voffB);
    PG8_WAIT_V(6); PG8_BAR;
    for (;;) {
        const bool has_next = S.next(ui + 1, nxt);
        const char* nA = has_next ? (const char*)g.A + (size_t)nxt.pm * tstepA + (size_t)nxt.ks * ksl : cA; const char* nB = has_next ? (const char*)g.Bt + (size_t)nxt.pn * tstepB + (size_t)nxt.ks * ksl : cB;
        for (int t = 0; t < nt; t += 2) {
            const bool last = (t == nt - 2);
            const char* a1 = cA + (size_t)(t + 1) * kstep;
            const char* a2 = last ? nA : cA + (size_t)(t + 2) * kstep; const char* b2 = last ? nB : cB + (size_t)(t + 2) * kstep;
            const char* a3 = a2 + kstep; const char* b3 = b2 + kstep;
            PG8_LDB(B0, 0, 0); PG8_LDB(B1, 0, 1); PG8_SCHED; PG8_LDA(At, 0, 0); PG8_STAGE(PG8_SA(1, 1), a1 + hstepA, voffA);
            PG8_WAIT_V(8); PG8_WAIT_L(0); PG8_BAR; PG8_MMA(0, 0, At, B0); PG8_MMA(0, 1, At, B1); PG8_BAR; PG8_SCHED;
            PG8_LDA(At, 0, 1); PG8_STAGE(PG8_SB(0, 0), b2, voffB); PG8_STAGE(PG8_SB(0, 1), b2 + hstepB, voffB); PG8_STAGE(PG8_SA(0, 0), a2, voffA);
            PG8_WAIT_V(8); PG8_WAIT_L(0); PG8_BAR; PG8_MMA(1, 0, At, B0); PG8_MMA(1, 1, At, B1); PG8_BAR; PG8_SCHED;
            PG8_LDB(B0, 1, 0); PG8_LDB(B1, 1, 1); PG8_SCHED; PG8_LDA(At, 1, 0); PG8_STAGE(PG8_SA(0, 1), a2 + hstepA, voffA);
            PG8_WAIT_V(8); PG8_WAIT_L(0); PG8_BAR; PG8_MMA(0, 0, At, B0); PG8_MMA(0, 1, At, B1); PG8_BAR; PG8_SCHED;
            PG8_LDA(At, 1, 1); PG8_STAGE(PG8_SB(1, 0), b3, voffB); PG8_STAGE(PG8_SB(1, 1), b3 + hstepB, voffB); PG8_STAGE(PG8_SA(1, 0), a3, voffA);
            PG8_WAIT_V(8); PG8_WAIT_L(0); PG8_BAR; PG8_MMA(1, 0, At, B0); PG8_MMA(1, 1, At, B1); PG8_BAR; PG8_SCHED;
        }
        if constexpr (ALIGN_EPI) { if (wr == 0) PG8_BAR; }
        E(acc, cur, wr, wc, fr, fq);
        if (!has_next) break;
#pragma unroll
        for (int a = 0; a < 2; ++a)
#pragma unroll
            for (int b = 0; b < 2; ++b)
#pragma unroll
                for (int m = 0; m < 4; ++m)
#pragma unroll
                    for (int n = 0; n < 2; ++n) acc[a][b][m][n] = (f32x4){0.f, 0.f, 0.f, 0.f};
        cur = nxt; cA = nA; cB = nB; ++ui;
        if constexpr (ALIGN_EPI) { if (wr == 1) PG8_BAR; }
    }
    PG8_WAIT_V(0);
    if constexpr (!ALIGN_EPI) { if (wr == 0) PG8_BAR; }
    PG8_BAR;
#undef PG8_SA
#undef PG8_SB
#undef PG8_STAGE
#undef PG8_LDA
#undef PG8_LDB
#undef PG8_MMA
#undef PG8_WAIT_V
#undef PG8_WAIT_L
#undef PG8_BAR
#undef PG8_SCHED
}
}

DI void transpose_item(const float* W, int K, int N, bf16_t* WT, int sh, int add, LAS float* scr, int item, int lane, const float* gain) {
    const int nblk = N / 32, kb = item / nblk, nb = item % nblk, k0 = 64 * kb, n0 = 32 * nb;
#pragma unroll 8
    for (int i = 0; i < 32; ++i) { const int kk = 2 * i + (lane >> 5); const float gk = gain ? gain[k0 + kk] : 1.f; scr[kk * 33 + (lane & 31)] = W[(size_t)(k0 + kk) * N + n0 + (lane & 31)] * gk; }
    LDS_WAIT();
    const int c = lane & 7;
#pragma unroll
    for (int j = 0; j < 4; ++j) { const int n = (lane >> 3) + 8 * j; const LAS float* s = scr + (8 * c) * 33 + n;
        u32x4 o; o.x = pk2(s[0 * 33], s[1 * 33]); o.y = pk2(s[2 * 33], s[3 * 33]); o.z = pk2(s[4 * 33], s[5 * 33]); o.w = pk2(s[6 * 33], s[7 * 33]);
        const int cc = n0 + n, drow = ((cc >> 7) << sh) + add + (cc & 127);
        *(u32x4*)(WT + (size_t)drow * K + k0 + 8 * c) = o; }
    LDS_WAIT();
}
DI void norm_row_bf16(const float* xrow, const float* gain, bf16_t* orow, int lane) {
    const f32x4* xr = (const f32x4*)xrow + lane;
    f32x4 v[8]; float s = 0.f;
#pragma unroll
    for (int j = 0; j < 8; ++j) { v[j] = xr[64 * j]; s += (v[j].x * v[j].x + v[j].y * v[j].y) + (v[j].z * v[j].z + v[j].w * v[j].w); }
    const float rstd = rsqrtf(wave_sum(s) * (1.f / D) + EPS);
    u32x2* o8 = (u32x2*)orow + lane;
#pragma unroll
    for (int j = 0; j < 8; ++j) { const f32x4 gg = ((const f32x4*)gain)[lane + 64 * j]; u32x2 w; w.x = pk2(v[j].x * rstd * gg.x, v[j].y * rstd * gg.y); w.y = pk2(v[j].z * rstd * gg.z, v[j].w * rstd * gg.w); o8[64 * j] = w; }
}
DI void norm_row_f32(float* xrow, const float* gain, int lane) {
    f32x4* xr = (f32x4*)xrow + lane;
    f32x4 v[8]; float s = 0.f;
#pragma unroll
    for (int j = 0; j < 8; ++j) { v[j] = xr[64 * j]; s += (v[j].x * v[j].x + v[j].y * v[j].y) + (v[j].z * v[j].z + v[j].w * v[j].w); }
    const float rstd = rsqrtf(wave_sum(s) * (1.f / D) + EPS);
#pragma unroll
    for (int j = 0; j < 8; ++j) { const f32x4 gg = ((const f32x4*)gain)[lane + 64 * j]; xr[64 * j] = v[j] * rstd * gg; }
}

DI void feed_row(const float* xrow, bf16_t* orow, float* ssp, int lane) {
    const f32x4* xr = (const f32x4*)xrow + lane;
    f32x4 v[8]; float s = 0.f;
#pragma unroll
    for (int j = 0; j < 8; ++j) { v[j] = xr[64 * j]; s += (v[j].x * v[j].x + v[j].y * v[j].y) + (v[j].z * v[j].z + v[j].w * v[j].w); }
    s = wave_sum(s);
    u32x2* o8 = (u32x2*)orow + lane;
#pragma unroll
    for (int j = 0; j < 8; ++j) { u32x2 w; w.x = pk2(v[j].x, v[j].y); w.y = pk2(v[j].z, v[j].w); o8[64 * j] = w; }
    if (lane == 0) *ssp = s;
}

DI void attn_load_q(bf16x8 (&qf)[2][4], const bf16_t* Qp, int ldq, int nqg, const float* qgain, int fr, int fq) {
#pragma unroll
    for (int g = 0; g < 2; ++g) {
        if (g < nqg) {
            const bf16_t* qrow = Qp + (size_t)(g * 16 + fr) * ldq + fq * 8;
            float qv[4][8]; float ss = 0.f;
#pragma unroll
            for (int s = 0; s < 4; ++s) { unpack8(*(const u32x4*)(qrow + s * 32), qv[s]);
#pragma unroll
                for (int e = 0; e < 8; ++e) ss += qv[s][e] * qv[s][e]; }
            ss += __shfl_xor(ss, 16); ss += __shfl_xor(ss, 32);
            const float rs = rsqrtf(ss * (1.f / 128.f) + EPS) * (0.08838834764831845f * LOG2E);
#pragma unroll
            for (int s = 0; s < 4; ++s) { const f32x4 g0 = *(const f32x4*)(qgain + s * 32 + fq * 8), g1 = *(const f32x4*)(qgain + s * 32 + fq * 8 + 4);
                float t[8];
#pragma unroll
                for (int e = 0; e < 4; ++e) { t[e] = qv[s][e] * rs * g0[e]; t[4 + e] = qv[s][4 + e] * rs * g1[e]; }
                qf[g][s] = __builtin_bit_cast(bf16x8, pack8(t)); }
        } else {
#pragma unroll
            for (int s = 0; s < 4; ++s) qf[g][s] = (bf16x8){0, 0, 0, 0, 0, 0, 0, 0};
        }
    }
}
template <bool BIAS>
DI void attn_tile(const bf16x8 (&kf)[2][4], const bf16x8 (&vf)[8], const bf16x8 (&qf)[2][4], f32x4 (&o)[2][8], float (&mrun)[2], float (&lrun)[2],
                  int nqg, const LAS float* tbl, int idx0, bool tail, int kpos0, int nvalid) {
    f32x4 st[2][2];
#pragma unroll
    for (int g = 0; g < 2; ++g)
#pragma unroll
        for (int hh = 0; hh < 2; ++hh) { st[g][hh] = (f32x4){0.f, 0.f, 0.f, 0.f};
#pragma unroll
            for (int s = 0; s < 4; ++s) st[g][hh] = __builtin_amdgcn_mfma_f32_16x16x32_bf16(kf[hh][s], qf[g][s], st[g][hh], 0, 0, 0); }
#pragma unroll
    for (int g = 0; g < 2; ++g) {
        if (g < nqg) {
            float sv[8];
#pragma unroll
            for (int e = 0; e < 4; ++e) { sv[e] = st[g][0][e]; sv[4 + e] = st[g][1][e]; }
            if (BIAS) {
#pragma unroll
                for (int e = 0; e < 8; ++e) sv[e] += tbl[idx0 + g * 16 - e]; }
            if (tail) {
#pragma unroll
                for (int e = 0; e < 8; ++e) if (kpos0 + e >= nvalid) sv[e] = -1e30f; }
            float tmax = fmaxf(fmaxf(fmaxf(sv[0], sv[1]), fmaxf(sv[2], sv[3])), fmaxf(fmaxf(sv[4], sv[5]), fmaxf(sv[6], sv[7])));
            tmax = fmaxf(tmax, __shfl_xor(tmax, 16)); tmax = fmaxf(tmax, __shfl_xor(tmax, 32));
            const float mn = fmaxf(mrun[g], tmax), alpha = fast_exp2(mrun[g] - mn); mrun[g] = mn;
            float pv[8], ps = 0.f;
#pragma unroll
            for (int e = 0; e < 8; ++e) { pv[e] = fast_exp2(sv[e] - mn); ps += pv[e]; }
            lrun[g] = lrun[g] * alpha + ps;
            const bf16x8 pf = __builtin_bit_cast(bf16x8, pack8(pv));
#pragma unroll
            for (int dt = 0; dt < 8; ++dt) { o[g][dt] = o[g][dt] * alpha; o[g][dt] = __builtin_amdgcn_mfma_f32_16x16x32_bf16(vf[dt], pf, o[g][dt], 0, 0, 0); }
        }
    }
}
DI void attn_store_o(const f32x4 (&o)[2][8], const float (&lrun)[2], bf16_t* Op, int ldo, int nqg, int fr, int fq) {
#pragma unroll
    for (int g = 0; g < 2; ++g) {
        if (g < nqg) {
            float lt = lrun[g]; lt += __shfl_xor(lt, 16); lt += __shfl_xor(lt, 32);
            const float inv = 1.0f / lt;
            bf16_t* orow = Op + (size_t)(g * 16 + fr) * ldo + fq * 4;
#pragma unroll
            for (int dt = 0; dt < 8; ++dt) { u32x2 w; w.x = pk2(o[g][dt][0] * inv, o[g][dt][1] * inv); w.y = pk2(o[g][dt][2] * inv, o[g][dt][3] * inv); *(u32x2*)(orow + dt * 16) = w; }
        }
    }
}
template <bool BIAS>
DI void attn_task(const bf16_t* Qp, int ldq, bf16_t* Op, int ldo, const bf16_t* Kp, int ldk, const bf16_t* Vtp, int ldv,
                  int nkt, int nvalid, int nqg, const float* qgain, const LAS float* tbl, int dbase, int lane) {
    const int fr = lane & 15, fq = lane >> 4;
    bf16x8 qf[2][4];
    attn_load_q(qf, Qp, ldq, nqg, qgain, fr, fq);
    f32x4 o[2][8];
#pragma unroll
    for (int g = 0; g < 2; ++g)
#pragma unroll
        for (int dt = 0; dt < 8; ++dt) o[g][dt] = (f32x4){0.f, 0.f, 0.f, 0.f};
    float mrun[2] = {-1e30f, -1e30f}, lrun[2] = {0.f, 0.f};
    const bf16_t* kb0 = Kp + (size_t)((fr >> 2) * 8 + (fr & 3)) * ldk + fq * 8;
    const bf16_t* vb0 = Vtp + (size_t)fr * ldv + fq * 8;
#pragma unroll 1
    for (int kt = 0; kt < nkt; ++kt) {
        const bf16_t* kb = kb0 + (size_t)kt * 32 * ldk;
        bf16x8 kf[2][4];
#pragma unroll
        for (int hh = 0; hh < 2; ++hh)
#pragma unroll
            for (int s = 0; s < 4; ++s) kf[hh][s] = *(const bf16x8*)(kb + (size_t)hh * 4 * ldk + s * 32);
        bf16x8 vf[8];
#pragma unroll
        for (int dt = 0; dt < 8; ++dt) vf[dt] = *(const bf16x8*)(vb0 + (size_t)dt * 16 * ldv + kt * 32);
        attn_tile<BIAS>(kf, vf, qf, o, mrun, lrun, nqg, tbl, dbase + fr - kt * 32 - fq * 8, kt * 32 + 32 > nvalid, kt * 32 + fq * 8, nvalid);
    }
    attn_store_o(o, lrun, Op, ldo, nqg, fr, fq);
}
constexpr int AT_TBL = 0, AT_K = 4096, AT_KB = 32 * 272, AT_V = AT_K + 2 * AT_KB, AT_VB = 128 * 80;
DI void attn_wg_prompt(const Params& p, LAS unsigned char* lds, int b, int h, int cg, bf16_t* obase, int ldo, int ocol, int tid) {
    const int lane = tid & 63, wave = __builtin_amdgcn_readfirstlane(tid >> 6), fr = lane & 15, fq = lane >> 4;
    const int c = cg * 4 + (wave >> 1), half = wave & 1;
    const bf16_t* Ub = (const bf16_t*)(p.ws + W_U); const bf16_t* Vtg = (const bf16_t*)(p.ws + W_VT);
    LAS float* tbl = (LAS float*)(lds + AT_TBL);
    __syncthreads();
    for (int i = tid; i < 640; i += NWAVES * 64) { int d = i - 63; d = d < -256 ? -256 : (d > 256 ? 256 : d); tbl[i] = p.in[17][h * 513 + d + 256] * LOG2E; }
    const size_t qrow0 = (size_t)b * TSEQ + c * 64 + half * 32;
    bf16x8 qf[2][4];
    attn_load_q(qf, Ub + qrow0 * NU + OQ + h * 128, NU, 2, p.in[15], fr, fq);
    f32x4 o[2][8];
#pragma unroll
    for (int g = 0; g < 2; ++g)
#pragma unroll
        for (int dt = 0; dt < 8; ++dt) o[g][dt] = (f32x4){0.f, 0.f, 0.f, 0.f};
    float mrun[2] = {-1e30f, -1e30f}, lrun[2] = {0.f, 0.f};
    const int key_lo = (cg * 4 - 8) * 64 > 0 ? (cg * 4 - 8) * 64 : 0, nkt = ((cg * 4 + 4) * 64 - key_lo) / 32;
    const bf16_t* kg = Ub + ((size_t)b * TSEQ + key_lo + (tid >> 4)) * NU + OKK + h * 128 + (tid & 15) * 8;
    const bf16_t* vg = Vtg + ((size_t)(b * 8 + h) * 128 + (tid >> 2)) * TSEQ + key_lo + (tid & 3) * 8;
    const unsigned kw = (unsigned)(tid >> 4) * 272u + (unsigned)(tid & 15) * 16u, vw = (unsigned)(tid >> 2) * 80u + (unsigned)(tid & 3) * 16u;
    const unsigned kroff = (unsigned)((fr >> 2) * 8 + (fr & 3)) * 272u + (unsigned)fq * 16u, vroff = (unsigned)fr * 80u + (unsigned)fq * 16u;
    const int dbase = c * 64 + half * 32 - key_lo + 63;
    u32x4 kr = *(const u32x4*)kg, vr = *(const u32x4*)vg;
#pragma unroll 1
    for (int kt = 0; kt < nkt; ++kt) {
        const int buf = kt & 1;
        *(LAS u32x4*)(lds + AT_K + buf * AT_KB + kw) = kr; *(LAS u32x4*)(lds + AT_V + buf * AT_VB + vw) = vr;
        if (kt + 1 < nkt) { kr = *(const u32x4*)(kg + (size_t)(kt + 1) * 32 * NU); vr = *(const u32x4*)(vg + (kt + 1) * 32); }
        __syncthreads();
        const int kc = (key_lo + kt * 32) >> 6;
        if (kc >= c - 8 && kc <= c) {
            bf16x8 kf[2][4], vf[8];
#pragma unroll
            for (int hh = 0; hh < 2; ++hh)
#pragma unroll
                for (int s = 0; s < 4; ++s) kf[hh][s] = *(const LAS bf16x8*)(lds + AT_K + buf * AT_KB + kroff + hh * (4 * 272) + s * 64);
#pragma unroll
            for (int dt = 0; dt < 8; ++dt) vf[dt] = *(const LAS bf16x8*)(lds + AT_V + buf * AT_VB + vroff + dt * (16 * 80));
            attn_tile<true>(kf, vf, qf, o, mrun, lrun, 2, tbl, dbase + fr - kt * 32 - fq * 8, false, 0, 0);
        }
    }
    attn_store_o(o, lrun, obase + qrow0 * ldo + ocol + h * 128, ldo, 2, fr, fq);
}

constexpr int LT_OFF = 98304, LT_WG = 64 * 144, LT_PAR = 2 * LT_WG;
DI void lru_tables_to_lds(const Params& p, LAS unsigned char* lt, int nblk, int tid) {
    const bf16_t* Wt = (const bf16_t*)(p.ws + W_LRU);
    for (int i = tid; i < 2 * 64 * 8; i += NWAVES * 64) { const int g = i >> 9, row = (i >> 3) & 63, seg = i & 7;
        *(LAS u32x4*)(lt + g * LT_WG + row * 144 + seg * 16) = *(const u32x4*)(Wt + (size_t)g * 65536 + (size_t)(nblk * 64 + row) * 64 + seg * 8); }
    for (int i = tid; i < 512; i += NWAVES * 64) { const int k = i >> 6, ch = nblk * 64 + (i & 63);
        const float v = k < 4 ? p.in[18][k * 1024 + ch] : (k == 4 ? p.in[19][ch] : (k == 5 ? p.in[21][ch] : (k == 6 ? p.in[23][ch] : ((const float*)(p.ws + W_C8))[ch])));
        ((LAS float*)(lt + LT_PAR))[i] = v; }
    __syncthreads();
}
template <int PASS>
DI void lru_unit(const Params& p, int seq, int chunk, int nblk, int lane, bf16_t* obase, unsigned opitch, unsigned ocol, const LAS unsigned char* lt) {
    unsigned char* ws = p.ws;
    const char* Ub = (const char*)(ws + W_U);
    const LAS float* par = (const LAS float*)(lt + LT_PAR);
    float* cA = (float*)(ws + W_CA); float* cB = (float*)(ws + W_CB);
    const bool is_s = seq >= NBATCH;
    const int sb = seq - NBATCH;
    const unsigned row0 = is_s ? (unsigned)MP + (unsigned)sb * STOK : (unsigned)seq * TSEQ;
    const int t0 = is_s ? 0 : chunk * 64, ntt = is_s ? 1 : 4;
    float hc[2][8], arun[2][8];
#pragma unroll
    for (int ks = 0; ks < 2; ++ks)
#pragma unroll
        for (int e = 0; e < 8; ++e) { hc[ks][e] = 0.f; arun[ks][e] = 1.f; }
    if (PASS == 1) {
        float H;
        if (is_s) H = p.in[5][(size_t)sb * 1024 + nblk * 64 + lane];
        else { H = 0.f;
            const float* pa = cA + (size_t)seq * 64 * 1024 + nblk * 64 + lane; const float* pb = cB + (size_t)seq * 64 * 1024 + nblk * 64 + lane;
            for (int c2 = 0; c2 < chunk; c2 += 8) {
                float ta[8], tb[8];
#pragma unroll
                for (int j = 0; j < 8; ++j) { const int cc = (c2 + j < chunk) ? c2 + j : chunk - 1; ta[j] = pa[(size_t)cc * 1024]; tb[j] = pb[(size_t)cc * 1024]; }
#pragma unroll
                for (int j = 0; j < 8; ++j) if (c2 + j < chunk) H = ta[j] * H + tb[j];
            } }
        const int fq0 = lane >> 4;
#pragma unroll
        for (int ks = 0; ks < 2; ++ks)
#pragma unroll
            for (int e = 0; e < 8; ++e) hc[ks][e] = __shfl(H, ks * 32 + fq0 * 8 + e);
    }
#pragma unroll 1
    for (int tt = 0; tt < ntt; ++tt) {
        int lo = lane; asm volatile("" : "+v"(lo) :: "memory");
        const int fr = lo & 15, fq = lo >> 4;
        const int t = t0 + tt * 16 + fr;
        const unsigned chb0 = (unsigned)(nblk * 64 + fq * 8);
        float xc[2][8]; bf16x8 xf[2];
#pragma unroll
        for (int ks = 0; ks < 2; ++ks) {
            const unsigned chb = chb0 + ks * 32;
            const int chl = ks * 32 + fq * 8;
            const f32x4 b0 = *(const LAS f32x4*)(par + 4 * 64 + chl), b1 = *(const LAS f32x4*)(par + 4 * 64 + chl + 4);
#pragma unroll
            for (int e = 0; e < 4; ++e) { xc[ks][e] = b0[e]; xc[ks][4 + e] = b1[e]; }
#pragma unroll
            for (int j = 0; j < 4; ++j) {
                const int tj = t - 3 + j;
                float xv[8];
                if (tj >= 0) unpack8(*(const u32x4*)(Ub + ((row0 + (unsigned)tj) * (unsigned)NU + OXR + chb) * 2u), xv);
                else if (is_s) { const char* sp = (const char*)p.in[4] + (((unsigned)sb * 3u + (unsigned)(3 + tj)) * 1024u + chb) * 4u; const f32x4 s0 = *(const f32x4*)sp, s1 = *(const f32x4*)(sp + 16);
#pragma unroll
                    for (int e = 0; e < 4; ++e) { xv[e] = s0[e]; xv[4 + e] = s1[e]; } }
                else {
#pragma unroll
                    for (int e = 0; e < 8; ++e) xv[e] = 0.f; }
                const f32x4 w0 = *(const LAS f32x4*)(par + j * 64 + chl), w1 = *(const LAS f32x4*)(par + j * 64 + chl + 4);
#pragma unroll
                for (int e = 0; e < 4; ++e) { xc[ks][e] += w0[e] * xv[e]; xc[ks][4 + e] += w1[e] * xv[4 + e]; }
            }
            xf[ks] = __builtin_bit_cast(bf16x8, pack8(xc[ks]));
        }
        float av[2][8], bv[2][8];
        const unsigned wbase = (unsigned)((fr >> 2) * 8 + (fr & 3)) * 144u + (unsigned)fq * 16u;
#pragma unroll
        for (int ct = 0; ct < 4; ++ct) {
            const int ks = ct >> 1, hq = ct & 1;
            const unsigned woff = wbase + (unsigned)((ks * 32 + hq * 4) * 144);
            f32x4 aa = (f32x4){0.f, 0.f, 0.f, 0.f}, ax = (f32x4){0.f, 0.f, 0.f, 0.f};
#pragma unroll
            for (int k2 = 0; k2 < 2; ++k2) {
                const bf16x8 wa = *(const LAS bf16x8*)(lt + woff + k2 * 64u), wx = *(const LAS bf16x8*)(lt + LT_WG + woff + k2 * 64u);
                aa = __builtin_amdgcn_mfma_f32_16x16x32_bf16(wa, xf[k2], aa, 0, 0, 0);
                ax = __builtin_amdgcn_mfma_f32_16x16x32_bf16(wx, xf[k2], ax, 0, 0, 0); }
            const int chq = ks * 32 + fq * 8 + hq * 4;
            const f32x4 ba4 = *(const LAS f32x4*)(par + 5 * 64 + chq), bx4 = *(const LAS f32x4*)(par + 6 * 64 + chq), c84 = *(const LAS f32x4*)(par + 7 * 64 + chq);
#pragma unroll
            for (int j = 0; j < 4; ++j) {
                const int e = hq * 4 + j;
                const float r = sigmoidf_(aa[j] + ba4[j]), ig = sigmoidf_(ax[j] + bx4[j]);
                const float a = fast_exp2(c84[j] * r);
                av[ks][e] = a; bv[ks][e] = sqrtf(fmaxf(1.0f - a * a, 0.f)) * ig * xc[ks][e];
            }
        }
#pragma unroll
        for (int ks = 0; ks < 2; ++ks)
#pragma unroll
            for (int e = 0; e < 8; ++e) {
                float a = av[ks][e], b = bv[ks][e], pa, pb;
                pa = dpp_shr<1>(1.f, a); pb = dpp_shr<1>(0.f, b); b = a * pb + b; a = a * pa;
                pa = dpp_shr<2>(1.f, a); pb = dpp_shr<2>(0.f, b); b = a * pb + b; a = a * pa;
                pa = dpp_shr<4>(1.f, a); pb = dpp_shr<4>(0.f, b); b = a * pb + b; a = a * pa;
                pa = dpp_shr<8>(1.f, a); pb = dpp_shr<8>(0.f, b); b = a * pb + b; a = a * pa;
                const float h = a * hc[ks][e] + b;
                bv[ks][e] = h; av[ks][e] = a;
            }
        const int l15 = (lo & 48) | 15;
        if (PASS == 1) {
#pragma unroll
            for (int ks = 0; ks < 2; ++ks) {
                const unsigned chb = chb0 + ks * 32;
                const char* gp = Ub + ((row0 + (unsigned)t) * (unsigned)NU + OGR + chb) * 2u;
                char* op = (char*)obase + ((row0 + (unsigned)t) * opitch + ocol + chb) * 2u;
                float gv[8], ov[8]; unpack8(*(const u32x4*)gp, gv);
#pragma unroll
                for (int e = 0; e < 8; ++e) { const float x = gv[e]; const float u2 = 1.5957691216057308f * (x + 0.044715f * x * x * x); ov[e] = x * fast_rcp(1.0f + fast_exp2(-u2 * LOG2E)) * bv[ks][e]; }
                *(u32x4*)op = pack8(ov);
                if (fr == 15 && tt == ntt - 1 && (is_s || chunk == 63)) {
                    float* lo2 = p.out + (is_s ? O_LS + (size_t)sb * 1024 : O_LP + (size_t)seq * 1024) + chb;
                    *(f32x4*)lo2 = (f32x4){bv[ks][0], bv[ks][1], bv[ks][2], bv[ks][3]}; *(f32x4*)(lo2 + 4) = (f32x4){bv[ks][4], bv[ks][5], bv[ks][6], bv[ks][7]};
                }
#pragma unroll
                for (int e = 0; e < 8; ++e) hc[ks][e] = __shfl(bv[ks][e], l15);
            }
        } else {
#pragma unroll
            for (int ks = 0; ks < 2; ++ks)
#pragma unroll
                for (int e = 0; e < 8; ++e) { hc[ks][e] = __shfl(bv[ks][e], l15); arun[ks][e] *= __shfl(av[ks][e], l15); }
        }
    }
    if (PASS == 0 && (lane & 15) == 0) {
        const int fq = lane >> 4;
#pragma unroll
        for (int ks = 0; ks < 2; ++ks) { const size_t o = ((size_t)seq * 64 + chunk) * 1024 + nblk * 64 + ks * 32 + fq * 8;
            *(f32x4*)(cA + o) = (f32x4){arun[ks][0], arun[ks][1], arun[ks][2], arun[ks][3]}; *(f32x4*)(cA + o + 4) = (f32x4){arun[ks][4], arun[ks][5], arun[ks][6], arun[ks][7]};
            *(f32x4*)(cB + o) = (f32x4){hc[ks][0], hc[ks][1], hc[ks][2], hc[ks][3]}; *(f32x4*)(cB + o + 4) = (f32x4){hc[ks][4], hc[ks][5], hc[ks][6], hc[ks][7]}; }
    }
}


DI void sample_cache_tasks(const Params& p, int first, int stride, int lane) {
    constexpr int T_KS = SBATCH * 512, T_VTS = SBATCH * 8 * 8;
    bf16_t* Ks = (bf16_t*)(p.ws + W_KS); bf16_t* Vts = (bf16_t*)(p.ws + W_VTS);
        for (int r = first; r < T_KS; r += stride) {
                const int b = r >> 9, j = r & 511;
                const float* src = p.in[2] + (size_t)r * 1024 + lane * 16;
                float t0[8], t1[8];
                { const f32x4 a = *(const f32x4*)src, c = *(const f32x4*)(src + 4), d = *(const f32x4*)(src + 8), e = *(const f32x4*)(src + 12);
                  t0[0] = a.x; t0[1] = a.y; t0[2] = a.z; t0[3] = a.w; t0[4] = c.x; t0[5] = c.y; t0[6] = c.z; t0[7] = c.w;
                  t1[0] = d.x; t1[1] = d.y; t1[2] = d.z; t1[3] = d.w; t1[4] = e.x; t1[5] = e.y; t1[6] = e.z; t1[7] = e.w; }
                bf16_t* kd = Ks + ((size_t)b * SKEYS + j) * 1024 + lane * 16;
                *(u32x4*)kd = pack8(t0); *(u32x4*)(kd + 8) = pack8(t1);


        }
        for (int r = first; r < T_VTS; r += stride) {
                const int b = r >> 6, h = (r >> 3) & 7, jg = r & 7, j = jg * 64 + lane;
                const float* src = p.in[3] + (((size_t)b * 512 + j) * 8 + h) * 128;
                bf16_t* dst = Vts + ((size_t)(b * 8 + h) * 128) * SKEYS + j;
#pragma unroll 4
                for (int dc = 0; dc < 32; ++dc) { const f32x4 v = *(const f32x4*)(src + dc * 4);
                    dst[(size_t)(dc * 4 + 0) * SKEYS] = (bf16_t)pk2(v.x, 0.f); dst[(size_t)(dc * 4 + 1) * SKEYS] = (bf16_t)pk2(v.y, 0.f);
                    dst[(size_t)(dc * 4 + 2) * SKEYS] = (bf16_t)pk2(v.z, 0.f); dst[(size_t)(dc * 4 + 3) * SKEYS] = (bf16_t)pk2(v.w, 0.f); }
                if (jg == 7 && lane < 16) { bf16_t* pz = Vts + ((size_t)(b * 8 + h) * 128) * SKEYS + 528 + lane;
                    for (int d = 0; d < 128; ++d) pz[(size_t)d * SKEYS] = 0; }


        }
}

DI void mem_tasks(const Params& p, int first, int stride, int lane) {
    const float* MKVF = (const float*)(p.ws + W_MKVF); bf16_t* Km = (bf16_t*)(p.ws + W_KM); bf16_t* Vtm = (bf16_t*)(p.ws + W_VTM);
        for (int r = first; r < 2048; r += stride) {
            const float* src = MKVF + (size_t)r * 1024 + lane * 8;
            const f32x4 k0 = *(const f32x4*)src, k1 = *(const f32x4*)(src + 4), v0 = *(const f32x4*)(src + 512), v1 = *(const f32x4*)(src + 516);
            float ss = (k0.x * k0.x + k0.y * k0.y + k0.z * k0.z + k0.w * k0.w) + (k1.x * k1.x + k1.y * k1.y + k1.z * k1.z + k1.w * k1.w);
            ss += __shfl_xor(ss, 1); ss += __shfl_xor(ss, 2); ss += __shfl_xor(ss, 4); ss += __shfl_xor(ss, 8);
            const float rs = rsqrtf(ss * (1.f / 128.f) + EPS);
            const f32x4 g0 = *(const f32x4*)(p.in[34] + (lane * 8) % 128), g1 = *(const f32x4*)(p.in[34] + (lane * 8) % 128 + 4);
            const f32x4 n0 = k0 * rs * g0, n1 = k1 * rs * g1;
            float* ko = p.out + O_MK + (size_t)r * 512 + lane * 8; *(f32x4*)ko = n0; *(f32x4*)(ko + 4) = n1;
            float* vo = p.out + O_MV + (size_t)r * 512 + lane * 8; *(f32x4*)vo = v0; *(f32x4*)(vo + 4) = v1;
            u32x4 w; w.x = pk2(n0.x, n0.y); w.y = pk2(n0.z, n0.w); w.z = pk2(n1.x, n1.y); w.w = pk2(n1.z, n1.w);
            *(u32x4*)(Km + (size_t)r * 512 + lane * 8) = w;
        }
        for (int r = first; r < SBATCH * 256; r += stride) {
            const float* src = p.in[6] + (size_t)r * 512 + lane * 8; const f32x4 k0 = *(const f32x4*)src, k1 = *(const f32x4*)(src + 4);
            u32x4 w; w.x = pk2(k0.x, k0.y); w.y = pk2(k0.z, k0.w); w.z = pk2(k1.x, k1.y); w.w = pk2(k1.z, k1.w);
            *(u32x4*)(Km + ((size_t)NBATCH * 256 + r) * 512 + lane * 8) = w;
        }
        for (int it = first; it < NSEQ * 4 * 4; it += stride) {
            const int seq = it >> 4, h = (it >> 2) & 3, j = (it & 3) * 64 + lane;
            const float* src = seq < NBATCH ? MKVF + ((size_t)seq * 256 + j) * 1024 + 512 + h * 128 : p.in[7] + (((size_t)(seq - NBATCH) * 256 + j) * 4 + h) * 128;
            bf16_t* dst = Vtm + ((size_t)(seq * 4 + h) * 128) * 256 + j;
#pragma unroll 4
            for (int dc = 0; dc < 32; ++dc) { const f32x4 v = *(const f32x4*)(src + dc * 4);
                dst[(size_t)(dc * 4 + 0) * 256] = (bf16_t)(pk2(v.x, 0.f)); dst[(size_t)(dc * 4 + 1) * 256] = (bf16_t)(pk2(v.y, 0.f));
                dst[(size_t)(dc * 4 + 2) * 256] = (bf16_t)(pk2(v.z, 0.f)); dst[(size_t)(dc * 4 + 3) * 256] = (bf16_t)(pk2(v.w, 0.f)); }
        }
}

#define XB_TMO      128
#define XB_XCNT(j)  (256  + 64 * (j))
#define XB_XSUB(j)  (1280 + 64 * (j))
#define XB_XGEN(j)  (2304 + 64 * (j))
#define XB_TOP      3328
#define XB_TOPGEN   3392
#define XCD_BAR_WORDS 3456
#define XB_SPIN_CAP (1u << 18)
DI unsigned xb_ld(unsigned* p)              { return __hip_atomic_load(p, __ATOMIC_RELAXED, __HIP_MEMORY_SCOPE_AGENT); }
DI unsigned xb_add(unsigned* p, unsigned v) { return __hip_atomic_fetch_add(p, v, __ATOMIC_RELAXED, __HIP_MEMORY_SCOPE_AGENT); }
DI unsigned xb_xcc_id() { return (unsigned)__builtin_amdgcn_s_getreg((3 << 11) | 20) & 0xFu; }
#define XB_SPIN(cond, bar) do { unsigned _sp = 0; while (cond) { __builtin_amdgcn_s_sleep(1); \
    if ((++_sp & 255u) == 0u) { if (xb_ld(&(bar)[XB_TMO])) break; if (_sp > XB_SPIN_CAP) { atomicAdd(&(bar)[XB_TMO], 1u); break; } } } } while (0)
struct XcdBarrier { unsigned* bar; unsigned x; volatile LAS unsigned* st; };
DI XcdBarrier xcd_barrier_post(unsigned* bar, volatile LAS unsigned* st) {
    XcdBarrier b; b.bar = bar; b.x = xb_xcc_id(); b.st = st;
    if (threadIdx.x == 0) (void)xb_add(&bar[XB_XCNT(b.x)], 1u);
    return b;
}
DI void xcd_barrier_complete(unsigned* bar, unsigned x, unsigned& nloc, unsigned& nx) {
    const unsigned G = gridDim.x * gridDim.y * gridDim.z;
    unsigned sum, cnt, mine, sp = 0u;
    for (;;) {
        sum = 0u; cnt = 0u; mine = 0u;
#pragma unroll
        for (unsigned j = 0; j < 16; ++j) { const unsigned c = xb_ld(&bar[XB_XCNT(j)]); sum += c; cnt += (c > 0u) ? 1u : 0u; mine = (j == x) ? c : mine; }
        if (sum == G) break;
        __builtin_amdgcn_s_sleep(1);
        if ((++sp & 255u) == 0u) { if (xb_ld(&bar[XB_TMO])) break; if (sp > XB_SPIN_CAP) { atomicAdd(&bar[XB_TMO], 1u); break; } }
    }
    nloc = mine > 0u ? mine : 1u; nx = cnt > 0u ? cnt : 1u;
}
DI void xcd_barrier(const XcdBarrier& b) {
    asm volatile("s_waitcnt vmcnt(0)" ::: "memory");
    __syncthreads();
    if (threadIdx.x == 0) {
        unsigned* bar = b.bar;
        __builtin_amdgcn_s_waitcnt(0);
        unsigned nloc = b.st[0], nx = b.st[1];
        if (nloc == 0u) { xcd_barrier_complete(bar, b.x, nloc, nx); b.st[0] = nloc; b.st[1] = nx; }
        const unsigned old = xb_add(&bar[XB_XSUB(b.x)], 1u);
        const unsigned gen = old / nloc;
        if (old + 1u == (gen + 1u) * nloc) {
            __builtin_amdgcn_fence(__ATOMIC_RELEASE, "agent");
            asm volatile("s_waitcnt vmcnt(0)" ::: "memory");
            const unsigned og = xb_add(&bar[XB_TOP], 1u);
            const unsigned tg = og / nx;
            if (og + 1u == (tg + 1u) * nx) xb_add(&bar[XB_TOPGEN], 1u);
            else XB_SPIN(xb_ld(&bar[XB_TOPGEN]) == tg, bar);
            __builtin_amdgcn_fence(__ATOMIC_ACQUIRE, "agent");
            xb_add(&bar[XB_XGEN(b.x)], 1u);
            asm volatile("s_waitcnt vmcnt(0)" ::: "memory");
        } else {
            XB_SPIN(xb_ld(&bar[XB_XGEN(b.x)]) == gen, bar);
            __builtin_amdgcn_fence(__ATOMIC_ACQUIRE, "agent");
            asm volatile("s_waitcnt vmcnt(0)" ::: "memory");
        }
    }
    __syncthreads();
}

__global__ void __launch_bounds__(NWAVES * 64, 2) fwd_megakernel(Params p) {
    extern __shared__ __attribute__((aligned(16))) unsigned char lds_raw[];
    cg::grid_group grid = cg::this_grid();
    LAS unsigned char* lds = (LAS unsigned char*)lds_raw;
#define PH_IDS int tid = threadIdx.x; asm volatile("" : "+v"(tid)); const int lane = tid & 63, wave = __builtin_amdgcn_readfirstlane(tid >> 6); \
    const int G = gridDim.x, gw = blockIdx.x * NWAVES + wave, NGW = G * NWAVES; (void)lane; (void)gw; (void)NGW; (void)G
    unsigned char* ws = p.ws;
    float* R = p.out;
    bf16_t* XN = (bf16_t*)(ws + W_XN); bf16_t* U = (bf16_t*)(ws + W_U); bf16_t* H = (bf16_t*)(ws + W_H);
    bf16_t* Vt = (bf16_t*)(ws + W_VT); bf16_t* Ks = (bf16_t*)(ws + W_KS); bf16_t* Vts = (bf16_t*)(ws + W_VTS);
    bf16_t* Km = (bf16_t*)(ws + W_KM); bf16_t* Vtm = (bf16_t*)(ws + W_VTM);
    bf16_t* MN = (bf16_t*)(ws + W_MN); float* MKVF = (float*)(ws + W_MKVF); bf16_t* MQ = (bf16_t*)(ws + W_MQB);

    for (int rep_ = 0; rep_ < 1 + ((REPM >> 0) & 1); ++rep_) { if (rep_) grid.sync(); PH_IDS;
        if (blockIdx.x == 0) for (int i = tid; i < 4096; i += NWAVES * 64) ((unsigned*)(ws + W_BAR))[i] = 0u;
        if (tid < 2) ((volatile LAS unsigned*)(lds + 131072 + 64))[tid] = 0u;
        LAS float* scr = (LAS float*)(lds + wave * 16384);
        constexpr int I_FU = (D / 64) * (FF / 32), I_FD = (FF / 64) * (D / 32), I_IN = (D / 64) * (NU / 32), I_P = (1024 / 64) * (D / 32), I_O = (D / 64) * (D / 32),
                      I_M = (D / 64) * (512 / 32), I_MO = (512 / 64) * (D / 32);
        constexpr int NITEMS = 4 * I_FU + 2 * I_FD + I_IN + 2 * I_P + I_O + 3 * I_M + I_MO;
        for (int it = gw; it < NITEMS; it += NGW) {
            int r = it;
#define TJ(IDX, KK, NN, OFF, SH, ADD, NI, GN) if (r < (NI)) { transpose_item(p.in[IDX], KK, NN, (bf16_t*)(ws + (OFF)), SH, ADD, scr, r, lane, GN); continue; } r -= (NI);
            TJ(10, D, FF, W_GU1, 8, 0, I_FU, nullptr) TJ(11, D, FF, W_GU1, 8, 128, I_FU, nullptr) TJ(12, FF, D, W_D1, 7, 0, I_FD, nullptr)
            TJ(37, D, FF, W_GU2, 8, 0, I_FU, p.in[36]) TJ(38, D, FF, W_GU2, 8, 128, I_FU, p.in[36]) TJ(39, FF, D, W_D2, 7, 0, I_FD, nullptr)
            TJ(14, D, NU, W_IN, 7, 0, I_IN, p.in[13]) TJ(25, 1024, D, W_PA, 7, 0, I_P, nullptr) TJ(26, 1024, D, W_PB, 7, 0, I_P, nullptr) TJ(27, D, D, W_OUT, 7, 0, I_O, nullptr)
            TJ(30, D, 512, W_MQ, 7, 0, I_M, p.in[28]) TJ(31, D, 512, W_MKV, 7, 0, I_M, nullptr) TJ(32, D, 512, W_MKV, 7, 512, I_M, nullptr)
            transpose_item(p.in[35], 512, D, (bf16_t*)(ws + W_MO), 7, 0, scr, r, lane, nullptr);
#undef TJ
        }
        for (int m = gw; m < MT; m += NGW) norm_row_bf16(m < MP ? p.in[0] + (size_t)m * D : p.in[1] + (size_t)(m - MP) * D, p.in[9], XN + (size_t)m * D, lane);
        for (int m = gw; m < 2048; m += NGW) norm_row_bf16(p.in[8] + (size_t)m * D, p.in[29], MN + (size_t)m * D, lane);
        {
            bf16_t* Wt = (bf16_t*)(ws + W_LRU); float* c8 = (float*)(ws + W_C8);
            for (int i = blockIdx.x * 512 + tid; i < 2 * 65536; i += G * 512) { const int gsel = i >> 16, n = (i >> 12) & 15, c = (i >> 6) & 63, k = i & 63;
                const float v = p.in[gsel ? 22 : 20][n * 4096 + k * 64 + c]; Wt[i] = (bf16_t)(pk2(v, 0.f) & 0xffffu); }
            for (int i = blockIdx.x * 512 + tid; i < 1024; i += G * 512) c8[i] = -8.0f * log1pf(expf(-p.in[24][i])) * LOG2E;
            float* ssz = (float*)(ws + W_SS);
            for (int i = blockIdx.x * 512 + tid; i < 3 * MT; i += G * 512) ssz[i] = 0.f;
            for (int i = blockIdx.x * 512 + tid; i < MS * D / 4; i += G * 512) ((f32x4*)(R + (size_t)MP * D))[i] = ((const f32x4*)p.in[1])[i];
        }
    }
    grid.sync();
    XcdBarrier xbar = xcd_barrier_post((unsigned*)(p.ws + W_BAR), (volatile LAS unsigned*)(lds + 131072 + 64));

    for (int rr = 0; rr < ((REPM >> 18) & 1) * 20; ++rr) grid.sync();
    for (int rep_ = 0; rep_ < 1 + ((REPM >> 1) & 1); ++rep_) { if (rep_) grid.sync(); PH_IDS;
        pg8::Gemm g{XN, (const bf16_t*)(ws + W_GU1), MT, 2 * FF, D, D, D}; pg8::StaticOrder S; S.init(MT, 2 * FF, G, (int)blockIdx.x);
        pg8::EpiSwiglu E{H, FF, nullptr};
        pg8::gemm_phase<pg8::EpiSwiglu, true>(lds, g, S, E, STAG);
        pg8::Gemm g2{MN, (const bf16_t*)(ws + W_MKV), 2048, 1024, D, D, D}; pg8::StaticOrder S2; S2.init(2048, 1024, G, (int)((blockIdx.x + 128) % G));
        pg8::EpiF32 E2{MKVF, 1024};
        pg8::gemm_phase<pg8::EpiF32, true>(lds, g2, S2, E2);
        if (G > 160 && (int)blockIdx.x >= 160) sample_cache_tasks(p, ((int)blockIdx.x - 160) * NWAVES + wave, (G - 160) * NWAVES, lane);
    }
    xcd_barrier(xbar);

    for (int rep_ = 0; rep_ < 1 + ((REPM >> 2) & 1); ++rep_) { if (rep_) grid.sync(); PH_IDS;
        pg8::Gemm g{H, (const bf16_t*)(ws + W_D1), MP, D, FF, FF, FF}; pg8::StaticOrder S; S.init(MP, D, G, (int)blockIdx.x);
        pg8::EpiResid E{R, p.in[0], XN, (float*)(ws + W_SS), 0.5f};
        pg8::gemm_phase<pg8::EpiResid, true>(lds, g, S, E, STAG);
        pg8::Gemm gs{H + (size_t)MP * FF, (const bf16_t*)(ws + W_D1), MS, D, FF, FF, FF / 4}; pg8::SplitOrder Ss; Ss.init(MS, D, 4, G, (int)blockIdx.x);
        pg8::EpiResidAtomic Es{R + (size_t)MP * D, 0.5f};
        pg8::gemm_phase<pg8::EpiResidAtomic, true>(lds, gs, Ss, Es);
        if (G > 64 && (int)blockIdx.x >= 64) mem_tasks(p, ((int)blockIdx.x - 64) * NWAVES + wave, (G - 64) * NWAVES, lane);
    }
    xcd_barrier(xbar);

    for (int rep_ = 0; rep_ < 1 + ((REPM >> 3) & 1); ++rep_) { if (rep_) grid.sync(); PH_IDS;
        for (int m = MP + gw; m < MT; m += NGW) feed_row(R + (size_t)m * D, XN + (size_t)m * D, (float*)(ws + W_SS) + m, lane);
        if (G <= 64) mem_tasks(p, gw, NGW, lane);
    }
    xcd_barrier(xbar);

    for (int rep_ = 0; rep_ < 1 + ((REPM >> 4) & 1); ++rep_) { if (rep_) grid.sync(); PH_IDS;
        pg8::Gemm g{XN, (const bf16_t*)(ws + W_IN), MT, NU, D, D, D}; pg8::StaticOrder S; S.init(MT, NU, G, (int)blockIdx.x);
        pg8::EpiBf16 E{U, NU, (const float*)(ws + W_SS)};
        pg8::gemm_phase<pg8::EpiBf16, true>(lds, g, S, E, STAG);
    }
    xcd_barrier(xbar);

    for (int rep_ = 0; rep_ < 1 + ((REPM >> 5) & 1); ++rep_) { if (rep_) grid.sync(); PH_IDS;
        const bool dummy5 = ((REPM >> 5) & 1) && rep_ == 0;
        constexpr int T_ROWS = MT, T_VT = NBATCH * 64 * 8, T_KS = SBATCH * 512, T_VTS = SBATCH * 8 * 8, T_LRU = NBATCH * 64 * 16;
        for (int r = gw; r < T_ROWS; r += NGW) {
                const bool is_s = r >= MP; const int rs_ = r - MP;
                const int b = is_s ? (rs_ >> 4) : (r >> 12), t = is_s ? (rs_ & 15) : (r & 4095);
                bf16_t* urow = U + (size_t)r * NU;
                float kv[16], vv[16];
                { const u32x4 a = *(const u32x4*)(urow + OKK + lane * 16), c = *(const u32x4*)(urow + OKK + lane * 16 + 8);
                  float t0[8], t1[8]; unpack8(a, t0); unpack8(c, t1);
#pragma unroll
                  for (int i = 0; i < 8; ++i) { kv[i] = t0[i]; kv[8 + i] = t1[i]; } }
                { const u32x4 a = *(const u32x4*)(urow + OV + lane * 16), c = *(const u32x4*)(urow + OV + lane * 16 + 8);
                  float t0[8], t1[8]; unpack8(a, t0); unpack8(c, t1);
#pragma unroll
                  for (int i = 0; i < 8; ++i) { vv[i] = t0[i]; vv[8 + i] = t1[i]; } }
                float ss = 0.f;
#pragma unroll
                for (int i = 0; i < 16; ++i) ss += kv[i] * kv[i];
                ss += __shfl_xor(ss, 1); ss += __shfl_xor(ss, 2); ss += __shfl_xor(ss, 4);
                const float rstd = rsqrtf(ss * (1.f / 128.f) + EPS);
                const float* gp = p.in[16] + (lane * 16) % 128;
#pragma unroll
                for (int i = 0; i < 4; ++i) { const f32x4 gg = *(const f32x4*)(gp + 4 * i);
#pragma unroll
                    for (int j = 0; j < 4; ++j) kv[4 * i + j] *= rstd * gg[j]; }
                bf16_t* kd = is_s ? Ks + ((size_t)b * SKEYS + 512 + t) * 1024 + lane * 16 : (dummy5 ? XN + (size_t)r * 1024 + lane * 16 : urow + OKK + lane * 16);
                { float t0[8], t1[8];
#pragma unroll
                  for (int i = 0; i < 8; ++i) { t0[i] = kv[i]; t1[i] = kv[8 + i]; }
                  *(u32x4*)kd = pack8(t0); *(u32x4*)(kd + 8) = pack8(t1); }
                const bool wr_kv = is_s || t >= TSEQ - 512;
                if (wr_kv) {
                    const size_t ro = is_s ? (size_t)rs_ * 1024 : ((size_t)b * 512 + (t - (TSEQ - 512))) * 1024;
                    float* ko = p.out + (is_s ? O_KS : O_KP) + ro + lane * 16; float* vo = p.out + (is_s ? O_VS : O_VP) + ro + lane * 16;
#pragma unroll
                    for (int i = 0; i < 4; ++i) { *(f32x4*)(ko + 4 * i) = (f32x4){kv[4 * i], kv[4 * i + 1], kv[4 * i + 2], kv[4 * i + 3]}; *(f32x4*)(vo + 4 * i) = (f32x4){vv[4 * i], vv[4 * i + 1], vv[4 * i + 2], vv[4 * i + 3]}; }
                }
                const int tl = is_s ? STOK : TSEQ;
                if (t >= tl - 3) {
                    float xv[16];
                    { const u32x4 a = *(const u32x4*)(urow + OXR + lane * 16), c = *(const u32x4*)(urow + OXR + lane * 16 + 8);
                      float t0[8], t1[8]; unpack8(a, t0); unpack8(c, t1);
#pragma unroll
                      for (int i = 0; i < 8; ++i) { xv[i] = t0[i]; xv[8 + i] = t1[i]; } }
                    float* co = p.out + (is_s ? O_CS : O_CP) + ((size_t)b * 3 + (t - (tl - 3))) * 1024 + lane * 16;
#pragma unroll
                    for (int i = 0; i < 4; ++i) *(f32x4*)(co + 4 * i) = (f32x4){xv[4 * i], xv[4 * i + 1], xv[4 * i + 2], xv[4 * i + 3]};
                }
                if (is_s) {
                    const int h = lane >> 3, d0 = (lane & 7) * 16;
                    bf16_t* dst = Vts + ((size_t)(b * 8 + h) * 128 + d0) * SKEYS + 512 + t;
#pragma unroll
                    for (int i = 0; i < 16; ++i) dst[(size_t)i * SKEYS] = (bf16_t)pk2(vv[i], 0.f);
                }


        }
        for (int r = gw; r < T_VT; r += NGW) {
                const int b = r >> 9, c = (r >> 3) & 63, h = r & 7, t = c * 64 + lane;
                const bf16_t* src = U + ((size_t)b * TSEQ + t) * NU + OV + h * 128;
                bf16_t* dst = Vt + ((size_t)(b * 8 + h) * 128) * TSEQ + t;
#pragma unroll 4
                for (int dc = 0; dc < 16; ++dc) { const u32x4 w = *(const u32x4*)(src + dc * 8);
                    dst[(size_t)(dc * 8 + 0) * TSEQ] = (bf16_t)(w.x & 0xffffu); dst[(size_t)(dc * 8 + 1) * TSEQ] = (bf16_t)(w.x >> 16);
                    dst[(size_t)(dc * 8 + 2) * TSEQ] = (bf16_t)(w.y & 0xffffu); dst[(size_t)(dc * 8 + 3) * TSEQ] = (bf16_t)(w.y >> 16);
                    dst[(size_t)(dc * 8 + 4) * TSEQ] = (bf16_t)(w.z & 0xffffu); dst[(size_t)(dc * 8 + 5) * TSEQ] = (bf16_t)(w.z >> 16);
                    dst[(size_t)(dc * 8 + 6) * TSEQ] = (bf16_t)(w.w & 0xffffu); dst[(size_t)(dc * 8 + 7) * TSEQ] = (bf16_t)(w.w >> 16); }


        }
        if (G <= 160) sample_cache_tasks(p, gw, NGW, lane);
        {
            const int nblk = blockIdx.x & 15, slot = (blockIdx.x >> 4) * NWAVES + wave, nslot = (G >> 4) * NWAVES;
            __syncthreads();
            lru_tables_to_lds(p, lds + LT_OFF, nblk, tid);
            for (int rr = 0; rr < 1 + ((REPM >> 17) & 1) * 3; ++rr)
            for (int u = slot; u < NBATCH * 64; u += nslot) lru_unit<0>(p, u >> 6, u & 63, nblk, lane, nullptr, 0u, 0u, lds + LT_OFF);
            (void)T_LRU;
        }
    }
    xcd_barrier(xbar);

    for (int rep_ = 0; rep_ < 1 + ((REPM >> 6) & 1); ++rep_) { if (rep_) grid.sync(); PH_IDS;
        const bool dummy = ((REPM >> 6) & 1) && rep_ == 0;
        LAS float* tbl = (LAS float*)(lds + 65536);
        constexpr int T_AP = NBATCH * 64 * 8 * 2, T_AS = SBATCH * 8, T_LP = NBATCH * 64 * 16, T_LS = SBATCH * 16;
        for (int wt = blockIdx.x; wt < NBATCH * 8 * 16; wt += G) {
            int pair, cg4;
            if (G == 256) { const int itp = wt >> 8, x = blockIdx.x & 7, j = blockIdx.x >> 3; pair = x * 8 + itp * 2 + (j >> 4); cg4 = (j + itp * 4) & 15; }
            else { pair = wt >> 4; cg4 = wt & 15; }
            attn_wg_prompt(p, lds, pair >> 3, pair & 7, cg4, dummy ? XN : U, dummy ? 1024 : NU, dummy ? 0 : OQ, tid);
        }
        __syncthreads();
        for (int q = blockIdx.x; q < T_AS; q += G) if (wave == 0) {
            const int b = q >> 3, h = q & 7;
            for (int i = lane; i < 640; i += 64) { int d = i - 63; d = d < -256 ? -256 : (d > 256 ? 256 : d); tbl[i] = p.in[17][h * 513 + d + 256] * LOG2E; }
            asm volatile("s_waitcnt lgkmcnt(0)" ::: "memory");
            __builtin_amdgcn_wave_barrier();
            bf16_t* qp = U + ((size_t)MP + (size_t)b * STOK) * NU + OQ + h * 128;
            attn_task<true>(qp, NU, dummy ? XN + ((size_t)MP + (size_t)b * STOK) * 1024 + h * 128 : qp, dummy ? 1024 : NU, Ks + (size_t)b * SKEYS * 1024 + h * 128, 1024, Vts + ((size_t)(b * 8 + h) * 128) * SKEYS, SKEYS,
                            17, 528, 1, p.in[15], tbl, 1024 - 512 + 63, lane);
            asm volatile("s_waitcnt lgkmcnt(0)" ::: "memory");
            __builtin_amdgcn_wave_barrier();
        }
        {
            const int nblk = blockIdx.x & 15, slot = (blockIdx.x >> 4) * NWAVES + wave, nslot = (G >> 4) * NWAVES;
            __syncthreads();
            lru_tables_to_lds(p, lds + LT_OFF, nblk, tid);
            for (int u = slot; u < NBATCH * 64 + SBATCH; u += nslot) { const bool pr = u < NBATCH * 64;
                lru_unit<1>(p, pr ? (u >> 6) : NBATCH + (u - NBATCH * 64), pr ? (u & 63) : 0, nblk, lane, dummy ? XN + (size_t)MT * 1024 : U, dummy ? 1024u : (unsigned)NU, dummy ? 0u : (unsigned)OGR, lds + LT_OFF); }
            (void)T_LP; (void)T_LS;
        }
    }
    xcd_barrier(xbar);

    for (int rep_ = 0; rep_ < 1 + ((REPM >> 7) & 1); ++rep_) { if (rep_) grid.sync(); PH_IDS;
        pg8::StaticOrder S; S.init(MT, D, G, (int)blockIdx.x);
        pg8::Gemm g1{U + OQ, (const bf16_t*)(ws + W_PA), MT, D, 1024, NU, 1024};
        pg8::EpiGate E1{U + OGA, U + OGA, NU, 0};
        pg8::gemm_phase<pg8::EpiGate, true>(lds, g1, S, E1, STAG);
        pg8::Gemm g2{U + OGR, (const bf16_t*)(ws + W_PB), MT, D, 1024, NU, 1024};
        pg8::EpiGate E2{U + OGA, U + OGB, NU, 1};
        pg8::gemm_phase<pg8::EpiGate, true>(lds, g2, S, E2, 0);
    }
    xcd_barrier(xbar);

    for (int rep_ = 0; rep_ < 1 + ((REPM >> 8) & 1); ++rep_) { if (rep_) grid.sync(); PH_IDS;
        pg8::Gemm g{U + OGA, (const bf16_t*)(ws + W_OUT), MP, D, D, NU, D}; pg8::StaticOrder S; S.init(MP, D, G, (int)blockIdx.x);
        pg8::EpiResid E{R, nullptr, XN, (float*)(ws + W_SS) + MT, 1.0f};
        pg8::gemm_phase<pg8::EpiResid, true>(lds, g, S, E, STAG);
        pg8::Gemm gs{U + (size_t)MP * NU + OGA, (const bf16_t*)(ws + W_OUT), MS, D, D, NU, D / 4}; pg8::SplitOrder Ss; Ss.init(MS, D, 4, G, (int)blockIdx.x);
        pg8::EpiResidAtomic Es{R + (size_t)MP * D, 1.0f};
        pg8::gemm_phase<pg8::EpiResidAtomic, true>(lds, gs, Ss, Es);
    }
    xcd_barrier(xbar);

    for (int rep_ = 0; rep_ < 1 + ((REPM >> 9) & 1); ++rep_) { PH_IDS;
    for (int m = MP + gw; m < MT; m += NGW) feed_row(R + (size_t)m * D, XN + (size_t)m * D, (float*)(ws + W_SS) + MT + m, lane);
    for (int i = blockIdx.x * 512 + tid; i < MP; i += G * 512) ((float*)(ws + W_SS))[i] = 0.f; }
    xcd_barrier(xbar);

    for (int rep_ = 0; rep_ < 1 + ((REPM >> 10) & 1); ++rep_) { if (rep_) grid.sync(); PH_IDS;
        pg8::Gemm g{XN, (const bf16_t*)(ws + W_MQ), MT, 512, D, D, D}; pg8::StaticOrder S; S.init(MT, 512, G, (int)blockIdx.x);
        pg8::EpiBf16 E{MQ, 512, (const float*)(ws + W_SS) + MT};
        pg8::gemm_phase<pg8::EpiBf16, true>(lds, g, S, E, 0);
    }
    xcd_barrier(xbar);

    for (int rep_ = 0; rep_ < 1 + ((REPM >> 11) & 1); ++rep_) { if (rep_) grid.sync(); PH_IDS;
        constexpr int T_P = (MP / 32) * 4, T_S = SBATCH * 4;
        for (int it = gw; it < T_P + T_S; it += NGW) {
            if (it < T_P) { const int rt = it >> 2, h = it & 3, seq = rt >> 7;
                bf16_t* qp = MQ + (size_t)rt * 32 * 512 + h * 128;
                attn_task<false>(qp, 512, qp, 512, Km + (size_t)seq * 256 * 512 + h * 128, 512, Vtm + ((size_t)(seq * 4 + h) * 128) * 256, 256, 8, 256, 2, p.in[33], nullptr, 0, lane);
            } else { const int q = it - T_P, b = q >> 2, h = q & 3, seq = NBATCH + b;
                bf16_t* qp = MQ + ((size_t)MP + (size_t)b * STOK) * 512 + h * 128;
                attn_task<false>(qp, 512, qp, 512, Km + (size_t)seq * 256 * 512 + h * 128, 512, Vtm + ((size_t)(seq * 4 + h) * 128) * 256, 256, 8, 256, 1, p.in[33], nullptr, 0, lane);
            }
        }
    }
    xcd_barrier(xbar);

    for (int rep_ = 0; rep_ < 1 + ((REPM >> 12) & 1); ++rep_) { if (rep_) grid.sync(); PH_IDS;
        pg8::Gemm g{MQ, (const bf16_t*)(ws + W_MO), MT, D, 512, 512, 512}; pg8::StaticOrder S; S.init(MT, D, G, (int)blockIdx.x);
        pg8::EpiResid E{R, nullptr, XN, (float*)(ws + W_SS) + 2 * MT, 1.0f};
        pg8::gemm_phase<pg8::EpiResid, true>(lds, g, S, E, 0);
    }
    xcd_barrier(xbar);

    for (int rep_ = 0; rep_ < 1 + ((REPM >> 14) & 1); ++rep_) { if (rep_) grid.sync(); PH_IDS;
        pg8::Gemm g{XN, (const bf16_t*)(ws + W_GU2), MT, 2 * FF, D, D, D}; pg8::StaticOrder S; S.init(MT, 2 * FF, G, (int)blockIdx.x);
        pg8::EpiSwiglu E{H, FF, (const float*)(ws + W_SS) + 2 * MT};
        pg8::gemm_phase<pg8::EpiSwiglu, true>(lds, g, S, E, STAG);
    }
    xcd_barrier(xbar);

    for (int rep_ = 0; rep_ < 1 + ((REPM >> 15) & 1); ++rep_) { if (rep_) grid.sync(); PH_IDS;
        pg8::Gemm g{H, (const bf16_t*)(ws + W_D2), MP, D, FF, FF, FF}; pg8::StaticOrder S; S.init(MP, D, G, (int)blockIdx.x);
        pg8::EpiResid E{R, nullptr, XN, (float*)(ws + W_SS), 0.5f};
        pg8::gemm_phase<pg8::EpiResid, true>(lds, g, S, E, STAG);
        pg8::Gemm gs{H + (size_t)MP * FF, (const bf16_t*)(ws + W_D2), MS, D, FF, FF, FF / 4}; pg8::SplitOrder Ss; Ss.init(MS, D, 4, G, (int)blockIdx.x);
        pg8::EpiResidAtomic Es{R + (size_t)MP * D, 0.5f};
        pg8::gemm_phase<pg8::EpiResidAtomic, true>(lds, gs, Ss, Es);
    }
    xcd_barrier(xbar);

    for (int rep_ = 0; rep_ < 1 + ((REPM >> 16) & 1); ++rep_) { PH_IDS;
    for (int m = gw; m < MT; m += NGW) {
        if (m >= MP) { norm_row_f32(R + (size_t)m * D, p.in[40], lane); continue; }
        const float rs = rsqrtf(((const float*)(ws + W_SS))[m] * (1.f / D) + EPS);
        const u32x2* xb = (const u32x2*)(XN + (size_t)m * D) + lane; f32x4* yo = (f32x4*)(R + (size_t)m * D) + lane;
#pragma unroll
        for (int j = 0; j < 8; ++j) { const u32x2 w = xb[64 * j]; const f32x4 gg = ((const f32x4*)p.in[40])[lane + 64 * j];
            yo[64 * j] = (f32x4){bf_lo(w.x) * rs * gg.x, bf_hi(w.x) * rs * gg.y, bf_lo(w.y) * rs * gg.z, bf_hi(w.y) * rs * gg.w}; }
    } }
}

extern "C" void kernel_launch(void* const* d_in, const int* in_sizes, int n_in, void* d_out, int out_size, void* d_ws, size_t ws_size, hipStream_t stream) {
    static int grid = 0;
    if (grid == 0) {
        if (n_in != 41 || (size_t)out_size != O_END || ws_size < W_END) {
            fprintf(stderr, "kernel_launch: unexpected sizes: n_in %d out %d (want %zu) ws %zu (want >= %zu)\n", n_in, out_size, (size_t)O_END, ws_size, (size_t)W_END); grid = -1; return; }
        int dev = 0, cus = 0, per_cu = 0;
        hipGetDevice(&dev); hipDeviceGetAttribute(&cus, hipDeviceAttributeMultiprocessorCount, dev);
        hipFuncSetAttribute((const void*)fwd_megakernel, hipFuncAttributeMaxDynamicSharedMemorySize, LDS_BYTES);
        hipOccupancyMaxActiveBlocksPerMultiprocessor(&per_cu, (const void*)fwd_megakernel, NWAVES * 64, LDS_BYTES);
        if (per_cu < 1) { fprintf(stderr, "kernel_launch: occupancy query says %d blocks per CU\n", per_cu); per_cu = 1; }
        (void)hipGetLastError();
        grid = cus * 1;
    }
    if (grid < 0) return;
    Params p{};
    for (int i = 0; i < 41; ++i) p.in[i] = (const float*)d_in[i];
    p.out = (float*)d_out; p.ws = (unsigned char*)d_ws;
    void* args[] = {&p};
    hipError_t e = hipLaunchCooperativeKernel((const void*)fwd_megakernel, dim3(grid), dim3(NWAVES * 64), args, LDS_BYTES, stream);
    if (e != hipSuccess) fprintf(stderr, "kernel_launch: cooperative launch failed: %s (grid %d)\n", hipGetErrorString(e), grid);
}
```

```cpp
#include <hip/hip_runtime.h>
#include <hip/hip_cooperative_groups.h>
#include <cstdio>
#include <cstdint>
namespace cg = cooperative_groups;

#define LAS __attribute__((address_space(3)))
typedef unsigned short bf16_t;
typedef short bf16x8 __attribute__((ext_vector_type(8)));
typedef float f32x4 __attribute__((ext_vector_type(4)));
typedef float f32x2 __attribute__((ext_vector_type(2)));
typedef unsigned u32x4 __attribute__((ext_vector_type(4)));
typedef unsigned u32x2 __attribute__((ext_vector_type(2)));
typedef __bf16 bf16x2_t __attribute__((ext_vector_type(2)));
#define DI __device__ __forceinline__

constexpr int D = 2048, NBATCH = 8, TSEQ = 4096, MP = NBATCH * TSEQ, SBATCH = 32, STOK = 16, MS = SBATCH * STOK, MT = MP + MS;
constexpr int FF = 5632, NU = 9216, NWAVES = 8;
constexpr int OQ = 0, OKK = 1024, OV = 2048, OXR = 3072, OGR = 4096, OGA = 5120, OGB = 7168;
constexpr int SKEYS = 544;
constexpr float EPS = 1e-6f, LOG2E = 1.4426950408889634f;
constexpr int NSEQ = NBATCH + SBATCH;

constexpr size_t O_YP = 0, O_YS = (size_t)MP * D, O_KP = O_YS + (size_t)MS * D, O_VP = O_KP + (size_t)NBATCH * 512 * 1024,
                 O_CP = O_VP + (size_t)NBATCH * 512 * 1024, O_LP = O_CP + (size_t)NBATCH * 3 * 1024, O_MK = O_LP + (size_t)NBATCH * 1024,
                 O_MV = O_MK + (size_t)NBATCH * 256 * 512, O_KS = O_MV + (size_t)NBATCH * 256 * 512, O_VS = O_KS + (size_t)MS * 1024,
                 O_CS = O_VS + (size_t)MS * 1024, O_LS = O_CS + (size_t)SBATCH * 3 * 1024, O_END = O_LS + (size_t)SBATCH * 1024;

constexpr size_t al256(size_t x) { return (x + 255) & ~(size_t)255; }
constexpr size_t W_GU1 = 0, W_D1 = W_GU1 + (size_t)2 * FF * D * 2, W_IN = W_D1 + (size_t)D * FF * 2, W_PA = W_IN + (size_t)NU * D * 2,
                 W_PB = W_PA + (size_t)D * 1024 * 2, W_OUT = W_PB + (size_t)D * 1024 * 2, W_MQ = W_OUT + (size_t)D * D * 2, W_MKV = W_MQ + (size_t)512 * D * 2,
                 W_MO = W_MKV + (size_t)1024 * D * 2, W_GU2 = W_MO + (size_t)D * 512 * 2, W_D2 = W_GU2 + (size_t)2 * FF * D * 2, W_LRU = W_D2 + (size_t)D * FF * 2,
                 W_C8 = W_LRU + (size_t)2 * 16 * 64 * 64 * 2, W_XN = al256(W_C8 + 1024 * 4), W_U = W_XN + (size_t)MT * D * 2, W_VT = W_U + (size_t)MT * NU * 2,
                 W_KS = W_VT + (size_t)NBATCH * 8 * 128 * TSEQ * 2, W_VTS = W_KS + (size_t)SBATCH * SKEYS * 1024 * 2, W_KM = W_VTS + (size_t)SBATCH * 8 * 128 * SKEYS * 2,
                 W_VTM = W_KM + (size_t)NSEQ * 256 * 512 * 2, W_CA = W_VTM + (size_t)NSEQ * 4 * 128 * 256 * 2, W_CB = W_CA + (size_t)NBATCH * 64 * 1024 * 4,
                 W_SS = W_CB + (size_t)NBATCH * 64 * 1024 * 4, W_BAR = al256(W_SS + (size_t)3 * MT * 4), W_END = W_BAR + 16384;
constexpr size_t W_H = W_U, W_MQB = W_U, W_MN = W_VT, W_MKVF = W_MN + (size_t)2048 * D * 2;

#ifndef STAG
#define STAG 0
#endif
#ifndef REPM
#define REPM 0
#endif
constexpr int RING_BYTES = 131072, LDS_BYTES = 147456;

struct Params { const float* in[41]; float* out; unsigned char* ws; };

DI unsigned pk2(float a, float b) { f32x2 v = {a, b}; bf16x2_t r = __builtin_convertvector(v, bf16x2_t); return __builtin_bit_cast(unsigned, r); }
DI float bf_lo(unsigned w) { return __builtin_bit_cast(float, w << 16); }
DI float bf_hi(unsigned w) { return __builtin_bit_cast(float, w & 0xffff0000u); }
DI void unpack8(const u32x4 w, float (&f)[8]) { f[0] = bf_lo(w.x); f[1] = bf_hi(w.x); f[2] = bf_lo(w.y); f[3] = bf_hi(w.y); f[4] = bf_lo(w.z); f[5] = bf_hi(w.z); f[6] = bf_lo(w.w); f[7] = bf_hi(w.w); }
DI u32x4 pack8(const float (&f)[8]) { u32x4 w; w.x = pk2(f[0], f[1]); w.y = pk2(f[2], f[3]); w.z = pk2(f[4], f[5]); w.w = pk2(f[6], f[7]); return w; }
DI float wave_sum(float v) {
#pragma unroll
    for (int o = 1; o < 64; o <<= 1) v += __shfl_xor(v, o);
    return v;
}
DI float fast_exp2(float x) { return __builtin_amdgcn_exp2f(x); }
DI float fast_rcp(float x) { return __builtin_amdgcn_rcpf(x); }
DI float sigmoidf_(float x) { return fast_rcp(1.0f + fast_exp2(-x * LOG2E)); }
template <int S> DI float dpp_shr(float old, float v) {
    return __builtin_bit_cast(float, __builtin_amdgcn_update_dpp(__builtin_bit_cast(int, old), __builtin_bit_cast(int, v), 0x110 + S, 0xf, 0xf, false));
}
#define LDS_WAIT() asm volatile("s_waitcnt lgkmcnt(0)" ::: "memory")

namespace pg8 {
constexpr int BM = 256, BK = 64, HALF = 128, HTB = HALF * BK * 2, STAGE_BYTES = 8 * HTB, NXCD = 8, WGM = 8;
DI int lds_byte(int r, int c) { const int st = (r >> 4) * 2 + (c >> 5), rr = r & 15, cc = c & 31, ob = rr * 64 + cc * 2; return st * 1024 + (ob ^ (((ob >> 9) & 1) << 5)); }
DI void stage_rc(int b, int& R, int& C) { const int st = b / 1024, sb = b % 1024, swz = sb ^ (((sb >> 9) & 1) << 5); R = (st >> 1) * 16 + swz / 64; C = (st & 1) * 32 + (swz % 64) / 2; }
DI int perm32(int rho) { const int n = rho >> 4, i = rho & 15; return 8 * (i >> 2) + 4 * n + (i & 3); }
struct Unit { int pm, pn, ks, sel; };
struct Gemm { const bf16_t* A; const bf16_t* Bt; int M, N, K, lda, kloop; const bf16_t* A2; const bf16_t* Bt2; };
struct StaticOrder {
    int nM, nN, nwg, G, c;
    DI void init(int M, int N, int G_, int c_) { nM = M / BM; nN = N / BM; nwg = nM * nN; G = G_; c = c_; }
    DI bool next(int i, Unit& u) const {
        const long L = (long)i * G + c; if (L >= nwg) return false;
        int wgid = (int)L; { const int q = nwg / NXCD, r = nwg % NXCD, xcd = wgid % NXCD, off = wgid / NXCD; wgid = (xcd < r ? xcd * (q + 1) : r * (q + 1) + (xcd - r) * q) + off; }
        const int nig = WGM * nN, gid = wgid / nig, fm = gid * WGM, gsz = (nM - fm) < WGM ? (nM - fm) : WGM;
        u.pm = fm + ((wgid % nig) % gsz); u.pn = (wgid % nig) / gsz; u.ks = 0; u.sel = 0; return true;
    }
};
struct PairOrder {
    StaticOrder S;
    DI void init(int M, int N, int G_, int c_) { S.init(M, N, G_, c_); }
    DI bool next(int i, Unit& u) const { if (!S.next(i >> 1, u)) return false; u.sel = i & 1; return true; }
};
struct SplitOrder {
    int nM, nN, ntot, G, c;
    DI void init(int M, int N, int nsplit, int G_, int c_) { nM = M / BM; nN = N / BM; ntot = nM * nN * nsplit; G = G_; c = c_; }
    DI bool next(int i, Unit& u) const {
        const int L = i * G + c; if (L >= ntot) return false;
        u.pm = L % nM; const int r = L / nM; u.pn = r % nN; u.ks = r / nN; u.sel = 0; return true;
    }
};
typedef f32x4 Acc[2][2][4][2];

struct EpiBf16 {
    static constexpr bool PERM = true;
    bf16_t* O; int ldc; const float* ss;
    DI void operator()(const Acc& acc, const Unit& u, int wr, int wc, int fr, int fq) const {
        const int row0 = u.pm * BM + wr * 64 + fr, col0 = u.pn * BM + wc * 32 + 8 * fq;
#pragma unroll
        for (int ai = 0; ai < 2; ++ai)
#pragma unroll
            for (int m = 0; m < 4; ++m) { bf16_t* rowp = O + (size_t)(row0 + ai * HALF + m * 16) * ldc + col0;
                const float rs = ss ? rsqrtf(ss[row0 + ai * HALF + m * 16] * (1.f / D) + EPS) : 1.f;
#pragma unroll
                for (int bj = 0; bj < 2; ++bj) { const f32x4 v0 = acc[ai][bj][m][0] * rs, v1 = acc[ai][bj][m][1] * rs;
                    u32x4 w; w.x = pk2(v0[0], v0[1]); w.y = pk2(v0[2], v0[3]); w.z = pk2(v1[0], v1[1]); w.w = pk2(v1[2], v1[3]);
                    *(u32x4*)(rowp + bj * HALF) = w; } }
    }
};
struct EpiSwiglu {
    static constexpr bool PERM = true;
    bf16_t* O; int ldc; const float* ss;
    DI void operator()(const Acc& acc, const Unit& u, int wr, int wc, int fr, int fq) const {
        const int row0 = u.pm * BM + wr * 64 + fr, col0 = u.pn * HALF + wc * 32 + 8 * fq;
#pragma unroll
        for (int ai = 0; ai < 2; ++ai)
#pragma unroll
            for (int m = 0; m < 4; ++m) {
                const float rs = ss ? rsqrtf(ss[row0 + ai * HALF + m * 16] * (1.f / D) + EPS) : 1.f;
                float h[8];
#pragma unroll
                for (int n = 0; n < 2; ++n)
#pragma unroll
                    for (int j = 0; j < 4; ++j) { const float g = acc[ai][0][m][n][j] * rs, up = acc[ai][1][m][n][j] * rs; h[n * 4 + j] = g * sigmoidf_(g) * up; }
                *(u32x4*)(O + (size_t)(row0 + ai * HALF + m * 16) * ldc + col0) = pack8(h); }
    }
};
struct EpiGate {
    static constexpr bool PERM = true;
    bf16_t* O; const bf16_t* G0; const bf16_t* G1; int ld;
    DI void operator()(const Acc& acc, const Unit& u, int wr, int wc, int fr, int fq) const {
        const int row0 = u.pm * BM + wr * 64 + fr, col0 = u.pn * BM + wc * 32 + 8 * fq;
        const int accum = u.sel; const bf16_t* const G = accum ? G1 : G0;
#pragma unroll
        for (int ai = 0; ai < 2; ++ai)
#pragma unroll
            for (int m = 0; m < 4; ++m)
#pragma unroll
                for (int bj = 0; bj < 2; ++bj) {
                    const size_t off = (size_t)(row0 + ai * HALF + m * 16) * ld + col0 + bj * HALF;
                    float gv[8], o[8]; unpack8(*(const u32x4*)(G + off), gv);
                    if (accum) unpack8(*(const u32x4*)(O + off), o);
                    else {
#pragma unroll
                        for (int i = 0; i < 8; ++i) o[i] = 0.f; }
#pragma unroll
                    for (int n = 0; n < 2; ++n)
#pragma unroll
                        for (int j = 0; j < 4; ++j) o[n * 4 + j] += sigmoidf_(gv[n * 4 + j]) * acc[ai][bj][m][n][j];
                    *(u32x4*)(O + off) = pack8(o); }
    }
};
struct EpiResid {
    static constexpr bool PERM = false;
    float* R; const float* xp; bf16_t* Xb; float* ss; float alpha;
    DI void operator()(const Acc& acc, const Unit& u, int wr, int wc, int fr, int fq) const {
        const float al = alpha; bf16_t* const xb = Xb; float* const ssp = ss; const float* const xin = xp; float* const rf = R;
        const int row0 = u.pm * BM + wr * 64 + fr, col0 = u.pn * BM + wc * 32 + 4 * fq;
        const bool smp = u.pm * BM >= MP;
#pragma unroll
        for (int ai = 0; ai < 2; ++ai)
#pragma unroll
            for (int m = 0; m < 4; ++m) { const int row = row0 + ai * HALF + m * 16;
                const size_t ro = (size_t)row * D + col0;
                float sq = 0.f;
#pragma unroll
                for (int bj = 0; bj < 2; ++bj)
#pragma unroll
                    for (int n = 0; n < 2; ++n) { const size_t o = ro + bj * HALF + n * 16;
                        f32x4 b;
                        if (smp) b = *(const f32x4*)(rf + o);
                        else if (xin) b = *(const f32x4*)(xin + o);
                        else { const u32x2 w0 = *(const u32x2*)(xb + o); b = (f32x4){bf_lo(w0.x), bf_hi(w0.x), bf_lo(w0.y), bf_hi(w0.y)}; }
                        const f32x4 a4 = acc[ai][bj][m][n];
                        f32x4 v; v[0] = b[0] + al * a4[0]; v[1] = b[1] + al * a4[1]; v[2] = b[2] + al * a4[2]; v[3] = b[3] + al * a4[3];
                        if (smp) *(f32x4*)(rf + o) = v;
                        u32x2 w; w.x = pk2(v[0], v[1]); w.y = pk2(v[2], v[3]); *(u32x2*)(xb + o) = w;
                        sq += (v[0] * v[0] + v[1] * v[1]) + (v[2] * v[2] + v[3] * v[3]); }
                sq += __shfl_xor(sq, 16); sq += __shfl_xor(sq, 32); if (fq == 0) unsafeAtomicAdd(ssp + row, sq); }
    }
};
struct EpiResidAtomic {
    static constexpr bool PERM = false;
    float* R; float alpha;
    DI void operator()(const Acc& acc, const Unit& u, int wr, int wc, int fr, int fq) const {
        const int row0 = u.pm * BM + wr * 64 + fr, col0 = u.pn * BM + wc * 32 + 4 * fq;
#pragma unroll
        for (int ai = 0; ai < 2; ++ai)
#pragma unroll
            for (int m = 0; m < 4; ++m) { float* rp = R + (size_t)(row0 + ai * HALF + m * 16) * D + col0;
#pragma unroll
                for (int bj = 0; bj < 2; ++bj)
#pragma unroll
                    for (int n = 0; n < 2; ++n)
#pragma unroll
                        for (int j = 0; j < 4; ++j) unsafeAtomicAdd(rp + bj * HALF + n * 16 + j, alpha * acc[ai][bj][m][n][j]); }
    }
};
struct EpiF32 {
    static constexpr bool PERM = false;
    float* C; int ldc;
    DI void operator()(const Acc& acc, const Unit& u, int wr, int wc, int fr, int fq) const {
        const int row0 = u.pm * BM + wr * 64 + fr, col0 = u.pn * BM + wc * 32 + 4 * fq;
#pragma unroll
        for (int ai = 0; ai < 2; ++ai)
#pragma unroll
            for (int m = 0; m < 4; ++m) { float* rp = C + (size_t)(row0 + ai * HALF + m * 16) * ldc + col0;
#pragma unroll
                for (int bj = 0; bj < 2; ++bj)
#pragma unroll
                    for (int n = 0; n < 2; ++n) *(f32x4*)(rp + bj * HALF + n * 16) = acc[ai][bj][m][n]; }
    }
};

template <class Epi, bool ALIGN_EPI, class Sched>
DI void gemm_phase(LAS unsigned char* lds, const Gemm g, const Sched& S, const Epi& E, int stag = 0) {
    int tid = threadIdx.x; asm volatile("" : "+v"(tid));
    const int wid = __builtin_amdgcn_readfirstlane(tid >> 6), lane = tid & 63, wr = wid >> 2, wc = wid & 3, fr = lane & 15, fq = lane >> 4;
    const int K = g.K, nt = g.kloop / BK;
    const size_t ksl = (size_t)g.kloop * 2;
    unsigned voffA[2], voffB[2];
#pragma unroll
    for (int i = 0; i < 2; ++i) { int R, C; stage_rc(tid * 16 + i * 8192, R, C); const int Rb = Epi::PERM ? ((R & ~31) + perm32(R & 31)) : R;
        voffA[i] = (unsigned)(R * g.lda + C) * 2u; voffB[i] = (unsigned)(Rb * K + C) * 2u; }
    const size_t kstep = (size_t)(BK * 2);
    const size_t hstepA = (size_t)HALF * g.lda * 2, hstepB = (size_t)HALF * K * 2;
    const size_t tstepA = 2 * hstepA, tstepB = 2 * hstepB;
    const unsigned ldsw = (unsigned)wid * 1024u;
    const int aoff = lds_byte(wr * 64 + fr, fq * 8), boff = lds_byte(wc * 32 + fr, fq * 8);
#define PG8_SA(b, h) (((b) * 2 + (h)) * HTB)
#define PG8_SB(b, h) ((4 + (b) * 2 + (h)) * HTB)
#define PG8_STAGE(bufoff, gbase, voff) do { _Pragma("unroll") for (int _i = 0; _i < 2; ++_i) \
        __builtin_amdgcn_global_load_lds((const unsigned*)((const char*)(gbase) + (voff)[_i]), (LAS unsigned*)(lds + (bufoff) + ldsw + _i * 8192), 16, 0, 0); } while (0)
#define PG8_LDA(dst, b, h) do { _Pragma("unroll") for (int m = 0; m < 4; ++m) _Pragma("unroll") for (int k = 0; k < 2; ++k) dst[m][k] = *(const LAS bf16x8*)(lds + PG8_SA(b, h) + aoff + m * 2048 + k * 1024); } while (0)
#define PG8_LDB(dst, b, h) do { _Pragma("unroll") for (int n = 0; n < 2; ++n) _Pragma("unroll") for (int k = 0; k < 2; ++k) dst[n][k] = *(const LAS bf16x8*)(lds + PG8_SB(b, h) + boff + n * 2048 + k * 1024); } while (0)
#define PG8_MMA(ai, bj, At, Bt) do { __builtin_amdgcn_s_setprio(1); _Pragma("unroll") for (int m = 0; m < 4; ++m) _Pragma("unroll") for (int n = 0; n < 2; ++n) _Pragma("unroll") for (int k = 0; k < 2; ++k) \
        acc[ai][bj][m][n] = __builtin_amdgcn_mfma_f32_16x16x32_bf16(Bt[n][k], At[m][k], acc[ai][bj][m][n], 0, 0, 0); __builtin_amdgcn_s_setprio(0); } while (0)
#define PG8_WAIT_V(n) asm volatile("s_waitcnt vmcnt(" #n ")" ::: "memory")
#define PG8_WAIT_L(n) asm volatile("s_waitcnt lgkmcnt(" #n ")" ::: "memory")
#define PG8_BAR __builtin_amdgcn_s_barrier()
#define PG8_SCHED __builtin_amdgcn_sched_barrier(0)
    Unit cur, nxt; int ui = 0;
    if (!S.next(0, cur)) return;
    if (stag) {
        const unsigned long long t0 = __builtin_amdgcn_s_memrealtime(), dl = (unsigned long long)((blockIdx.x >> 5) & 7) * (unsigned)stag;
        while (__builtin_amdgcn_s_memrealtime() - t0 < dl) __builtin_amdgcn_s_sleep(8);
    }
    Acc acc;
#pragma unroll
    for (int a = 0; a < 2; ++a)
#pragma unroll
        for (int b = 0; b < 2; ++b)
#pragma unroll
            for (int m = 0; m < 4; ++m)
#pragma unroll
                for (int n = 0; n < 2; ++n) acc[a][b][m][n] = (f32x4){0.f, 0.f, 0.f, 0.f};
    bf16x8 At[4][2], B0[2][2], B1[2][2];
    const char* cA = (const char*)(cur.sel ? g.A2 : g.A) + (size_t)cur.pm * tstepA + (size_t)cur.ks * ksl; const char* cB = (const char*)(cur.sel ? g.Bt2 : g.Bt) + (size_t)cur.pn * tstepB + (size_t)cur.ks * ksl;
    PG8_STAGE(PG8_SB(0, 0), cB, voffB); PG8_STAGE(PG8_SB(0, 1), cB + hstepB, voffB); PG8_STAGE(PG8_SA(0, 0), cA, voffA); PG8_STAGE(PG8_SA(0, 1), cA + hstepA, voffA);
    if (wr == 1) PG8_BAR;
    PG8_WAIT_V(2); PG8_BAR;
    PG8_STAGE(PG8_SB(1, 0), cB + kstep, voffB); PG8_STAGE(PG8_SA(1, 0), cA + kstep, voffA); PG8_STAGE(PG8_SB(1, 1), cB + hstepB + kstep, voffB);
    PG8_WAIT_V(6); PG8_BAR;
    for (;;) {
        const bool has_next = S.next(ui + 1, nxt);
        const char* nA = has_next ? (const char*)(nxt.sel ? g.A2 : g.A) + (size_t)nxt.pm * tstepA + (size_t)nxt.ks * ksl : cA; const char* nB = has_next ? (const char*)(nxt.sel ? g.Bt2 : g.Bt) + (size_t)nxt.pn * tstepB + (size_t)nxt.ks * ksl : cB;
        for (int t = 0; t < nt; t += 2) {
            const bool last = (t == nt - 2);
            const char* a1 = cA + (size_t)(t + 1) * kstep;
            const char* a2 = last ? nA : cA + (size_t)(t + 2) * kstep; const char* b2 = last ? nB : cB + (size_t)(t + 2) * kstep;
            const char* a3 = a2 + kstep; const char* b3 = b2 + kstep;
            PG8_LDB(B0, 0, 0); PG8_LDB(B1, 0, 1); PG8_SCHED; PG8_LDA(At, 0, 0); PG8_STAGE(PG8_SA(1, 1), a1 + hstepA, voffA);
            PG8_WAIT_V(8); PG8_WAIT_L(0); PG8_BAR; PG8_MMA(0, 0, At, B0); PG8_MMA(0, 1, At, B1); PG8_BAR; PG8_SCHED;
            PG8_LDA(At, 0, 1); PG8_STAGE(PG8_SB(0, 0), b2, voffB); PG8_STAGE(PG8_SB(0, 1), b2 + hstepB, voffB); PG8_STAGE(PG8_SA(0, 0), a2, voffA);
            PG8_WAIT_V(8); PG8_WAIT_L(0); PG8_BAR; PG8_MMA(1, 0, At, B0); PG8_MMA(1, 1, At, B1); PG8_BAR; PG8_SCHED;
            PG8_LDB(B0, 1, 0); PG8_LDB(B1, 1, 1); PG8_SCHED; PG8_LDA(At, 1, 0); PG8_STAGE(PG8_SA(0, 1), a2 + hstepA, voffA);
            PG8_WAIT_V(8); PG8_WAIT_L(0); PG8_BAR; PG8_MMA(0, 0, At, B0); PG8_MMA(0, 1, At, B1); PG8_BAR; PG8_SCHED;
            PG8_LDA(At, 1, 1); PG8_STAGE(PG8_SB(1, 0), b3, voffB); PG8_STAGE(PG8_SB(1, 1), b3 + hstepB, voffB); PG8_STAGE(PG8_SA(1, 0), a3, voffA);
            PG8_WAIT_V(8); PG8_WAIT_L(0); PG8_BAR; PG8_MMA(1, 0, At, B0); PG8_MMA(1, 1, At, B1); PG8_BAR; PG8_SCHED;
        }
        if constexpr (ALIGN_EPI) { if (wr == 0) PG8_BAR; }
        E(acc, cur, wr, wc, fr, fq);
        if (!has_next) break;
#pragma unroll
        for (int a = 0; a < 2; ++a)
#pragma unroll
            for (int b = 0; b < 2; ++b)
#pragma unroll
                for (int m = 0; m < 4; ++m)
#pragma unroll
                    for (int n = 0; n < 2; ++n) acc[a][b][m][n] = (f32x4){0.f, 0.f, 0.f, 0.f};
        cur = nxt; cA = nA; cB = nB; ++ui;
        if constexpr (ALIGN_EPI) { if (wr == 1) PG8_BAR; }
    }
    PG8_WAIT_V(0);
    if constexpr (!ALIGN_EPI) { if (wr == 0) PG8_BAR; }
    PG8_BAR;
#undef PG8_SA
#undef PG8_SB
#undef PG8_STAGE
#undef PG8_LDA
#undef PG8_LDB
#undef PG8_MMA
#undef PG8_WAIT_V
#undef PG8_WAIT_L
#undef PG8_BAR
#undef PG8_SCHED
}
}

DI void transpose_item(const float* W, int K, int N, bf16_t* WT, int sh, int add, LAS float* scr, int item, int lane, const float* gain) {
    const int nblk = N / 32, kb = item / nblk, nb = item % nblk, k0 = 64 * kb, n0 = 32 * nb;
#pragma unroll 8
    for (int i = 0; i < 32; ++i) { const int kk = 2 * i + (lane >> 5); const float gk = gain ? gain[k0 + kk] : 1.f; scr[kk * 33 + (lane & 31)] = W[(size_t)(k0 + kk) * N + n0 + (lane & 31)] * gk; }
    LDS_WAIT();
    const int c = lane & 7;
#pragma unroll
    for (int j = 0; j < 4; ++j) { const int n = (lane >> 3) + 8 * j; const LAS float* s = scr + (8 * c) * 33 + n;
        u32x4 o; o.x = pk2(s[0 * 33], s[1 * 33]); o.y = pk2(s[2 * 33], s[3 * 33]); o.z = pk2(s[4 * 33], s[5 * 33]); o.w = pk2(s[6 * 33], s[7 * 33]);
        const int cc = n0 + n, drow = ((cc >> 7) << sh) + add + (cc & 127);
        *(u32x4*)(WT + (size_t)drow * K + k0 + 8 * c) = o; }
    LDS_WAIT();
}
DI void norm_row_bf16(const float* xrow, const float* gain, bf16_t* orow, int lane) {
    const f32x4* xr = (const f32x4*)xrow + lane;
    f32x4 v[8]; float s = 0.f;
#pragma unroll
    for (int j = 0; j < 8; ++j) { v[j] = xr[64 * j]; s += (v[j].x * v[j].x + v[j].y * v[j].y) + (v[j].z * v[j].z + v[j].w * v[j].w); }
    const float rstd = rsqrtf(wave_sum(s) * (1.f / D) + EPS);
    u32x2* o8 = (u32x2*)orow + lane;
#pragma unroll
    for (int j = 0; j < 8; ++j) { const f32x4 gg = ((const f32x4*)gain)[lane + 64 * j]; u32x2 w; w.x = pk2(v[j].x * rstd * gg.x, v[j].y * rstd * gg.y); w.y = pk2(v[j].z * rstd * gg.z, v[j].w * rstd * gg.w); o8[64 * j] = w; }
}
DI void norm_row_f32(float* xrow, const float* gain, int lane) {
    f32x4* xr = (f32x4*)xrow + lane;
    f32x4 v[8]; float s = 0.f;
#pragma unroll
    for (int j = 0; j < 8; ++j) { v[j] = xr[64 * j]; s += (v[j].x * v[j].x + v[j].y * v[j].y) + (v[j].z * v[j].z + v[j].w * v[j].w); }
    const float rstd = rsqrtf(wave_sum(s) * (1.f / D) + EPS);
#pragma unroll
    for (int j = 0; j < 8; ++j) { const f32x4 gg = ((const f32x4*)gain)[lane + 64 * j]; xr[64 * j] = v[j] * rstd * gg; }
}

DI void feed_row(const float* xrow, bf16_t* orow, float* ssp, int lane) {
    const f32x4* xr = (const f32x4*)xrow + lane;
    f32x4 v[8]; float s = 0.f;
#pragma unroll
    for (int j = 0; j < 8; ++j) { v[j] = xr[64 * j]; s += (v[j].x * v[j].x + v[j].y * v[j].y) + (v[j].z * v[j].z + v[j].w * v[j].w); }
    s = wave_sum(s);
    u32x2* o8 = (u32x2*)orow + lane;
#pragma unroll
    for (int j = 0; j < 8; ++j) { u32x2 w; w.x = pk2(v[j].x, v[j].y); w.y = pk2(v[j].z, v[j].w); o8[64 * j] = w; }
    if (lane == 0) *ssp = s;
}

DI void attn_load_q(bf16x8 (&qf)[2][4], const bf16_t* Qp, int ldq, int nqg, const float* qgain, int fr, int fq) {
#pragma unroll
    for (int g = 0; g < 2; ++g) {
        if (g < nqg) {
            const bf16_t* qrow = Qp + (size_t)(g * 16 + fr) * ldq + fq * 8;
            float qv[4][8]; float ss = 0.f;
#pragma unroll
            for (int s = 0; s < 4; ++s) { unpack8(*(const u32x4*)(qrow + s * 32), qv[s]);
#pragma unroll
                for (int e = 0; e < 8; ++e) ss += qv[s][e] * qv[s][e]; }
            ss += __shfl_xor(ss, 16); ss += __shfl_xor(ss, 32);
            const float rs = rsqrtf(ss * (1.f / 128.f) + EPS) * (0.08838834764831845f * LOG2E);
#pragma unroll
            for (int s = 0; s < 4; ++s) { const f32x4 g0 = *(const f32x4*)(qgain + s * 32 + fq * 8), g1 = *(const f32x4*)(qgain + s * 32 + fq * 8 + 4);
                float t[8];
#pragma unroll
                for (int e = 0; e < 4; ++e) { t[e] = qv[s][e] * rs * g0[e]; t[4 + e] = qv[s][4 + e] * rs * g1[e]; }
                qf[g][s] = __builtin_bit_cast(bf16x8, pack8(t)); }
        } else {
#pragma unroll
            for (int s = 0; s < 4; ++s) qf[g][s] = (bf16x8){0, 0, 0, 0, 0, 0, 0, 0};
        }
    }
}
template <bool BIAS>
DI void attn_tile(const bf16x8 (&kf)[2][4], const bf16x8 (&vf)[8], const bf16x8 (&qf)[2][4], f32x4 (&o)[2][8], float (&mrun)[2], float (&lrun)[2],
                  int nqg, const LAS float* tbl, int idx0, bool tail, int kpos0, int nvalid) {
    f32x4 st[2][2];
#pragma unroll
    for (int g = 0; g < 2; ++g)
#pragma unroll
        for (int hh = 0; hh < 2; ++hh) { st[g][hh] = (f32x4){0.f, 0.f, 0.f, 0.f};
#pragma unroll
            for (int s = 0; s < 4; ++s) st[g][hh] = __builtin_amdgcn_mfma_f32_16x16x32_bf16(kf[hh][s], qf[g][s], st[g][hh], 0, 0, 0); }
#pragma unroll
    for (int g = 0; g < 2; ++g) {
        if (g < nqg) {
            float sv[8];
#pragma unroll
            for (int e = 0; e < 4; ++e) { sv[e] = st[g][0][e]; sv[4 + e] = st[g][1][e]; }
            if (BIAS) {
#pragma unroll
                for (int e = 0; e < 8; ++e) sv[e] += tbl[idx0 + g * 16 - e]; }
            if (tail) {
#pragma unroll
                for (int e = 0; e < 8; ++e) if (kpos0 + e >= nvalid) sv[e] = -1e30f; }
            float tmax = fmaxf(fmaxf(fmaxf(sv[0], sv[1]), fmaxf(sv[2], sv[3])), fmaxf(fmaxf(sv[4], sv[5]), fmaxf(sv[6], sv[7])));
            tmax = fmaxf(tmax, __shfl_xor(tmax, 16)); tmax = fmaxf(tmax, __shfl_xor(tmax, 32));
            const float mn = fmaxf(mrun[g], tmax), alpha = fast_exp2(mrun[g] - mn); mrun[g] = mn;
            float pv[8], ps = 0.f;
#pragma unroll
            for (int e = 0; e < 8; ++e) { pv[e] = fast_exp2(sv[e] - mn); ps += pv[e]; }
            lrun[g] = lrun[g] * alpha + ps;
            const bf16x8 pf = __builtin_bit_cast(bf16x8, pack8(pv));
#pragma unroll
            for (int dt = 0; dt < 8; ++dt) { o[g][dt] = o[g][dt] * alpha; o[g][dt] = __builtin_amdgcn_mfma_f32_16x16x32_bf16(vf[dt], pf, o[g][dt], 0, 0, 0); }
        }
    }
}
DI void attn_store_o(const f32x4 (&o)[2][8], const float (&lrun)[2], bf16_t* Op, int ldo, int nqg, int fr, int fq) {
#pragma unroll
    for (int g = 0; g < 2; ++g) {
        if (g < nqg) {
            float lt = lrun[g]; lt += __shfl_xor(lt, 16); lt += __shfl_xor(lt, 32);
            const float inv = 1.0f / lt;
            bf16_t* orow = Op + (size_t)(g * 16 + fr) * ldo + fq * 4;
#pragma unroll
            for (int dt = 0; dt < 8; ++dt) { u32x2 w; w.x = pk2(o[g][dt][0] * inv, o[g][dt][1] * inv); w.y = pk2(o[g][dt][2] * inv, o[g][dt][3] * inv); *(u32x2*)(orow + dt * 16) = w; }
        }
    }
}
template <bool BIAS>
DI void attn_task(const bf16_t* Qp, int ldq, bf16_t* Op, int ldo, const bf16_t* Kp, int ldk, const bf16_t* Vtp, int ldv,
                  int nkt, int nvalid, int nqg, const float* qgain, const LAS float* tbl, int dbase, int lane) {
    const int fr = lane & 15, fq = lane >> 4;
    bf16x8 qf[2][4];
    attn_load_q(qf, Qp, ldq, nqg, qgain, fr, fq);
    f32x4 o[2][8];
#pragma unroll
    for (int g = 0; g < 2; ++g)
#pragma unroll
        for (int dt = 0; dt < 8; ++dt) o[g][dt] = (f32x4){0.f, 0.f, 0.f, 0.f};
    float mrun[2] = {-1e30f, -1e30f}, lrun[2] = {0.f, 0.f};
    const bf16_t* kb0 = Kp + (size_t)((fr >> 2) * 8 + (fr & 3)) * ldk + fq * 8;
    const bf16_t* vb0 = Vtp + (size_t)fr * ldv + fq * 8;
#pragma unroll 1
    for (int kt = 0; kt < nkt; ++kt) {
        const bf16_t* kb = kb0 + (size_t)kt * 32 * ldk;
        bf16x8 kf[2][4];
#pragma unroll
        for (int hh = 0; hh < 2; ++hh)
#pragma unroll
            for (int s = 0; s < 4; ++s) kf[hh][s] = *(const bf16x8*)(kb + (size_t)hh * 4 * ldk + s * 32);
        bf16x8 vf[8];
#pragma unroll
        for (int dt = 0; dt < 8; ++dt) vf[dt] = *(const bf16x8*)(vb0 + (size_t)dt * 16 * ldv + kt * 32);
        attn_tile<BIAS>(kf, vf, qf, o, mrun, lrun, nqg, tbl, dbase + fr - kt * 32 - fq * 8, kt * 32 + 32 > nvalid, kt * 32 + fq * 8, nvalid);
    }
    attn_store_o(o, lrun, Op, ldo, nqg, fr, fq);
}
constexpr int AT_TBL = 0, AT_K = 4096, AT_KB = 32 * 272, AT_V = AT_K + 2 * AT_KB, AT_VB = 128 * 80;
DI void attn_wg_prompt(const Params& p, LAS unsigned char* lds, int b, int h, int cg, bf16_t* obase, int ldo, int ocol, int tid) {
    const int lane = tid & 63, wave = __builtin_amdgcn_readfirstlane(tid >> 6), fr = lane & 15, fq = lane >> 4;
    const int c = cg * 4 + (wave >> 1), half = wave & 1;
    const bf16_t* Ub = (const bf16_t*)(p.ws + W_U); const bf16_t* Vtg = (const bf16_t*)(p.ws + W_VT);
    LAS float* tbl = (LAS float*)(lds + AT_TBL);
    __syncthreads();
    for (int i = tid; i < 640; i += NWAVES * 64) { int d = i - 63; d = d < -256 ? -256 : (d > 256 ? 256 : d); tbl[i] = p.in[17][h * 513 + d + 256] * LOG2E; }
    const size_t qrow0 = (size_t)b * TSEQ + c * 64 + half * 32;
    bf16x8 qf[2][4];
    attn_load_q(qf, Ub + qrow0 * NU + OQ + h * 128, NU, 2, p.in[15], fr, fq);
    f32x4 o[2][8];
#pragma unroll
    for (int g = 0; g < 2; ++g)
#pragma unroll
        for (int dt = 0; dt < 8; ++dt) o[g][dt] = (f32x4){0.f, 0.f, 0.f, 0.f};
    float mrun[2] = {-1e30f, -1e30f}, lrun[2] = {0.f, 0.f};
    const int key_lo = (cg * 4 - 8) * 64 > 0 ? (cg * 4 - 8) * 64 : 0, nkt = ((cg * 4 + 4) * 64 - key_lo) / 32;
    const bf16_t* kg = Ub + ((size_t)b * TSEQ + key_lo + (tid >> 4)) * NU + OKK + h * 128 + (tid & 15) * 8;
    const bf16_t* vg = Vtg + ((size_t)(b * 8 + h) * 128 + (tid >> 2)) * TSEQ + key_lo + (tid & 3) * 8;
    const unsigned kw = (unsigned)(tid >> 4) * 272u + (unsigned)(tid & 15) * 16u, vw = (unsigned)(tid >> 2) * 80u + (unsigned)(tid & 3) * 16u;
    const unsigned kroff = (unsigned)((fr >> 2) * 8 + (fr & 3)) * 272u + (unsigned)fq * 16u, vroff = (unsigned)fr * 80u + (unsigned)fq * 16u;
    const int dbase = c * 64 + half * 32 - key_lo + 63;
    u32x4 kr = *(const u32x4*)kg, vr = *(const u32x4*)vg;
#pragma unroll 1
    for (int kt = 0; kt < nkt; ++kt) {
        const int buf = kt & 1;
        *(LAS u32x4*)(lds + AT_K + buf * AT_KB + kw) = kr; *(LAS u32x4*)(lds + AT_V + buf * AT_VB + vw) = vr;
        if (kt + 1 < nkt) { kr = *(const u32x4*)(kg + (size_t)(kt + 1) * 32 * NU); vr = *(const u32x4*)(vg + (kt + 1) * 32); }
        __syncthreads();
        const int kc = (key_lo + kt * 32) >> 6;
        if (kc >= c - 8 && kc <= c) {
            bf16x8 kf[2][4], vf[8];
#pragma unroll
            for (int hh = 0; hh < 2; ++hh)
#pragma unroll
                for (int s = 0; s < 4; ++s) kf[hh][s] = *(const LAS bf16x8*)(lds + AT_K + buf * AT_KB + kroff + hh * (4 * 272) + s * 64);
#pragma unroll
            for (int dt = 0; dt < 8; ++dt) vf[dt] = *(const LAS bf16x8*)(lds + AT_V + buf * AT_VB + vroff + dt * (16 * 80));
            attn_tile<true>(kf, vf, qf, o, mrun, lrun, 2, tbl, dbase + fr - kt * 32 - fq * 8, false, 0, 0);
        }
    }
    attn_store_o(o, lrun, obase + qrow0 * ldo + ocol + h * 128, ldo, 2, fr, fq);
}

constexpr int LT_OFF = 98304, LT_WG = 64 * 144, LT_PAR = 2 * LT_WG;
DI void lru_tables_to_lds(const Params& p, LAS unsigned char* lt, int nblk, int tid) {
    const bf16_t* Wt = (const bf16_t*)(p.ws + W_LRU);
    for (int i = tid; i < 2 * 64 * 8; i += NWAVES * 64) { const int g = i >> 9, row = (i >> 3) & 63, seg = i & 7;
        *(LAS u32x4*)(lt + g * LT_WG + row * 144 + seg * 16) = *(const u32x4*)(Wt + (size_t)g * 65536 + (size_t)(nblk * 64 + row) * 64 + seg * 8); }
    for (int i = tid; i < 512; i += NWAVES * 64) { const int k = i >> 6, ch = nblk * 64 + (i & 63);
        const float v = k < 4 ? p.in[18][k * 1024 + ch] : (k == 4 ? p.in[19][ch] : (k == 5 ? p.in[21][ch] : (k == 6 ? p.in[23][ch] : ((const float*)(p.ws + W_C8))[ch])));
        ((LAS float*)(lt + LT_PAR))[i] = v; }
    __syncthreads();
}
template <int PASS>
DI void lru_unit(const Params& p, int seq, int chunk, int nblk, int lane, bf16_t* obase, unsigned opitch, unsigned ocol, const LAS unsigned char* lt) {
    unsigned char* ws = p.ws;
    const char* Ub = (const char*)(ws + W_U);
    const LAS float* par = (const LAS float*)(lt + LT_PAR);
    float* cA = (float*)(ws + W_CA); float* cB = (float*)(ws + W_CB);
    const bool is_s = seq >= NBATCH;
    const int sb = seq - NBATCH;
    const unsigned row0 = is_s ? (unsigned)MP + (unsigned)sb * STOK : (unsigned)seq * TSEQ;
    const int t0 = is_s ? 0 : chunk * 64, ntt = is_s ? 1 : 4;
    float hc[2][8], arun[2][8];
#pragma unroll
    for (int ks = 0; ks < 2; ++ks)
#pragma unroll
        for (int e = 0; e < 8; ++e) { hc[ks][e] = 0.f; arun[ks][e] = 1.f; }
    if (PASS == 1) {
        float H;
        if (is_s) H = p.in[5][(size_t)sb * 1024 + nblk * 64 + lane];
        else { H = 0.f;
            const float* pa = cA + (size_t)seq * 64 * 1024 + nblk * 64 + lane; const float* pb = cB + (size_t)seq * 64 * 1024 + nblk * 64 + lane;
            for (int c2 = 0; c2 < chunk; c2 += 8) {
                float ta[8], tb[8];
#pragma unroll
                for (int j = 0; j < 8; ++j) { const int cc = (c2 + j < chunk) ? c2 + j : chunk - 1; ta[j] = pa[(size_t)cc * 1024]; tb[j] = pb[(size_t)cc * 1024]; }
#pragma unroll
                for (int j = 0; j < 8; ++j) if (c2 + j < chunk) H = ta[j] * H + tb[j];
            } }
        const int fq0 = lane >> 4;
#pragma unroll
        for (int ks = 0; ks < 2; ++ks)
#pragma unroll
            for (int e = 0; e < 8; ++e) hc[ks][e] = __shfl(H, ks * 32 + fq0 * 8 + e);
    }
#pragma unroll 1
    for (int tt = 0; tt < ntt; ++tt) {
        int lo = lane; asm volatile("" : "+v"(lo) :: "memory");
        const int fr = lo & 15, fq = lo >> 4;
        const int t = t0 + tt * 16 + fr;
        const unsigned chb0 = (unsigned)(nblk * 64 + fq * 8);
        float xc[2][8]; bf16x8 xf[2];
#pragma unroll
        for (int ks = 0; ks < 2; ++ks) {
            const unsigned chb = chb0 + ks * 32;
            const int chl = ks * 32 + fq * 8;
            const f32x4 b0 = *(const LAS f32x4*)(par + 4 * 64 + chl), b1 = *(const LAS f32x4*)(par + 4 * 64 + chl + 4);
#pragma unroll
            for (int e = 0; e < 4; ++e) { xc[ks][e] = b0[e]; xc[ks][4 + e] = b1[e]; }
#pragma unroll
            for (int j = 0; j < 4; ++j) {
                const int tj = t - 3 + j;
                float xv[8];
                if (tj >= 0) unpack8(*(const u32x4*)(Ub + ((row0 + (unsigned)tj) * (unsigned)NU + OXR + chb) * 2u), xv);
                else if (is_s) { const char* sp = (const char*)p.in[4] + (((unsigned)sb * 3u + (unsigned)(3 + tj)) * 1024u + chb) * 4u; const f32x4 s0 = *(const f32x4*)sp, s1 = *(const f32x4*)(sp + 16);
#pragma unroll
                    for (int e = 0; e < 4; ++e) { xv[e] = s0[e]; xv[4 + e] = s1[e]; } }
                else {
#pragma unroll
                    for (int e = 0; e < 8; ++e) xv[e] = 0.f; }
                const f32x4 w0 = *(const LAS f32x4*)(par + j * 64 + chl), w1 = *(const LAS f32x4*)(par + j * 64 + chl + 4);
#pragma unroll
                for (int e = 0; e < 4; ++e) { xc[ks][e] += w0[e] * xv[e]; xc[ks][4 + e] += w1[e] * xv[4 + e]; }
            }
            xf[ks] = __builtin_bit_cast(bf16x8, pack8(xc[ks]));
        }
        float av[2][8], bv[2][8];
        const unsigned wbase = (unsigned)((fr >> 2) * 8 + (fr & 3)) * 144u + (unsigned)fq * 16u;
#pragma unroll
        for (int ct = 0; ct < 4; ++ct) {
            const int ks = ct >> 1, hq = ct & 1;
            const unsigned woff = wbase + (unsigned)((ks * 32 + hq * 4) * 144);
            f32x4 aa = (f32x4){0.f, 0.f, 0.f, 0.f}, ax = (f32x4){0.f, 0.f, 0.f, 0.f};
#pragma unroll
            for (int k2 = 0; k2 < 2; ++k2) {
                const bf16x8 wa = *(const LAS bf16x8*)(lt + woff + k2 * 64u), wx = *(const LAS bf16x8*)(lt + LT_WG + woff + k2 * 64u);
                aa = __builtin_amdgcn_mfma_f32_16x16x32_bf16(wa, xf[k2], aa, 0, 0, 0);
                ax = __builtin_amdgcn_mfma_f32_16x16x32_bf16(wx, xf[k2], ax, 0, 0, 0); }
            const int chq = ks * 32 + fq * 8 + hq * 4;
            const f32x4 ba4 = *(const LAS f32x4*)(par + 5 * 64 + chq), bx4 = *(const LAS f32x4*)(par + 6 * 64 + chq), c84 = *(const LAS f32x4*)(par + 7 * 64 + chq);
#pragma unroll
            for (int j = 0; j < 4; ++j) {
                const int e = hq * 4 + j;
                const float r = sigmoidf_(aa[j] + ba4[j]), ig = sigmoidf_(ax[j] + bx4[j]);
                const float a = fast_exp2(c84[j] * r);
                av[ks][e] = a; bv[ks][e] = sqrtf(fmaxf(1.0f - a * a, 0.f)) * ig * xc[ks][e];
            }
        }
#pragma unroll
        for (int ks = 0; ks < 2; ++ks)
#pragma unroll
            for (int e = 0; e < 8; ++e) {
                float a = av[ks][e], b = bv[ks][e], pa, pb;
                pa = dpp_shr<1>(1.f, a); pb = dpp_shr<1>(0.f, b); b = a * pb + b; a = a * pa;
                pa = dpp_shr<2>(1.f, a); pb = dpp_shr<2>(0.f, b); b = a * pb + b; a = a * pa;
                pa = dpp_shr<4>(1.f, a); pb = dpp_shr<4>(0.f, b); b = a * pb + b; a = a * pa;
                pa = dpp_shr<8>(1.f, a); pb = dpp_shr<8>(0.f, b); b = a * pb + b; a = a * pa;
                const float h = a * hc[ks][e] + b;
                bv[ks][e] = h; av[ks][e] = a;
            }
        const int l15 = (lo & 48) | 15;
        if (PASS == 1) {
#pragma unroll
            for (int ks = 0; ks < 2; ++ks) {
                const unsigned chb = chb0 + ks * 32;
                const char* gp = Ub + ((row0 + (unsigned)t) * (unsigned)NU + OGR + chb) * 2u;
                char* op = (char*)obase + ((row0 + (unsigned)t) * opitch + ocol + chb) * 2u;
                float gv[8], ov[8]; unpack8(*(const u32x4*)gp, gv);
#pragma unroll
                for (int e = 0; e < 8; ++e) { const float x = gv[e]; const float u2 = 1.5957691216057308f * (x + 0.044715f * x * x * x); ov[e] = x * fast_rcp(1.0f + fast_exp2(-u2 * LOG2E)) * bv[ks][e]; }
                *(u32x4*)op = pack8(ov);
                if (fr == 15 && tt == ntt - 1 && (is_s || chunk == 63)) {
                    float* lo2 = p.out + (is_s ? O_LS + (size_t)sb * 1024 : O_LP + (size_t)seq * 1024) + chb;
                    *(f32x4*)lo2 = (f32x4){bv[ks][0], bv[ks][1], bv[ks][2], bv[ks][3]}; *(f32x4*)(lo2 + 4) = (f32x4){bv[ks][4], bv[ks][5], bv[ks][6], bv[ks][7]};
                }
#pragma unroll
                for (int e = 0; e < 8; ++e) hc[ks][e] = __shfl(bv[ks][e], l15);
            }
        } else {
#pragma unroll
            for (int ks = 0; ks < 2; ++ks)
#pragma unroll
                for (int e = 0; e < 8; ++e) { hc[ks][e] = __shfl(bv[ks][e], l15); arun[ks][e] *= __shfl(av[ks][e], l15); }
        }
    }
    if (PASS == 0 && (lane & 15) == 0) {
        const int fq = lane >> 4;
#pragma unroll
        for (int ks = 0; ks < 2; ++ks) { const size_t o = ((size_t)seq * 64 + chunk) * 1024 + nblk * 64 + ks * 32 + fq * 8;
            *(f32x4*)(cA + o) = (f32x4){arun[ks][0], arun[ks][1], arun[ks][2], arun[ks][3]}; *(f32x4*)(cA + o + 4) = (f32x4){arun[ks][4], arun[ks][5], arun[ks][6], arun[ks][7]};
            *(f32x4*)(cB + o) = (f32x4){hc[ks][0], hc[ks][1], hc[ks][2], hc[ks][3]}; *(f32x4*)(cB + o + 4) = (f32x4){hc[ks][4], hc[ks][5], hc[ks][6], hc[ks][7]}; }
    }
}


DI void sample_cache_tasks(const Params& p, int first, int stride, int lane) {
    constexpr int T_KS = SBATCH * 512, T_VTS = SBATCH * 8 * 8;
    bf16_t* Ks = (bf16_t*)(p.ws + W_KS); bf16_t* Vts = (bf16_t*)(p.ws + W_VTS);
        for (int r = first; r < T_KS; r += stride) {
                const int b = r >> 9, j = r & 511;
                const float* src = p.in[2] + (size_t)r * 1024 + lane * 16;
                float t0[8], t1[8];
                { const f32x4 a = *(const f32x4*)src, c = *(const f32x4*)(src + 4), d = *(const f32x4*)(src + 8), e = *(const f32x4*)(src + 12);
                  t0[0] = a.x; t0[1] = a.y; t0[2] = a.z; t0[3] = a.w; t0[4] = c.x; t0[5] = c.y; t0[6] = c.z; t0[7] = c.w;
                  t1[0] = d.x; t1[1] = d.y; t1[2] = d.z; t1[3] = d.w; t1[4] = e.x; t1[5] = e.y; t1[6] = e.z; t1[7] = e.w; }
                bf16_t* kd = Ks + ((size_t)b * SKEYS + j) * 1024 + lane * 16;
                *(u32x4*)kd = pack8(t0); *(u32x4*)(kd + 8) = pack8(t1);


        }
        for (int r = first; r < T_VTS; r += stride) {
                const int b = r >> 6, h = (r >> 3) & 7, jg = r & 7, j = jg * 64 + lane;
                const float* src = p.in[3] + (((size_t)b * 512 + j) * 8 + h) * 128;
                bf16_t* dst = Vts + ((size_t)(b * 8 + h) * 128) * SKEYS + j;
#pragma unroll 4
                for (int dc = 0; dc < 32; ++dc) { const f32x4 v = *(const f32x4*)(src + dc * 4);
                    dst[(size_t)(dc * 4 + 0) * SKEYS] = (bf16_t)pk2(v.x, 0.f); dst[(size_t)(dc * 4 + 1) * SKEYS] = (bf16_t)pk2(v.y, 0.f);
                    dst[(size_t)(dc * 4 + 2) * SKEYS] = (bf16_t)pk2(v.z, 0.f); dst[(size_t)(dc * 4 + 3) * SKEYS] = (bf16_t)pk2(v.w, 0.f); }
                if (jg == 7 && lane < 16) { bf16_t* pz = Vts + ((size_t)(b * 8 + h) * 128) * SKEYS + 528 + lane;
                    for (int d = 0; d < 128; ++d) pz[(size_t)d * SKEYS] = 0; }


        }
}

DI void mem_tasks(const Params& p, int first, int stride, int lane) {
    const float* MKVF = (const float*)(p.ws + W_MKVF); bf16_t* Km = (bf16_t*)(p.ws + W_KM); bf16_t* Vtm = (bf16_t*)(p.ws + W_VTM);
        for (int r = first; r < 2048; r += stride) {
            const float* src = MKVF + (size_t)r * 1024 + lane * 8;
            const f32x4 k0 = *(const f32x4*)src, k1 = *(const f32x4*)(src + 4), v0 = *(const f32x4*)(src + 512), v1 = *(const f32x4*)(src + 516);
            float ss = (k0.x * k0.x + k0.y * k0.y + k0.z * k0.z + k0.w * k0.w) + (k1.x * k1.x + k1.y * k1.y + k1.z * k1.z + k1.w * k1.w);
            ss += __shfl_xor(ss, 1); ss += __shfl_xor(ss, 2); ss += __shfl_xor(ss, 4); ss += __shfl_xor(ss, 8);
            const float rs = rsqrtf(ss * (1.f / 128.f) + EPS);
            const f32x4 g0 = *(const f32x4*)(p.in[34] + (lane * 8) % 128), g1 = *(const f32x4*)(p.in[34] + (lane * 8) % 128 + 4);
            const f32x4 n0 = k0 * rs * g0, n1 = k1 * rs * g1;
            float* ko = p.out + O_MK + (size_t)r * 512 + lane * 8; *(f32x4*)ko = n0; *(f32x4*)(ko + 4) = n1;
            float* vo = p.out + O_MV + (size_t)r * 512 + lane * 8; *(f32x4*)vo = v0; *(f32x4*)(vo + 4) = v1;
            u32x4 w; w.x = pk2(n0.x, n0.y); w.y = pk2(n0.z, n0.w); w.z = pk2(n1.x, n1.y); w.w = pk2(n1.z, n1.w);
            *(u32x4*)(Km + (size_t)r * 512 + lane * 8) = w;
        }
        for (int r = first; r < SBATCH * 256; r += stride) {
            const float* src = p.in[6] + (size_t)r * 512 + lane * 8; const f32x4 k0 = *(const f32x4*)src, k1 = *(const f32x4*)(src + 4);
            u32x4 w; w.x = pk2(k0.x, k0.y); w.y = pk2(k0.z, k0.w); w.z = pk2(k1.x, k1.y); w.w = pk2(k1.z, k1.w);
            *(u32x4*)(Km + ((size_t)NBATCH * 256 + r) * 512 + lane * 8) = w;
        }
        for (int it = first; it < NSEQ * 4 * 4; it += stride) {
            const int seq = it >> 4, h = (it >> 2) & 3, j = (it & 3) * 64 + lane;
            const float* src = seq < NBATCH ? MKVF + ((size_t)seq * 256 + j) * 1024 + 512 + h * 128 : p.in[7] + (((size_t)(seq - NBATCH) * 256 + j) * 4 + h) * 128;
            bf16_t* dst = Vtm + ((size_t)(seq * 4 + h) * 128) * 256 + j;
#pragma unroll 4
            for (int dc = 0; dc < 32; ++dc) { const f32x4 v = *(const f32x4*)(src + dc * 4);
                dst[(size_t)(dc * 4 + 0) * 256] = (bf16_t)(pk2(v.x, 0.f)); dst[(size_t)(dc * 4 + 1) * 256] = (bf16_t)(pk2(v.y, 0.f));
                dst[(size_t)(dc * 4 + 2) * 256] = (bf16_t)(pk2(v.z, 0.f)); dst[(size_t)(dc * 4 + 3) * 256] = (bf16_t)(pk2(v.w, 0.f)); }
        }
}

#define XB_TMO      128
#define XB_XCNT(j)  (256  + 64 * (j))
#define XB_XSUB(j)  (1280 + 64 * (j))
#define XB_XGEN(j)  (2304 + 64 * (j))
#define XB_TOP      3328
#define XB_TOPGEN   3392
#define XCD_BAR_WORDS 3456
#define XB_SPIN_CAP (1u << 18)
DI unsigned xb_ld(unsigned* p)              { return __hip_atomic_load(p, __ATOMIC_RELAXED, __HIP_MEMORY_SCOPE_AGENT); }
DI unsigned xb_add(unsigned* p, unsigned v) { return __hip_atomic_fetch_add(p, v, __ATOMIC_RELAXED, __HIP_MEMORY_SCOPE_AGENT); }
DI unsigned xb_xcc_id() { return (unsigned)__builtin_amdgcn_s_getreg((3 << 11) | 20) & 0xFu; }
#define XB_SPIN(cond, bar) do { unsigned _sp = 0; while (cond) { __builtin_amdgcn_s_sleep(1); \
    if ((++_sp & 255u) == 0u) { if (xb_ld(&(bar)[XB_TMO])) break; if (_sp > XB_SPIN_CAP) { atomicAdd(&(bar)[XB_TMO], 1u); break; } } } } while (0)
struct XcdBarrier { unsigned* bar; unsigned x; volatile LAS unsigned* st; };
DI XcdBarrier xcd_barrier_post(unsigned* bar, volatile LAS unsigned* st) {
    XcdBarrier b; b.bar = bar; b.x = xb_xcc_id(); b.st = st;
    if (threadIdx.x == 0) (void)xb_add(&bar[XB_XCNT(b.x)], 1u);
    return b;
}
DI void xcd_barrier_complete(unsigned* bar, unsigned x, unsigned& nloc, unsigned& nx) {
    const unsigned G = gridDim.x * gridDim.y * gridDim.z;
    unsigned sum, cnt, mine, sp = 0u;
    for (;;) {
        sum = 0u; cnt = 0u; mine = 0u;
#pragma unroll
        for (unsigned j = 0; j < 16; ++j) { const unsigned c = xb_ld(&bar[XB_XCNT(j)]); sum += c; cnt += (c > 0u) ? 1u : 0u; mine = (j == x) ? c : mine; }
        if (sum == G) break;
        __builtin_amdgcn_s_sleep(1);
        if ((++sp & 255u) == 0u) { if (xb_ld(&bar[XB_TMO])) break; if (sp > XB_SPIN_CAP) { atomicAdd(&bar[XB_TMO], 1u); break; } }
    }
    nloc = mine > 0u ? mine : 1u; nx = cnt > 0u ? cnt : 1u;
}
DI void xcd_barrier(const XcdBarrier& b) {
    asm volatile("s_waitcnt vmcnt(0)" ::: "memory");
    __syncthreads();
    if (threadIdx.x == 0) {
        unsigned* bar = b.bar;
        __builtin_amdgcn_s_waitcnt(0);
        unsigned nloc = b.st[0], nx = b.st[1];
        if (nloc == 0u) { xcd_barrier_complete(bar, b.x, nloc, nx); b.st[0] = nloc; b.st[1] = nx; }
        const unsigned old = xb_add(&bar[XB_XSUB(b.x)], 1u);
        const unsigned gen = old / nloc;
        if (old + 1u == (gen + 1u) * nloc) {
            __builtin_amdgcn_fence(__ATOMIC_RELEASE, "agent");
            asm volatile("s_waitcnt vmcnt(0)" ::: "memory");
            const unsigned og = xb_add(&bar[XB_TOP], 1u);
            const unsigned tg = og / nx;
            if (og + 1u == (tg + 1u) * nx) xb_add(&bar[XB_TOPGEN], 1u);
            else XB_SPIN(xb_ld(&bar[XB_TOPGEN]) == tg, bar);
            __builtin_amdgcn_fence(__ATOMIC_ACQUIRE, "agent");
            xb_add(&bar[XB_XGEN(b.x)], 1u);
            asm volatile("s_waitcnt vmcnt(0)" ::: "memory");
        } else {
            XB_SPIN(xb_ld(&bar[XB_XGEN(b.x)]) == gen, bar);
            __builtin_amdgcn_fence(__ATOMIC_ACQUIRE, "agent");
            asm volatile("s_waitcnt vmcnt(0)" ::: "memory");
        }
    }
    __syncthreads();
}

__global__ void __launch_bounds__(NWAVES * 64, 2) fwd_megakernel(Params p) {
    extern __shared__ __attribute__((aligned(16))) unsigned char lds_raw[];
    cg::grid_group grid = cg::this_grid();
    LAS unsigned char* lds = (LAS unsigned char*)lds_raw;
#define PH_IDS int tid = threadIdx.x; asm volatile("" : "+v"(tid)); const int lane = tid & 63, wave = __builtin_amdgcn_readfirstlane(tid >> 6); \
    const int G = gridDim.x, gw = blockIdx.x * NWAVES + wave, NGW = G * NWAVES; (void)lane; (void)gw; (void)NGW; (void)G
    unsigned char* ws = p.ws;
    float* R = p.out;
    bf16_t* XN = (bf16_t*)(ws + W_XN); bf16_t* U = (bf16_t*)(ws + W_U); bf16_t* H = (bf16_t*)(ws + W_H);
    bf16_t* Vt = (bf16_t*)(ws + W_VT); bf16_t* Ks = (bf16_t*)(ws + W_KS); bf16_t* Vts = (bf16_t*)(ws + W_VTS);
    bf16_t* Km = (bf16_t*)(ws + W_KM); bf16_t* Vtm = (bf16_t*)(ws + W_VTM);
    bf16_t* MN = (bf16_t*)(ws + W_MN); float* MKVF = (float*)(ws + W_MKVF); bf16_t* MQ = (bf16_t*)(ws + W_MQB);

    for (int rep_ = 0; rep_ < 1 + ((REPM >> 0) & 1); ++rep_) { if (rep_) grid.sync(); PH_IDS;
        if (blockIdx.x == 0) for (int i = tid; i < 4096; i += NWAVES * 64) ((unsigned*)(ws + W_BAR))[i] = 0u;
        if (tid < 2) ((volatile LAS unsigned*)(lds + 131072 + 64))[tid] = 0u;
        LAS float* scr = (LAS float*)(lds + wave * 16384);
        constexpr int I_FU = (D / 64) * (FF / 32), I_FD = (FF / 64) * (D / 32), I_IN = (D / 64) * (NU / 32), I_P = (1024 / 64) * (D / 32), I_O = (D / 64) * (D / 32),
                      I_M = (D / 64) * (512 / 32), I_MO = (512 / 64) * (D / 32);
        constexpr int NITEMS = 4 * I_FU + 2 * I_FD + I_IN + 2 * I_P + I_O + 3 * I_M + I_MO;
        for (int it = gw; it < NITEMS; it += NGW) {
            int r = it;
#define TJ(IDX, KK, NN, OFF, SH, ADD, NI, GN) if (r < (NI)) { transpose_item(p.in[IDX], KK, NN, (bf16_t*)(ws + (OFF)), SH, ADD, scr, r, lane, GN); continue; } r -= (NI);
            TJ(10, D, FF, W_GU1, 8, 0, I_FU, nullptr) TJ(11, D, FF, W_GU1, 8, 128, I_FU, nullptr) TJ(12, FF, D, W_D1, 7, 0, I_FD, nullptr)
            TJ(37, D, FF, W_GU2, 8, 0, I_FU, p.in[36]) TJ(38, D, FF, W_GU2, 8, 128, I_FU, p.in[36]) TJ(39, FF, D, W_D2, 7, 0, I_FD, nullptr)
            TJ(14, D, NU, W_IN, 7, 0, I_IN, p.in[13]) TJ(25, 1024, D, W_PA, 7, 0, I_P, nullptr) TJ(26, 1024, D, W_PB, 7, 0, I_P, nullptr) TJ(27, D, D, W_OUT, 7, 0, I_O, nullptr)
            TJ(30, D, 512, W_MQ, 7, 0, I_M, p.in[28]) TJ(31, D, 512, W_MKV, 7, 0, I_M, nullptr) TJ(32, D, 512, W_MKV, 7, 512, I_M, nullptr)
            transpose_item(p.in[35], 512, D, (bf16_t*)(ws + W_MO), 7, 0, scr, r, lane, nullptr);
#undef TJ
        }
        for (int m = gw; m < MT; m += NGW) norm_row_bf16(m < MP ? p.in[0] + (size_t)m * D : p.in[1] + (size_t)(m - MP) * D, p.in[9], XN + (size_t)m * D, lane);
        for (int m = gw; m < 2048; m += NGW) norm_row_bf16(p.in[8] + (size_t)m * D, p.in[29], MN + (size_t)m * D, lane);
        {
            bf16_t* Wt = (bf16_t*)(ws + W_LRU); float* c8 = (float*)(ws + W_C8);
            for (int i = blockIdx.x * 512 + tid; i < 2 * 65536; i += G * 512) { const int gsel = i >> 16, n = (i >> 12) & 15, c = (i >> 6) & 63, k = i & 63;
                const float v = p.in[gsel ? 22 : 20][n * 4096 + k * 64 + c]; Wt[i] = (bf16_t)(pk2(v, 0.f) & 0xffffu); }
            for (int i = blockIdx.x * 512 + tid; i < 1024; i += G * 512) c8[i] = -8.0f * log1pf(expf(-p.in[24][i])) * LOG2E;
            float* ssz = (float*)(ws + W_SS);
            for (int i = blockIdx.x * 512 + tid; i < 3 * MT; i += G * 512) ssz[i] = 0.f;
            for (int i = blockIdx.x * 512 + tid; i < MS * D / 4; i += G * 512) ((f32x4*)(R + (size_t)MP * D))[i] = ((const f32x4*)p.in[1])[i];
        }
    }
    grid.sync();
    XcdBarrier xbar = xcd_barrier_post((unsigned*)(p.ws + W_BAR), (volatile LAS unsigned*)(lds + 131072 + 64));

    for (int rr = 0; rr < ((REPM >> 18) & 1) * 20; ++rr) grid.sync();
    for (int rep_ = 0; rep_ < 1 + ((REPM >> 1) & 1); ++rep_) { if (rep_) grid.sync(); PH_IDS;
        pg8::Gemm g{XN, (const bf16_t*)(ws + W_GU1), MT, 2 * FF, D, D, D}; pg8::StaticOrder S; S.init(MT, 2 * FF, G, (int)blockIdx.x);
        pg8::EpiSwiglu E{H, FF, nullptr};
        pg8::gemm_phase<pg8::EpiSwiglu, true>(lds, g, S, E, STAG);
        pg8::Gemm g2{MN, (const bf16_t*)(ws + W_MKV), 2048, 1024, D, D, D}; pg8::StaticOrder S2; S2.init(2048, 1024, G, (int)((blockIdx.x + 128) % G));
        pg8::EpiF32 E2{MKVF, 1024};
        pg8::gemm_phase<pg8::EpiF32, true>(lds, g2, S2, E2);
        if (G > 160 && (int)blockIdx.x >= 160) sample_cache_tasks(p, ((int)blockIdx.x - 160) * NWAVES + wave, (G - 160) * NWAVES, lane);
    }
    xcd_barrier(xbar);

    for (int rep_ = 0; rep_ < 1 + ((REPM >> 2) & 1); ++rep_) { if (rep_) grid.sync(); PH_IDS;
        pg8::Gemm g{H, (const bf16_t*)(ws + W_D1), MP, D, FF, FF, FF}; pg8::StaticOrder S; S.init(MP, D, G, (int)blockIdx.x);
        pg8::EpiResid E{R, p.in[0], XN, (float*)(ws + W_SS), 0.5f};
        pg8::gemm_phase<pg8::EpiResid, true>(lds, g, S, E, STAG);
        pg8::Gemm gs{H + (size_t)MP * FF, (const bf16_t*)(ws + W_D1), MS, D, FF, FF, FF / 4}; pg8::SplitOrder Ss; Ss.init(MS, D, 4, G, (int)blockIdx.x);
        pg8::EpiResidAtomic Es{R + (size_t)MP * D, 0.5f};
        pg8::gemm_phase<pg8::EpiResidAtomic, true>(lds, gs, Ss, Es);
        if (G > 64 && (int)blockIdx.x >= 64) mem_tasks(p, ((int)blockIdx.x - 64) * NWAVES + wave, (G - 64) * NWAVES, lane);
    }
    xcd_barrier(xbar);

    for (int rep_ = 0; rep_ < 1 + ((REPM >> 3) & 1); ++rep_) { if (rep_) grid.sync(); PH_IDS;
        for (int m = MP + gw; m < MT; m += NGW) feed_row(R + (size_t)m * D, XN + (size_t)m * D, (float*)(ws + W_SS) + m, lane);
        if (G <= 64) mem_tasks(p, gw, NGW, lane);
    }
    xcd_barrier(xbar);

    for (int rep_ = 0; rep_ < 1 + ((REPM >> 4) & 1); ++rep_) { if (rep_) grid.sync(); PH_IDS;
        pg8::Gemm g{XN, (const bf16_t*)(ws + W_IN), MT, NU, D, D, D}; pg8::StaticOrder S; S.init(MT, NU, G, (int)blockIdx.x);
        pg8::EpiBf16 E{U, NU, (const float*)(ws + W_SS)};
        pg8::gemm_phase<pg8::EpiBf16, true>(lds, g, S, E, STAG);
    }
    xcd_barrier(xbar);

    for (int rep_ = 0; rep_ < 1 + ((REPM >> 5) & 1); ++rep_) { if (rep_) grid.sync(); PH_IDS;
        const bool dummy5 = ((REPM >> 5) & 1) && rep_ == 0;
        constexpr int T_ROWS = MT, T_VT = NBATCH * 64 * 8, T_KS = SBATCH * 512, T_VTS = SBATCH * 8 * 8, T_LRU = NBATCH * 64 * 16;
        for (int r = gw; r < T_ROWS; r += NGW) {
                const bool is_s = r >= MP; const int rs_ = r - MP;
                const int b = is_s ? (rs_ >> 4) : (r >> 12), t = is_s ? (rs_ & 15) : (r & 4095);
                bf16_t* urow = U + (size_t)r * NU;
                float kv[16], vv[16];
                { const u32x4 a = *(const u32x4*)(urow + OKK + lane * 16), c = *(const u32x4*)(urow + OKK + lane * 16 + 8);
                  float t0[8], t1[8]; unpack8(a, t0); unpack8(c, t1);
#pragma unroll
                  for (int i = 0; i < 8; ++i) { kv[i] = t0[i]; kv[8 + i] = t1[i]; } }
                { const u32x4 a = *(const u32x4*)(urow + OV + lane * 16), c = *(const u32x4*)(urow + OV + lane * 16 + 8);
                  float t0[8], t1[8]; unpack8(a, t0); unpack8(c, t1);
#pragma unroll
                  for (int i = 0; i < 8; ++i) { vv[i] = t0[i]; vv[8 + i] = t1[i]; } }
                float ss = 0.f;
#pragma unroll
                for (int i = 0; i < 16; ++i) ss += kv[i] * kv[i];
                ss += __shfl_xor(ss, 1); ss += __shfl_xor(ss, 2); ss += __shfl_xor(ss, 4);
                const float rstd = rsqrtf(ss * (1.f / 128.f) + EPS);
                const float* gp = p.in[16] + (lane * 16) % 128;
#pragma unroll
                for (int i = 0; i < 4; ++i) { const f32x4 gg = *(const f32x4*)(gp + 4 * i);
#pragma unroll
                    for (int j = 0; j < 4; ++j) kv[4 * i + j] *= rstd * gg[j]; }
                bf16_t* kd = is_s ? Ks + ((size_t)b * SKEYS + 512 + t) * 1024 + lane * 16 : (dummy5 ? XN + (size_t)r * 1024 + lane * 16 : urow + OKK + lane * 16);
                { float t0[8], t1[8];
#pragma unroll
                  for (int i = 0; i < 8; ++i) { t0[i] = kv[i]; t1[i] = kv[8 + i]; }
                  *(u32x4*)kd = pack8(t0); *(u32x4*)(kd + 8) = pack8(t1); }
                const bool wr_kv = is_s || t >= TSEQ - 512;
                if (wr_kv) {
                    const size_t ro = is_s ? (size_t)rs_ * 1024 : ((size_t)b * 512 + (t - (TSEQ - 512))) * 1024;
                    float* ko = p.out + (is_s ? O_KS : O_KP) + ro + lane * 16; float* vo = p.out + (is_s ? O_VS : O_VP) + ro + lane * 16;
#pragma unroll
                    for (int i = 0; i < 4; ++i) { *(f32x4*)(ko + 4 * i) = (f32x4){kv[4 * i], kv[4 * i + 1], kv[4 * i + 2], kv[4 * i + 3]}; *(f32x4*)(vo + 4 * i) = (f32x4){vv[4 * i], vv[4 * i + 1], vv[4 * i + 2], vv[4 * i + 3]}; }
                }
                const int tl = is_s ? STOK : TSEQ;
                if (t >= tl - 3) {
                    float xv[16];
                    { const u32x4 a = *(const u32x4*)(urow + OXR + lane * 16), c = *(const u32x4*)(urow + OXR + lane * 16 + 8);
                      float t0[8], t1[8]; unpack8(a, t0); unpack8(c, t1);
#pragma unroll
                      for (int i = 0; i < 8; ++i) { xv[i] = t0[i]; xv[8 + i] = t1[i]; } }
                    float* co = p.out + (is_s ? O_CS : O_CP) + ((size_t)b * 3 + (t - (tl - 3))) * 1024 + lane * 16;
#pragma unroll
                    for (int i = 0; i < 4; ++i) *(f32x4*)(co + 4 * i) = (f32x4){xv[4 * i], xv[4 * i + 1], xv[4 * i + 2], xv[4 * i + 3]};
                }
                if (is_s) {
                    const int h = lane >> 3, d0 = (lane & 7) * 16;
                    bf16_t* dst = Vts + ((size_t)(b * 8 + h) * 128 + d0) * SKEYS + 512 + t;
#pragma unroll
                    for (int i = 0; i < 16; ++i) dst[(size_t)i * SKEYS] = (bf16_t)pk2(vv[i], 0.f);
                }


        }
        for (int r = gw; r < T_VT; r += NGW) {
                const int b = r >> 9, c = (r >> 3) & 63, h = r & 7, t = c * 64 + lane;
                const bf16_t* src = U + ((size_t)b * TSEQ + t) * NU + OV + h * 128;
                bf16_t* dst = Vt + ((size_t)(b * 8 + h) * 128) * TSEQ + t;
#pragma unroll 4
                for (int dc = 0; dc < 16; ++dc) { const u32x4 w = *(const u32x4*)(src + dc * 8);
                    dst[(size_t)(dc * 8 + 0) * TSEQ] = (bf16_t)(w.x & 0xffffu); dst[(size_t)(dc * 8 + 1) * TSEQ] = (bf16_t)(w.x >> 16);
                    dst[(size_t)(dc * 8 + 2) * TSEQ] = (bf16_t)(w.y & 0xffffu); dst[(size_t)(dc * 8 + 3) * TSEQ] = (bf16_t)(w.y >> 16);
                    dst[(size_t)(dc * 8 + 4) * TSEQ] = (bf16_t)(w.z & 0xffffu); dst[(size_t)(dc * 8 + 5) * TSEQ] = (bf16_t)(w.z >> 16);
                    dst[(size_t)(dc * 8 + 6) * TSEQ] = (bf16_t)(w.w & 0xffffu); dst[(size_t)(dc * 8 + 7) * TSEQ] = (bf16_t)(w.w >> 16); }


        }
        if (G <= 160) sample_cache_tasks(p, gw, NGW, lane);
        {
            const int nblk = blockIdx.x & 15, slot = (blockIdx.x >> 4) * NWAVES + wave, nslot = (G >> 4) * NWAVES;
            __syncthreads();
            lru_tables_to_lds(p, lds + LT_OFF, nblk, tid);
            for (int rr = 0; rr < 1 + ((REPM >> 17) & 1) * 3; ++rr)
            for (int u = slot; u < NBATCH * 64; u += nslot) lru_unit<0>(p, u >> 6, u & 63, nblk, lane, nullptr, 0u, 0u, lds + LT_OFF);
            (void)T_LRU;
        }
    }
    xcd_barrier(xbar);

    for (int rep_ = 0; rep_ < 1 + ((REPM >> 6) & 1); ++rep_) { if (rep_) grid.sync(); PH_IDS;
        const bool dummy = ((REPM >> 6) & 1) && rep_ == 0;
        LAS float* tbl = (LAS float*)(lds + 65536);
        constexpr int T_AP = NBATCH * 64 * 8 * 2, T_AS = SBATCH * 8, T_LP = NBATCH * 64 * 16, T_LS = SBATCH * 16;
        for (int wt = blockIdx.x; wt < NBATCH * 8 * 16; wt += G) {
            int pair, cg4;
            if (G == 256) { const int itp = wt >> 8, x = blockIdx.x & 7, j = blockIdx.x >> 3; pair = x * 8 + itp * 2 + (j >> 4); cg4 = (j + itp * 4) & 15; }
            else { pair = wt >> 4; cg4 = wt & 15; }
            attn_wg_prompt(p, lds, pair >> 3, pair & 7, cg4, dummy ? XN : U, dummy ? 1024 : NU, dummy ? 0 : OQ, tid);
        }
        __syncthreads();
        for (int q = blockIdx.x; q < T_AS; q += G) if (wave == 0) {
            const int b = q >> 3, h = q & 7;
            for (int i = lane; i < 640; i += 64) { int d = i - 63; d = d < -256 ? -256 : (d > 256 ? 256 : d); tbl[i] = p.in[17][h * 513 + d + 256] * LOG2E; }
            asm volatile("s_waitcnt lgkmcnt(0)" ::: "memory");
            __builtin_amdgcn_wave_barrier();
            bf16_t* qp = U + ((size_t)MP + (size_t)b * STOK) * NU + OQ + h * 128;
            attn_task<true>(qp, NU, dummy ? XN + ((size_t)MP + (size_t)b * STOK) * 1024 + h * 128 : qp, dummy ? 1024 : NU, Ks + (size_t)b * SKEYS * 1024 + h * 128, 1024, Vts + ((size_t)(b * 8 + h) * 128) * SKEYS, SKEYS,
                            17, 528, 1, p.in[15], tbl, 1024 - 512 + 63, lane);
            asm volatile("s_waitcnt lgkmcnt(0)" ::: "memory");
            __builtin_amdgcn_wave_barrier();
        }
        {
            const int nblk = blockIdx.x & 15, slot = (blockIdx.x >> 4) * NWAVES + wave, nslot = (G >> 4) * NWAVES;
            __syncthreads();
            lru_tables_to_lds(p, lds + LT_OFF, nblk, tid);
            for (int u = slot; u < NBATCH * 64 + SBATCH; u += nslot) { const bool pr = u < NBATCH * 64;
                lru_unit<1>(p, pr ? (u >> 6) : NBATCH + (u - NBATCH * 64), pr ? (u & 63) : 0, nblk, lane, dummy ? XN + (size_t)MT * 1024 : U, dummy ? 1024u : (unsigned)NU, dummy ? 0u : (unsigned)OGR, lds + LT_OFF); }
            (void)T_LP; (void)T_LS;
        }
    }
    xcd_barrier(xbar);

    for (int rep_ = 0; rep_ < 1 + ((REPM >> 7) & 1); ++rep_) { if (rep_) grid.sync(); PH_IDS;
        pg8::PairOrder S; S.init(MT, D, G, (int)blockIdx.x);
        pg8::Gemm g1{U + OQ, (const bf16_t*)(ws + W_PA), MT, D, 1024, NU, 1024, U + OGR, (const bf16_t*)(ws + W_PB)};
        pg8::EpiGate E1{U + OGA, U + OGA, U + OGB, NU};
        pg8::gemm_phase<pg8::EpiGate, true>(lds, g1, S, E1, STAG);
    }
    xcd_barrier(xbar);

    for (int rep_ = 0; rep_ < 1 + ((REPM >> 8) & 1); ++rep_) { if (rep_) grid.sync(); PH_IDS;
        pg8::Gemm g{U + OGA, (const bf16_t*)(ws + W_OUT), MP, D, D, NU, D}; pg8::StaticOrder S; S.init(MP, D, G, (int)blockIdx.x);
        pg8::EpiResid E{R, nullptr, XN, (float*)(ws + W_SS) + MT, 1.0f};
        pg8::gemm_phase<pg8::EpiResid, true>(lds, g, S, E, STAG);
        pg8::Gemm gs{U + (size_t)MP * NU + OGA, (const bf16_t*)(ws + W_OUT), MS, D, D, NU, D / 4}; pg8::SplitOrder Ss; Ss.init(MS, D, 4, G, (int)blockIdx.x);
        pg8::EpiResidAtomic Es{R + (size_t)MP * D, 1.0f};
        pg8::gemm_phase<pg8::EpiResidAtomic, true>(lds, gs, Ss, Es);
    }
    xcd_barrier(xbar);

    for (int rep_ = 0; rep_ < 1 + ((REPM >> 9) & 1); ++rep_) { PH_IDS;
    for (int m = MP + gw; m < MT; m += NGW) feed_row(R + (size_t)m * D, XN + (size_t)m * D, (float*)(ws + W_SS) + MT + m, lane);
    for (int i = blockIdx.x * 512 + tid; i < MP; i += G * 512) ((float*)(ws + W_SS))[i] = 0.f; }
    xcd_barrier(xbar);

    for (int rep_ = 0; rep_ < 1 + ((REPM >> 10) & 1); ++rep_) { if (rep_) grid.sync(); PH_IDS;
        pg8::Gemm g{XN, (const bf16_t*)(ws + W_MQ), MT, 512, D, D, D}; pg8::StaticOrder S; S.init(MT, 512, G, (int)blockIdx.x);
        pg8::EpiBf16 E{MQ, 512, (const float*)(ws + W_SS) + MT};
        pg8::gemm_phase<pg8::EpiBf16, true>(lds, g, S, E, 0);
    }
    xcd_barrier(xbar);

    for (int rep_ = 0; rep_ < 1 + ((REPM >> 11) & 1); ++rep_) { if (rep_) grid.sync(); PH_IDS;
        constexpr int T_P = (MP / 32) * 4, T_S = SBATCH * 4;
        for (int it = gw; it < T_P + T_S; it += NGW) {
            if (it < T_P) { const int rt = it >> 2, h = it & 3, seq = rt >> 7;
                bf16_t* qp = MQ + (size_t)rt * 32 * 512 + h * 128;
                attn_task<false>(qp, 512, qp, 512, Km + (size_t)seq * 256 * 512 + h * 128, 512, Vtm + ((size_t)(seq * 4 + h) * 128) * 256, 256, 8, 256, 2, p.in[33], nullptr, 0, lane);
            } else { const int q = it - T_P, b = q >> 2, h = q & 3, seq = NBATCH + b;
                bf16_t* qp = MQ + ((size_t)MP + (size_t)b * STOK) * 512 + h * 128;
                attn_task<false>(qp, 512, qp, 512, Km + (size_t)seq * 256 * 512 + h * 128, 512, Vtm + ((size_t)(seq * 4 + h) * 128) * 256, 256, 8, 256, 1, p.in[33], nullptr, 0, lane);
            }
        }
    }
    xcd_barrier(xbar);

    for (int rep_ = 0; rep_ < 1 + ((REPM >> 12) & 1); ++rep_) { if (rep_) grid.sync(); PH_IDS;
        pg8::Gemm g{MQ, (const bf16_t*)(ws + W_MO), MT, D, 512, 512, 512}; pg8::StaticOrder S; S.init(MT, D, G, (int)blockIdx.x);
        pg8::EpiResid E{R, nullptr, XN, (float*)(ws + W_SS) + 2 * MT, 1.0f};
        pg8::gemm_phase<pg8::EpiResid, true>(lds, g, S, E, 0);
    }
    xcd_barrier(xbar);

    for (int rep_ = 0; rep_ < 1 + ((REPM >> 14) & 1); ++rep_) { if (rep_) grid.sync(); PH_IDS;
        pg8::Gemm g{XN, (const bf16_t*)(ws + W_GU2), MT, 2 * FF, D, D, D}; pg8::StaticOrder S; S.init(MT, 2 * FF, G, (int)blockIdx.x);
        pg8::EpiSwiglu E{H, FF, (const float*)(ws + W_SS) + 2 * MT};
        pg8::gemm_phase<pg8::EpiSwiglu, true>(lds, g, S, E, STAG);
    }
    xcd_barrier(xbar);

    for (int rep_ = 0; rep_ < 1 + ((REPM >> 15) & 1); ++rep_) { if (rep_) grid.sync(); PH_IDS;
        pg8::Gemm g{H, (const bf16_t*)(ws + W_D2), MP, D, FF, FF, FF}; pg8::StaticOrder S; S.init(MP, D, G, (int)blockIdx.x);
        pg8::EpiResid E{R, nullptr, XN, (float*)(ws + W_SS), 0.5f};
        pg8::gemm_phase<pg8::EpiResid, true>(lds, g, S, E, STAG);
        pg8::Gemm gs{H + (size_t)MP * FF, (const bf16_t*)(ws + W_D2), MS, D, FF, FF, FF / 4}; pg8::SplitOrder Ss; Ss.init(MS, D, 4, G, (int)blockIdx.x);
        pg8::EpiResidAtomic Es{R + (size_t)MP * D, 0.5f};
        pg8::gemm_phase<pg8::EpiResidAtomic, true>(lds, gs, Ss, Es);
    }
    xcd_barrier(xbar);

    for (int rep_ = 0; rep_ < 1 + ((REPM >> 16) & 1); ++rep_) { PH_IDS;
    for (int m = gw; m < MT; m += NGW) {
        if (m >= MP) { norm_row_f32(R + (size_t)m * D, p.in[40], lane); continue; }
        const float rs = rsqrtf(((const float*)(ws + W_SS))[m] * (1.f / D) + EPS);
        const u32x2* xb = (const u32x2*)(XN + (size_t)m * D) + lane; f32x4* yo = (f32x4*)(R + (size_t)m * D) + lane;
#pragma unroll
        for (int j = 0; j < 8; ++j) { const u32x2 w = xb[64 * j]; const f32x4 gg = ((const f32x4*)p.in[40])[lane + 64 * j];
            yo[64 * j] = (f32x4){bf_lo(w.x) * rs * gg.x, bf_hi(w.x) * rs * gg.y, bf_lo(w.y) * rs * gg.z, bf_hi(w.y) * rs * gg.w}; }
    } }
}

extern "C" void kernel_launch(void* const* d_in, const int* in_sizes, int n_in, void* d_out, int out_size, void* d_ws, size_t ws_size, hipStream_t stream) {
    static int grid = 0;
    if (grid == 0) {
        if (n_in != 41 || (size_t)out_size != O_END || ws_size < W_END) {
            fprintf(stderr, "kernel_launch: unexpected sizes: n_in %d out %d (want %zu) ws %zu (want >= %zu)\n", n_in, out_size, (size_t)O_END, ws_size, (size_t)W_END); grid = -1; return; }
        int dev = 0, cus = 0, per_cu = 0;
        hipGetDevice(&dev); hipDeviceGetAttribute(&cus, hipDeviceAttributeMultiprocessorCount, dev);
        hipFuncSetAttribute((const void*)fwd_megakernel, hipFuncAttributeMaxDynamicSharedMemorySize, LDS_BYTES);
        hipOccupancyMaxActiveBlocksPerMultiprocessor(&per_cu, (const void*)fwd_megakernel, NWAVES * 64, LDS_BYTES);
        if (per_cu < 1) { fprintf(stderr, "kernel_launch: occupancy query says %d blocks per CU\n", per_cu); per_cu = 1; }
        (void)hipGetLastError();
        grid = cus * 1;
    }
    if (grid < 0) return;
    Params p{};
    for (int i = 0; i < 41; ++i) p.in[i] = (const float*)d_in[i];
    p.out = (float*)d_out; p.ws = (unsigned char*)d_ws;
    void* args[] = {&p};
    hipError_t e = hipLaunchCooperativeKernel((const void*)fwd_megakernel, dim3(grid), dim3(NWAVES * 64), args, LDS_BYTES, stream);
    if (e != hipSuccess) fprintf(stderr, "kernel_launch: cooperative launch failed: %s (grid %d)\n", hipGetErrorString(e), grid);
}
```

```cpp
#include <hip/hip_runtime.h>
#include <hip/hip_cooperative_groups.h>
#include <cstdio>
#include <cstdint>
namespace cg = cooperative_groups;

#define LAS __attribute__((address_space(3)))
typedef unsigned short bf16_t;
typedef short bf16x8 __attribute__((ext_vector_type(8)));
typedef float f32x4 __attribute__((ext_vector_type(4)));
typedef float f32x2 __attribute__((ext_vector_type(2)));
typedef unsigned u32x4 __attribute__((ext_vector_type(4)));
typedef unsigned u32x2 __attribute__((ext_vector_type(2)));
typedef __bf16 bf16x2_t __attribute__((ext_vector_type(2)));
#define DI __device__ __forceinline__

constexpr int D = 2048, NBATCH = 8, TSEQ = 4096, MP = NBATCH * TSEQ, SBATCH = 32, STOK = 16, MS = SBATCH * STOK, MT = MP + MS;
constexpr int FF = 5632, NU = 9216, NWAVES = 8;
constexpr int OQ = 0, OKK = 1024, OV = 2048, OXR = 3072, OGR = 4096, OGA = 5120, OGB = 7168;
constexpr int SKEYS = 544;
constexpr float EPS = 1e-6f, LOG2E = 1.4426950408889634f;
constexpr int NSEQ = NBATCH + SBATCH;

constexpr size_t O_YP = 0, O_YS = (size_t)MP * D, O_KP = O_YS + (size_t)MS * D, O_VP = O_KP + (size_t)NBATCH * 512 * 1024,
                 O_CP = O_VP + (size_t)NBATCH * 512 * 1024, O_LP = O_CP + (size_t)NBATCH * 3 * 1024, O_MK = O_LP + (size_t)NBATCH * 1024,
                 O_MV = O_MK + (size_t)NBATCH * 256 * 512, O_KS = O_MV + (size_t)NBATCH * 256 * 512, O_VS = O_KS + (size_t)MS * 1024,
                 O_CS = O_VS + (size_t)MS * 1024, O_LS = O_CS + (size_t)SBATCH * 3 * 1024, O_END = O_LS + (size_t)SBATCH * 1024;

constexpr size_t al256(size_t x) { return (x + 255) & ~(size_t)255; }
constexpr size_t W_GU1 = 0, W_D1 = W_GU1 + (size_t)2 * FF * D * 2, W_IN = W_D1 + (size_t)D * FF * 2, W_PA = W_IN + (size_t)NU * D * 2,
                 W_PB = W_PA + (size_t)D * 1024 * 2, W_OUT = W_PB + (size_t)D * 1024 * 2, W_MQ = W_OUT + (size_t)D * D * 2, W_MKV = W_MQ + (size_t)512 * D * 2,
                 W_MO = W_MKV + (size_t)1024 * D * 2, W_GU2 = W_MO + (size_t)D * 512 * 2, W_D2 = W_GU2 + (size_t)2 * FF * D * 2, W_LRU = W_D2 + (size_t)D * FF * 2,
                 W_C8 = W_LRU + (size_t)2 * 16 * 64 * 64 * 2, W_XN = al256(W_C8 + 1024 * 4), W_U = W_XN + (size_t)MT * D * 2, W_VT = W_U + (size_t)MT * NU * 2,
                 W_KS = W_VT + (size_t)NBATCH * 8 * 128 * TSEQ * 2, W_VTS = W_KS + (size_t)SBATCH * SKEYS * 1024 * 2, W_KM = W_VTS + (size_t)SBATCH * 8 * 128 * SKEYS * 2,
                 W_VTM = W_KM + (size_t)NSEQ * 256 * 512 * 2, W_CA = W_VTM + (size_t)NSEQ * 4 * 128 * 256 * 2, W_CB = W_CA + (size_t)NBATCH * 64 * 1024 * 4,
                 W_SS = W_CB + (size_t)NBATCH * 64 * 1024 * 4, W_BAR = al256(W_SS + (size_t)3 * MT * 4), W_END = W_BAR + 16384;
constexpr size_t W_SLAB = W_VT + (size_t)20 * 1048576;
constexpr size_t W_H = W_U, W_MQB = W_U, W_MN = W_VT, W_MKVF = W_MN + (size_t)2048 * D * 2;

#ifndef STAG
#define STAG 0
#endif
#ifndef REPM
#define REPM 0
#endif
constexpr int RING_BYTES = 131072, LDS_BYTES = 147456;

struct Params { const float* in[41]; float* out; unsigned char* ws; };

DI unsigned pk2(float a, float b) { f32x2 v = {a, b}; bf16x2_t r = __builtin_convertvector(v, bf16x2_t); return __builtin_bit_cast(unsigned, r); }
DI float bf_lo(unsigned w) { return __builtin_bit_cast(float, w << 16); }
DI float bf_hi(unsigned w) { return __builtin_bit_cast(float, w & 0xffff0000u); }
DI void unpack8(const u32x4 w, float (&f)[8]) { f[0] = bf_lo(w.x); f[1] = bf_hi(w.x); f[2] = bf_lo(w.y); f[3] = bf_hi(w.y); f[4] = bf_lo(w.z); f[5] = bf_hi(w.z); f[6] = bf_lo(w.w); f[7] = bf_hi(w.w); }
DI u32x4 pack8(const float (&f)[8]) { u32x4 w; w.x = pk2(f[0], f[1]); w.y = pk2(f[2], f[3]); w.z = pk2(f[4], f[5]); w.w = pk2(f[6], f[7]); return w; }
DI float wave_sum(float v) {
#pragma unroll
    for (int o = 1; o < 64; o <<= 1) v += __shfl_xor(v, o);
    return v;
}
DI float fast_exp2(float x) { return __builtin_amdgcn_exp2f(x); }
DI float fast_rcp(float x) { return __builtin_amdgcn_rcpf(x); }
DI float sigmoidf_(float x) { return fast_rcp(1.0f + fast_exp2(-x * LOG2E)); }
template <int S> DI float dpp_shr(float old, float v) {
    return __builtin_bit_cast(float, __builtin_amdgcn_update_dpp(__builtin_bit_cast(int, old), __builtin_bit_cast(int, v), 0x110 + S, 0xf, 0xf, false));
}
#define LDS_WAIT() asm volatile("s_waitcnt lgkmcnt(0)" ::: "memory")

namespace pg8 {
constexpr int BM = 256, BK = 64, HALF = 128, HTB = HALF * BK * 2, STAGE_BYTES = 8 * HTB, NXCD = 8, WGM = 8;
DI int lds_byte(int r, int c) { const int st = (r >> 4) * 2 + (c >> 5), rr = r & 15, cc = c & 31, ob = rr * 64 + cc * 2; return st * 1024 + (ob ^ (((ob >> 9) & 1) << 5)); }
DI void stage_rc(int b, int& R, int& C) { const int st = b / 1024, sb = b % 1024, swz = sb ^ (((sb >> 9) & 1) << 5); R = (st >> 1) * 16 + swz / 64; C = (st & 1) * 32 + (swz % 64) / 2; }
DI int perm32(int rho) { const int n = rho >> 4, i = rho & 15; return 8 * (i >> 2) + 4 * n + (i & 3); }
struct Unit { int pm, pn, ks, sel; };
struct Gemm { const bf16_t* A; const bf16_t* Bt; int M, N, K, lda, kloop; const bf16_t* A2; const bf16_t* Bt2; };
struct StaticOrder {
    int nM, nN, nwg, G, c;
    DI void init(int M, int N, int G_, int c_) { nM = M / BM; nN = N / BM; nwg = nM * nN; G = G_; c = c_; }
    DI bool next(int i, Unit& u) const {
        const long L = (long)i * G + c; if (L >= nwg) return false;
        int wgid = (int)L; { const int q = nwg / NXCD, r = nwg % NXCD, xcd = wgid % NXCD, off = wgid / NXCD; wgid = (xcd < r ? xcd * (q + 1) : r * (q + 1) + (xcd - r) * q) + off; }
        const int nig = WGM * nN, gid = wgid / nig, fm = gid * WGM, gsz = (nM - fm) < WGM ? (nM - fm) : WGM;
        u.pm = fm + ((wgid % nig) % gsz); u.pn = (wgid % nig) / gsz; u.ks = 0; u.sel = 0; return true;
    }
};
struct PairOrder {
    StaticOrder S;
    DI void init(int M, int N, int G_, int c_) { S.init(M, N, G_, c_); }
    DI bool next(int i, Unit& u) const { if (!S.next(i >> 1, u)) return false; u.sel = i & 1; return true; }
};
struct SplitOrder {
    int nM, nN, ntot, G, c;
    DI void init(int M, int N, int nsplit, int G_, int c_) { nM = M / BM; nN = N / BM; ntot = nM * nN * nsplit; G = G_; c = c_; }
    DI bool next(int i, Unit& u) const {
        const int L = i * G + c; if (L >= ntot) return false;
        u.pm = L % nM; const int r = L / nM; u.pn = r % nN; u.ks = r / nN; u.sel = 0; return true;
    }
};
typedef f32x4 Acc[2][2][4][2];

struct EpiBf16 {
    static constexpr bool PERM = true;
    bf16_t* O; int ldc; const float* ss;
    DI void operator()(const Acc& acc, const Unit& u, int wr, int wc, int fr, int fq) const {
        const int row0 = u.pm * BM + wr * 64 + fr, col0 = u.pn * BM + wc * 32 + 8 * fq;
#pragma unroll
        for (int ai = 0; ai < 2; ++ai)
#pragma unroll
            for (int m = 0; m < 4; ++m) { bf16_t* rowp = O + (size_t)(row0 + ai * HALF + m * 16) * ldc + col0;
                const float rs = ss ? rsqrtf(ss[row0 + ai * HALF + m * 16] * (1.f / D) + EPS) : 1.f;
#pragma unroll
                for (int bj = 0; bj < 2; ++bj) { const f32x4 v0 = acc[ai][bj][m][0] * rs, v1 = acc[ai][bj][m][1] * rs;
                    u32x4 w; w.x = pk2(v0[0], v0[1]); w.y = pk2(v0[2], v0[3]); w.z = pk2(v1[0], v1[1]); w.w = pk2(v1[2], v1[3]);
                    *(u32x4*)(rowp + bj * HALF) = w; } }
    }
};
struct EpiSwiglu {
    static constexpr bool PERM = true;
    bf16_t* O; int ldc; const float* ss;
    DI void operator()(const Acc& acc, const Unit& u, int wr, int wc, int fr, int fq) const {
        const int row0 = u.pm * BM + wr * 64 + fr, col0 = u.pn * HALF + wc * 32 + 8 * fq;
#pragma unroll
        for (int ai = 0; ai < 2; ++ai)
#pragma unroll
            for (int m = 0; m < 4; ++m) {
                const float rs = ss ? rsqrtf(ss[row0 + ai * HALF + m * 16] * (1.f / D) + EPS) : 1.f;
                float h[8];
#pragma unroll
                for (int n = 0; n < 2; ++n)
#pragma unroll
                    for (int j = 0; j < 4; ++j) { const float g = acc[ai][0][m][n][j] * rs, up = acc[ai][1][m][n][j] * rs; h[n * 4 + j] = g * sigmoidf_(g) * up; }
                *(u32x4*)(O + (size_t)(row0 + ai * HALF + m * 16) * ldc + col0) = pack8(h); }
    }
};
struct EpiGate {
    static constexpr bool PERM = true;
    bf16_t* O; const bf16_t* G0; const bf16_t* G1; int ld;
    DI void operator()(const Acc& acc, const Unit& u, int wr, int wc, int fr, int fq) const {
        const int row0 = u.pm * BM + wr * 64 + fr, col0 = u.pn * BM + wc * 32 + 8 * fq;
        const int accum = u.sel; const bf16_t* const G = accum ? G1 : G0;
#pragma unroll
        for (int ai = 0; ai < 2; ++ai)
#pragma unroll
            for (int m = 0; m < 4; ++m)
#pragma unroll
                for (int bj = 0; bj < 2; ++bj) {
                    const size_t off = (size_t)(row0 + ai * HALF + m * 16) * ld + col0 + bj * HALF;
                    float gv[8], o[8]; unpack8(*(const u32x4*)(G + off), gv);
                    if (accum) unpack8(*(const u32x4*)(O + off), o);
                    else {
#pragma unroll
                        for (int i = 0; i < 8; ++i) o[i] = 0.f; }
#pragma unroll
                    for (int n = 0; n < 2; ++n)
#pragma unroll
                        for (int j = 0; j < 4; ++j) o[n * 4 + j] += sigmoidf_(gv[n * 4 + j]) * acc[ai][bj][m][n][j];
                    *(u32x4*)(O + off) = pack8(o); }
    }
};
struct EpiResid {
    static constexpr bool PERM = false;
    float* R; const float* xp; bf16_t* Xb; float* ss; float alpha;
    DI void operator()(const Acc& acc, const Unit& u, int wr, int wc, int fr, int fq) const {
        const float al = alpha; bf16_t* const xb = Xb; float* const ssp = ss; const float* const xin = xp; float* const rf = R;
        const int row0 = u.pm * BM + wr * 64 + fr, col0 = u.pn * BM + wc * 32 + 4 * fq;
        const bool smp = u.pm * BM >= MP;
#pragma unroll
        for (int ai = 0; ai < 2; ++ai)
#pragma unroll
            for (int m = 0; m < 4; ++m) { const int row = row0 + ai * HALF + m * 16;
                const size_t ro = (size_t)row * D + col0;
                float sq = 0.f;
#pragma unroll
                for (int bj = 0; bj < 2; ++bj)
#pragma unroll
                    for (int n = 0; n < 2; ++n) { const size_t o = ro + bj * HALF + n * 16;
                        f32x4 b;
                        if (smp) b = *(const f32x4*)(rf + o);
                        else if (xin) b = *(const f32x4*)(xin + o);
                        else { const u32x2 w0 = *(const u32x2*)(xb + o); b = (f32x4){bf_lo(w0.x), bf_hi(w0.x), bf_lo(w0.y), bf_hi(w0.y)}; }
                        const f32x4 a4 = acc[ai][bj][m][n];
                        f32x4 v; v[0] = b[0] + al * a4[0]; v[1] = b[1] + al * a4[1]; v[2] = b[2] + al * a4[2]; v[3] = b[3] + al * a4[3];
                        if (smp) *(f32x4*)(rf + o) = v;
                        u32x2 w; w.x = pk2(v[0], v[1]); w.y = pk2(v[2], v[3]); *(u32x2*)(xb + o) = w;
                        sq += (v[0] * v[0] + v[1] * v[1]) + (v[2] * v[2] + v[3] * v[3]); }
                sq += __shfl_xor(sq, 16); sq += __shfl_xor(sq, 32); if (fq == 0) unsafeAtomicAdd(ssp + row, sq); }
    }
};
struct EpiPartial {
    static constexpr bool PERM = false;
    float* C; float alpha;
    DI void operator()(const Acc& acc, const Unit& u, int wr, int wc, int fr, int fq) const {
        const float al = alpha;
        const int row0 = u.pm * BM + wr * 64 + fr, col0 = u.pn * BM + wc * 32 + 4 * fq;
        float* const base = C + (size_t)u.ks * ((size_t)MS * D);
#pragma unroll
        for (int ai = 0; ai < 2; ++ai)
#pragma unroll
            for (int m = 0; m < 4; ++m) { float* rp = base + (size_t)(row0 + ai * HALF + m * 16) * D + col0;
#pragma unroll
                for (int bj = 0; bj < 2; ++bj)
#pragma unroll
                    for (int n = 0; n < 2; ++n) { const f32x4 a4 = acc[ai][bj][m][n]; *(f32x4*)(rp + bj * HALF + n * 16) = (f32x4){al * a4[0], al * a4[1], al * a4[2], al * a4[3]}; } }
    }
};
struct EpiResidAtomic {
    static constexpr bool PERM = false;
    float* R; float alpha;
    DI void operator()(const Acc& acc, const Unit& u, int wr, int wc, int fr, int fq) const {
        const int row0 = u.pm * BM + wr * 64 + fr, col0 = u.pn * BM + wc * 32 + 4 * fq;
#pragma unroll
        for (int ai = 0; ai < 2; ++ai)
#pragma unroll
            for (int m = 0; m < 4; ++m) { float* rp = R + (size_t)(row0 + ai * HALF + m * 16) * D + col0;
#pragma unroll
                for (int bj = 0; bj < 2; ++bj)
#pragma unroll
                    for (int n = 0; n < 2; ++n)
#pragma unroll
                        for (int j = 0; j < 4; ++j) unsafeAtomicAdd(rp + bj * HALF + n * 16 + j, alpha * acc[ai][bj][m][n][j]); }
    }
};
struct EpiF32 {
    static constexpr bool PERM = false;
    float* C; int ldc;
    DI void operator()(const Acc& acc, const Unit& u, int wr, int wc, int fr, int fq) const {
        const int row0 = u.pm * BM + wr * 64 + fr, col0 = u.pn * BM + wc * 32 + 4 * fq;
#pragma unroll
        for (int ai = 0; ai < 2; ++ai)
#pragma unroll
            for (int m = 0; m < 4; ++m) { float* rp = C + (size_t)(row0 + ai * HALF + m * 16) * ldc + col0;
#pragma unroll
                for (int bj = 0; bj < 2; ++bj)
#pragma unroll
                    for (int n = 0; n < 2; ++n) *(f32x4*)(rp + bj * HALF + n * 16) = acc[ai][bj][m][n]; }
    }
};

template <class Epi, bool ALIGN_EPI, class Sched>
DI void gemm_phase(LAS unsigned char* lds, const Gemm g, const Sched& S, const Epi& E, int stag = 0) {
    int tid = threadIdx.x; asm volatile("" : "+v"(tid));
    const int wid = __builtin_amdgcn_readfirstlane(tid >> 6), lane = tid & 63, wr = wid >> 2, wc = wid & 3, fr = lane & 15, fq = lane >> 4;
    const int K = g.K, nt = g.kloop / BK;
    const size_t ksl = (size_t)g.kloop * 2;
    unsigned voffA[2], voffB[2];
#pragma unroll
    for (int i = 0; i < 2; ++i) { int R, C; stage_rc(tid * 16 + i * 8192, R, C); const int Rb = Epi::PERM ? ((R & ~31) + perm32(R & 31)) : R;
        voffA[i] = (unsigned)(R * g.lda + C) * 2u; voffB[i] = (unsigned)(Rb * K + C) * 2u; }
    const size_t kstep = (size_t)(BK * 2);
    const size_t hstepA = (size_t)HALF * g.lda * 2, hstepB = (size_t)HALF * K * 2;
    const size_t tstepA = 2 * hstepA, tstepB = 2 * hstepB;
    const unsigned ldsw = (unsigned)wid * 1024u;
    const int aoff = lds_byte(wr * 64 + fr, fq * 8), boff = lds_byte(wc * 32 + fr, fq * 8);
#define PG8_SA(b, h) (((b) * 2 + (h)) * HTB)
#define PG8_SB(b, h) ((4 + (b) * 2 + (h)) * HTB)
#define PG8_STAGE(bufoff, gbase, voff) do { _Pragma("unroll") for (int _i = 0; _i < 2; ++_i) \
        __builtin_amdgcn_global_load_lds((const unsigned*)((const char*)(gbase) + (voff)[_i]), (LAS unsigned*)(lds + (bufoff) + ldsw + _i * 8192), 16, 0, 0); } while (0)
#define PG8_LDA(dst, b, h) do { _Pragma("unroll") for (int m = 0; m < 4; ++m) _Pragma("unroll") for (int k = 0; k < 2; ++k) dst[m][k] = *(const LAS bf16x8*)(lds + PG8_SA(b, h) + aoff + m * 2048 + k * 1024); } while (0)
#define PG8_LDB(dst, b, h) do { _Pragma("unroll") for (int n = 0; n < 2; ++n) _Pragma("unroll") for (int k = 0; k < 2; ++k) dst[n][k] = *(const LAS bf16x8*)(lds + PG8_SB(b, h) + boff + n * 2048 + k * 1024); } while (0)
#define PG8_MMA(ai, bj, At, Bt) do { __builtin_amdgcn_s_setprio(1); _Pragma("unroll") for (int m = 0; m < 4; ++m) _Pragma("unroll") for (int n = 0; n < 2; ++n) _Pragma("unroll") for (int k = 0; k < 2; ++k) \
        acc[ai][bj][m][n] = __builtin_amdgcn_mfma_f32_16x16x32_bf16(Bt[n][k], At[m][k], acc[ai][bj][m][n], 0, 0, 0); __builtin_amdgcn_s_setprio(0); } while (0)
#define PG8_WAIT_V(n) asm volatile("s_waitcnt vmcnt(" #n ")" ::: "memory")
#define PG8_WAIT_L(n) asm volatile("s_waitcnt lgkmcnt(" #n ")" ::: "memory")
#define PG8_BAR __builtin_amdgcn_s_barrier()
#define PG8_SCHED __builtin_amdgcn_sched_barrier(0)
    Unit cur, nxt; int ui = 0;
    if (!S.next(0, cur)) return;
    if (stag) {
        const unsigned long long t0 = __builtin_amdgcn_s_memrealtime(), dl = (unsigned long long)((blockIdx.x >> 5) & 7) * (unsigned)stag;
        while (__builtin_amdgcn_s_memrealtime() - t0 < dl) __builtin_amdgcn_s_sleep(8);
    }
    Acc acc;
#pragma unroll
    for (int a = 0; a < 2; ++a)
#pragma unroll
        for (int b = 0; b < 2; ++b)
#pragma unroll
            for (int m = 0; m < 4; ++m)
#pragma unroll
                for (int n = 0; n < 2; ++n) acc[a][b][m][n] = (f32x4){0.f, 0.f, 0.f, 0.f};
    bf16x8 At[4][2], B0[2][2], B1[2][2];
    const char* cA = (const char*)(cur.sel ? g.A2 : g.A) + (size_t)cur.pm * tstepA + (size_t)cur.ks * ksl; const char* cB = (const char*)(cur.sel ? g.Bt2 : g.Bt) + (size_t)cur.pn * tstepB + (size_t)cur.ks * ksl;
    PG8_STAGE(PG8_SB(0, 0), cB, voffB); PG8_STAGE(PG8_SB(0, 1), cB + hstepB, voffB); PG8_STAGE(PG8_SA(0, 0), cA, voffA); PG8_STAGE(PG8_SA(0, 1), cA + hstepA, voffA);
    if (wr == 1) PG8_BAR;
    PG8_WAIT_V(2); PG8_BAR;
    PG8_STAGE(PG8_SB(1, 0), cB + kstep, voffB); PG8_STAGE(PG8_SA(1, 0), cA + kstep, voffA); PG8_STAGE(PG8_SB(1, 1), cB + hstepB + kstep, voffB);
    PG8_WAIT_V(6); PG8_BAR;
    for (;;) {
        const bool has_next = S.next(ui + 1, nxt);
        const char* nA = has_next ? (const char*)(nxt.sel ? g.A2 : g.A) + (size_t)nxt.pm * tstepA + (size_t)nxt.ks * ksl : cA; const char* nB = has_next ? (const char*)(nxt.sel ? g.Bt2 : g.Bt) + (size_t)nxt.pn * tstepB + (size_t)nxt.ks * ksl : cB;
        for (int t = 0; t < nt; t += 2) {
            const bool last = (t == nt - 2);
            const char* a1 = cA + (size_t)(t + 1) * kstep;
            const char* a2 = last ? nA : cA + (size_t)(t + 2) * kstep; const char* b2 = last ? nB : cB + (size_t)(t + 2) * kstep;
            const char* a3 = a2 + kstep; const char* b3 = b2 + kstep;
            PG8_LDB(B0, 0, 0); PG8_LDB(B1, 0, 1); PG8_SCHED; PG8_LDA(At, 0, 0); PG8_STAGE(PG8_SA(1, 1), a1 + hstepA, voffA);
            PG8_WAIT_V(8); PG8_WAIT_L(0); PG8_BAR; PG8_MMA(0, 0, At, B0); PG8_MMA(0, 1, At, B1); PG8_BAR; PG8_SCHED;
            PG8_LDA(At, 0, 1); PG8_STAGE(PG8_SB(0, 0), b2, voffB); PG8_STAGE(PG8_SB(0, 1), b2 + hstepB, voffB); PG8_STAGE(PG8_SA(0, 0), a2, voffA);
            PG8_WAIT_V(8); PG8_WAIT_L(0); PG8_BAR; PG8_MMA(1, 0, At, B0); PG8_MMA(1, 1, At, B1); PG8_BAR; PG8_SCHED;
            PG8_LDB(B0, 1, 0); PG8_LDB(B1, 1, 1); PG8_SCHED; PG8_LDA(At, 1, 0); PG8_STAGE(PG8_SA(0, 1), a2 + hstepA, voffA);
            PG8_WAIT_V(8); PG8_WAIT_L(0); PG8_BAR; PG8_MMA(0, 0, At, B0); PG8_MMA(0, 1, At, B1); PG8_BAR; PG8_SCHED;
            PG8_LDA(At, 1, 1); PG8_STAGE(PG8_SB(1, 0), b3, voffB); PG8_STAGE(PG8_SB(1, 1), b3 + hstepB, voffB); PG8_STAGE(PG8_SA(1, 0), a3, voffA);
            PG8_WAIT_V(8); PG8_WAIT_L(0); PG8_BAR; PG8_MMA(1, 0, At, B0); PG8_MMA(1, 1, At, B1); PG8_BAR; PG8_SCHED;
        }
        if constexpr (ALIGN_EPI) { if (wr == 0) PG8_BAR; }
        E(acc, cur, wr, wc, fr, fq);
        if (!has_next) break;
#pragma unroll
        for (int a = 0; a < 2; ++a)
#pragma unroll
            for (int b = 0; b < 2; ++b)
#pragma unroll
                for (int m = 0; m < 4; ++m)
#pragma unroll
                    for (int n = 0; n < 2; ++n) acc[a][b][m][n] = (f32x4){0.f, 0.f, 0.f, 0.f};
        cur = nxt; cA = nA; cB = nB; ++ui;
        if constexpr (ALIGN_EPI) { if (wr == 1) PG8_BAR; }
    }
    PG8_WAIT_V(0);
    if constexpr (!ALIGN_EPI) { if (wr == 0) PG8_BAR; }
    PG8_BAR;
#undef PG8_SA
#undef PG8_SB
#undef PG8_STAGE
#undef PG8_LDA
#undef PG8_LDB
#undef PG8_MMA
#undef PG8_WAIT_V
#undef PG8_WAIT_L
#undef PG8_BAR
#undef PG8_SCHED
}
}

DI void transpose_item(const float* W, int K, int N, bf16_t* WT, int sh, int add, LAS float* scr, int item, int lane, const float* gain) {
    const int nblk = N / 32, kb = item / nblk, nb = item % nblk, k0 = 64 * kb, n0 = 32 * nb;
#pragma unroll 8
    for (int i = 0; i < 32; ++i) { const int kk = 2 * i + (lane >> 5); const float gk = gain ? gain[k0 + kk] : 1.f; scr[kk * 33 + (lane & 31)] = W[(size_t)(k0 + kk) * N + n0 + (lane & 31)] * gk; }
    LDS_WAIT();
    const int c = lane & 7;
#pragma unroll
    for (int j = 0; j < 4; ++j) { const int n = (lane >> 3) + 8 * j; const LAS float* s = scr + (8 * c) * 33 + n;
        u32x4 o; o.x = pk2(s[0 * 33], s[1 * 33]); o.y = pk2(s[2 * 33], s[3 * 33]); o.z = pk2(s[4 * 33], s[5 * 33]); o.w = pk2(s[6 * 33], s[7 * 33]);
        const int cc = n0 + n, drow = ((cc >> 7) << sh) + add + (cc & 127);
        *(u32x4*)(WT + (size_t)drow * K + k0 + 8 * c) = o; }
    LDS_WAIT();
}
DI void norm_row_bf16(const float* xrow, const float* gain, bf16_t* orow, int lane) {
    const f32x4* xr = (const f32x4*)xrow + lane;
    f32x4 v[8]; float s = 0.f;
#pragma unroll
    for (int j = 0; j < 8; ++j) { v[j] = xr[64 * j]; s += (v[j].x * v[j].x + v[j].y * v[j].y) + (v[j].z * v[j].z + v[j].w * v[j].w); }
    const float rstd = rsqrtf(wave_sum(s) * (1.f / D) + EPS);
    u32x2* o8 = (u32x2*)orow + lane;
#pragma unroll
    for (int j = 0; j < 8; ++j) { const f32x4 gg = ((const f32x4*)gain)[lane + 64 * j]; u32x2 w; w.x = pk2(v[j].x * rstd * gg.x, v[j].y * rstd * gg.y); w.y = pk2(v[j].z * rstd * gg.z, v[j].w * rstd * gg.w); o8[64 * j] = w; }
}
DI void norm_row_f32(float* xrow, const float* gain, int lane) {
    f32x4* xr = (f32x4*)xrow + lane;
    f32x4 v[8]; float s = 0.f;
#pragma unroll
    for (int j = 0; j < 8; ++j) { v[j] = xr[64 * j]; s += (v[j].x * v[j].x + v[j].y * v[j].y) + (v[j].z * v[j].z + v[j].w * v[j].w); }
    const float rstd = rsqrtf(wave_sum(s) * (1.f / D) + EPS);
#pragma unroll
    for (int j = 0; j < 8; ++j) { const f32x4 gg = ((const f32x4*)gain)[lane + 64 * j]; xr[64 * j] = v[j] * rstd * gg; }
}

DI void feed_row(const float* xrow, bf16_t* orow, float* ssp, int lane) {
    const f32x4* xr = (const f32x4*)xrow + lane;
    f32x4 v[8]; float s = 0.f;
#pragma unroll
    for (int j = 0; j < 8; ++j) { v[j] = xr[64 * j]; s += (v[j].x * v[j].x + v[j].y * v[j].y) + (v[j].z * v[j].z + v[j].w * v[j].w); }
    s = wave_sum(s);
    u32x2* o8 = (u32x2*)orow + lane;
#pragma unroll
    for (int j = 0; j < 8; ++j) { u32x2 w; w.x = pk2(v[j].x, v[j].y); w.y = pk2(v[j].z, v[j].w); o8[64 * j] = w; }
    if (lane == 0) *ssp = s;
}

DI void sample_row_reduce(float* xrow, const float* slab, int nsl, bf16_t* orow, float* ssp, const float* gain, int lane) {
    f32x4* xr = (f32x4*)xrow + lane;
    f32x4 v[8];
#pragma unroll
    for (int j = 0; j < 8; ++j) v[j] = xr[64 * j];
    for (int k = 0; k < nsl; ++k) { const f32x4* sp = (const f32x4*)(slab + (size_t)k * MS * D) + lane;
#pragma unroll
        for (int j = 0; j < 8; ++j) v[j] = v[j] + sp[64 * j]; }
    float s = 0.f;
#pragma unroll
    for (int j = 0; j < 8; ++j) s += (v[j].x * v[j].x + v[j].y * v[j].y) + (v[j].z * v[j].z + v[j].w * v[j].w);
    s = wave_sum(s);
    if (gain) { const float rstd = rsqrtf(s * (1.f / D) + EPS);
#pragma unroll
        for (int j = 0; j < 8; ++j) { const f32x4 gg = ((const f32x4*)gain)[lane + 64 * j]; xr[64 * j] = v[j] * rstd * gg; }
        return; }
    u32x2* o8 = (u32x2*)orow + lane;
#pragma unroll
    for (int j = 0; j < 8; ++j) { xr[64 * j] = v[j]; u32x2 w; w.x = pk2(v[j].x, v[j].y); w.y = pk2(v[j].z, v[j].w); o8[64 * j] = w; }
    if (lane == 0) *ssp = s;
}

DI void attn_load_q(bf16x8 (&qf)[2][4], const bf16_t* Qp, int ldq, int nqg, const float* qgain, int fr, int fq) {
#pragma unroll
    for (int g = 0; g < 2; ++g) {
        if (g < nqg) {
            const bf16_t* qrow = Qp + (size_t)(g * 16 + fr) * ldq + fq * 8;
            float qv[4][8]; float ss = 0.f;
#pragma unroll
            for (int s = 0; s < 4; ++s) { unpack8(*(const u32x4*)(qrow + s * 32), qv[s]);
#pragma unroll
                for (int e = 0; e < 8; ++e) ss += qv[s][e] * qv[s][e]; }
            ss += __shfl_xor(ss, 16); ss += __shfl_xor(ss, 32);
            const float rs = rsqrtf(ss * (1.f / 128.f) + EPS) * (0.08838834764831845f * LOG2E);
#pragma unroll
            for (int s = 0; s < 4; ++s) { const f32x4 g0 = *(const f32x4*)(qgain + s * 32 + fq * 8), g1 = *(const f32x4*)(qgain + s * 32 + fq * 8 + 4);
                float t[8];
#pragma unroll
                for (int e = 0; e < 4; ++e) { t[e] = qv[s][e] * rs * g0[e]; t[4 + e] = qv[s][4 + e] * rs * g1[e]; }
                qf[g][s] = __builtin_bit_cast(bf16x8, pack8(t)); }
        } else {
#pragma unroll
            for (int s = 0; s < 4; ++s) qf[g][s] = (bf16x8){0, 0, 0, 0, 0, 0, 0, 0};
        }
    }
}
template <bool BIAS>
DI void attn_tile(const bf16x8 (&kf)[2][4], const bf16x8 (&vf)[8], const bf16x8 (&qf)[2][4], f32x4 (&o)[2][8], float (&mrun)[2], float (&lrun)[2],
                  int nqg, const LAS float* tbl, int idx0, bool tail, int kpos0, int nvalid) {
    f32x4 st[2][2];
#pragma unroll
    for (int g = 0; g < 2; ++g)
#pragma unroll
        for (int hh = 0; hh < 2; ++hh) { st[g][hh] = (f32x4){0.f, 0.f, 0.f, 0.f};
#pragma unroll
            for (int s = 0; s < 4; ++s) st[g][hh] = __builtin_amdgcn_mfma_f32_16x16x32_bf16(kf[hh][s], qf[g][s], st[g][hh], 0, 0, 0); }
#pragma unroll
    for (int g = 0; g < 2; ++g) {
        if (g < nqg) {
            float sv[8];
#pragma unroll
            for (int e = 0; e < 4; ++e) { sv[e] = st[g][0][e]; sv[4 + e] = st[g][1][e]; }
            if (BIAS) {
#pragma unroll
                for (int e = 0; e < 8; ++e) sv[e] += tbl[idx0 + g * 16 - e]; }
            if (tail) {
#pragma unroll
                for (int e = 0; e < 8; ++e) if (kpos0 + e >= nvalid) sv[e] = -1e30f; }
            float tmax = fmaxf(fmaxf(fmaxf(sv[0], sv[1]), fmaxf(sv[2], sv[3])), fmaxf(fmaxf(sv[4], sv[5]), fmaxf(sv[6], sv[7])));
            tmax = fmaxf(tmax, __shfl_xor(tmax, 16)); tmax = fmaxf(tmax, __shfl_xor(tmax, 32));
            const float mn = fmaxf(mrun[g], tmax), alpha = fast_exp2(mrun[g] - mn); mrun[g] = mn;
            float pv[8], ps = 0.f;
#pragma unroll
            for (int e = 0; e < 8; ++e) { pv[e] = fast_exp2(sv[e] - mn); ps += pv[e]; }
            lrun[g] = lrun[g] * alpha + ps;
            const bf16x8 pf = __builtin_bit_cast(bf16x8, pack8(pv));
#pragma unroll
            for (int dt = 0; dt < 8; ++dt) { o[g][dt] = o[g][dt] * alpha; o[g][dt] = __builtin_amdgcn_mfma_f32_16x16x32_bf16(vf[dt], pf, o[g][dt], 0, 0, 0); }
        }
    }
}
DI void attn_store_o(const f32x4 (&o)[2][8], const float (&lrun)[2], bf16_t* Op, int ldo, int nqg, int fr, int fq) {
#pragma unroll
    for (int g = 0; g < 2; ++g) {
        if (g < nqg) {
            float lt = lrun[g]; lt += __shfl_xor(lt, 16); lt += __shfl_xor(lt, 32);
            const float inv = 1.0f / lt;
            bf16_t* orow = Op + (size_t)(g * 16 + fr) * ldo + fq * 4;
#pragma unroll
            for (int dt = 0; dt < 8; ++dt) { u32x2 w; w.x = pk2(o[g][dt][0] * inv, o[g][dt][1] * inv); w.y = pk2(o[g][dt][2] * inv, o[g][dt][3] * inv); *(u32x2*)(orow + dt * 16) = w; }
        }
    }
}
template <bool BIAS>
DI void attn_task(const bf16_t* Qp, int ldq, bf16_t* Op, int ldo, const bf16_t* Kp, int ldk, const bf16_t* Vtp, int ldv,
                  int nkt, int nvalid, int nqg, const float* qgain, const LAS float* tbl, int dbase, int lane) {
    const int fr = lane & 15, fq = lane >> 4;
    bf16x8 qf[2][4];
    attn_load_q(qf, Qp, ldq, nqg, qgain, fr, fq);
    f32x4 o[2][8];
#pragma unroll
    for (int g = 0; g < 2; ++g)
#pragma unroll
        for (int dt = 0; dt < 8; ++dt) o[g][dt] = (f32x4){0.f, 0.f, 0.f, 0.f};
    float mrun[2] = {-1e30f, -1e30f}, lrun[2] = {0.f, 0.f};
    const bf16_t* kb0 = Kp + (size_t)((fr >> 2) * 8 + (fr & 3)) * ldk + fq * 8;
    const bf16_t* vb0 = Vtp + (size_t)fr * ldv + fq * 8;
#pragma unroll 1
    for (int kt = 0; kt < nkt; ++kt) {
        const bf16_t* kb = kb0 + (size_t)kt * 32 * ldk;
        bf16x8 kf[2][4];
#pragma unroll
        for (int hh = 0; hh < 2; ++hh)
#pragma unroll
            for (int s = 0; s < 4; ++s) kf[hh][s] = *(const bf16x8*)(kb + (size_t)hh * 4 * ldk + s * 32);
        bf16x8 vf[8];
#pragma unroll
        for (int dt = 0; dt < 8; ++dt) vf[dt] = *(const bf16x8*)(vb0 + (size_t)dt * 16 * ldv + kt * 32);
        attn_tile<BIAS>(kf, vf, qf, o, mrun, lrun, nqg, tbl, dbase + fr - kt * 32 - fq * 8, kt * 32 + 32 > nvalid, kt * 32 + fq * 8, nvalid);
    }
    attn_store_o(o, lrun, Op, ldo, nqg, fr, fq);
}
constexpr int AT_TBL = 0, AT_K = 4096, AT_KB = 32 * 272, AT_V = AT_K + 2 * AT_KB, AT_VB = 128 * 80;
DI void attn_wg_prompt(const Params& p, LAS unsigned char* lds, int b, int h, int cg, bf16_t* obase, int ldo, int ocol, int tid) {
    const int lane = tid & 63, wave = __builtin_amdgcn_readfirstlane(tid >> 6), fr = lane & 15, fq = lane >> 4;
    const int c = cg * 4 + (wave >> 1), half = wave & 1;
    const bf16_t* Ub = (const bf16_t*)(p.ws + W_U); const bf16_t* Vtg = (const bf16_t*)(p.ws + W_VT);
    LAS float* tbl = (LAS float*)(lds + AT_TBL);
    __syncthreads();
    for (int i = tid; i < 640; i += NWAVES * 64) { int d = i - 63; d = d < -256 ? -256 : (d > 256 ? 256 : d); tbl[i] = p.in[17][h * 513 + d + 256] * LOG2E; }
    const size_t qrow0 = (size_t)b * TSEQ + c * 64 + half * 32;
    bf16x8 qf[2][4];
    attn_load_q(qf, Ub + qrow0 * NU + OQ + h * 128, NU, 2, p.in[15], fr, fq);
    f32x4 o[2][8];
#pragma unroll
    for (int g = 0; g < 2; ++g)
#pragma unroll
        for (int dt = 0; dt < 8; ++dt) o[g][dt] = (f32x4){0.f, 0.f, 0.f, 0.f};
    float mrun[2] = {-1e30f, -1e30f}, lrun[2] = {0.f, 0.f};
    const int key_lo = (cg * 4 - 8) * 64 > 0 ? (cg * 4 - 8) * 64 : 0, nkt = ((cg * 4 + 4) * 64 - key_lo) / 32;
    const bf16_t* kg = Ub + ((size_t)b * TSEQ + key_lo + (tid >> 4)) * NU + OKK + h * 128 + (tid & 15) * 8;
    const bf16_t* vg = Vtg + ((size_t)(b * 8 + h) * 128 + (tid >> 2)) * TSEQ + key_lo + (tid & 3) * 8;
    const unsigned kw = (unsigned)(tid >> 4) * 272u + (unsigned)(tid & 15) * 16u, vw = (unsigned)(tid >> 2) * 80u + (unsigned)(tid & 3) * 16u;
    const unsigned kroff = (unsigned)((fr >> 2) * 8 + (fr & 3)) * 272u + (unsigned)fq * 16u, vroff = (unsigned)fr * 80u + (unsigned)fq * 16u;
    const int dbase = c * 64 + half * 32 - key_lo + 63;
    u32x4 kr = *(const u32x4*)kg, vr = *(const u32x4*)vg;
#pragma unroll 1
    for (int kt = 0; kt < nkt; ++kt) {
        const int buf = kt & 1;
        *(LAS u32x4*)(lds + AT_K + buf * AT_KB + kw) = kr; *(LAS u32x4*)(lds + AT_V + buf * AT_VB + vw) = vr;
        if (kt + 1 < nkt) { kr = *(const u32x4*)(kg + (size_t)(kt + 1) * 32 * NU); vr = *(const u32x4*)(vg + (kt + 1) * 32); }
        __syncthreads();
        const int kc = (key_lo + kt * 32) >> 6;
        if (kc >= c - 8 && kc <= c) {
            bf16x8 kf[2][4], vf[8];
#pragma unroll
            for (int hh = 0; hh < 2; ++hh)
#pragma unroll
                for (int s = 0; s < 4; ++s) kf[hh][s] = *(const LAS bf16x8*)(lds + AT_K + buf * AT_KB + kroff + hh * (4 * 272) + s * 64);
#pragma unroll
            for (int dt = 0; dt < 8; ++dt) vf[dt] = *(const LAS bf16x8*)(lds + AT_V + buf * AT_VB + vroff + dt * (16 * 80));
            attn_tile<true>(kf, vf, qf, o, mrun, lrun, 2, tbl, dbase + fr - kt * 32 - fq * 8, false, 0, 0);
        }
    }
    attn_store_o(o, lrun, obase + qrow0 * ldo + ocol + h * 128, ldo, 2, fr, fq);
}

DI void attn_wg_mem(const Params& p, LAS unsigned char* lds, int seq, int h, int rg, int tid) {
    const int lane = tid & 63, wave = __builtin_amdgcn_readfirstlane(tid >> 6), fr = lane & 15, fq = lane >> 4;
    bf16_t* MQb = (bf16_t*)(p.ws + W_MQB); const bf16_t* Kmb = (const bf16_t*)(p.ws + W_KM); const bf16_t* Vtmb = (const bf16_t*)(p.ws + W_VTM);
    __syncthreads();
    bf16_t* qp = MQb + ((size_t)seq * TSEQ + rg * 256 + wave * 32) * 512 + h * 128;
    bf16x8 qf[2][4];
    attn_load_q(qf, qp, 512, 2, p.in[33], fr, fq);
    f32x4 o[2][8];
#pragma unroll
    for (int g = 0; g < 2; ++g)
#pragma unroll
        for (int dt = 0; dt < 8; ++dt) o[g][dt] = (f32x4){0.f, 0.f, 0.f, 0.f};
    float mrun[2] = {-1e30f, -1e30f}, lrun[2] = {0.f, 0.f};
    const bf16_t* kg = Kmb + ((size_t)seq * 256 + (tid >> 4)) * 512 + h * 128 + (tid & 15) * 8;
    const bf16_t* vg = Vtmb + ((size_t)(seq * 4 + h) * 128 + (tid >> 2)) * 256 + (tid & 3) * 8;
    const unsigned kw = (unsigned)(tid >> 4) * 272u + (unsigned)(tid & 15) * 16u, vw = (unsigned)(tid >> 2) * 80u + (unsigned)(tid & 3) * 16u;
    const unsigned kroff = (unsigned)((fr >> 2) * 8 + (fr & 3)) * 272u + (unsigned)fq * 16u, vroff = (unsigned)fr * 80u + (unsigned)fq * 16u;
    u32x4 kr = *(const u32x4*)kg, vr = *(const u32x4*)vg;
#pragma unroll 1
    for (int kt = 0; kt < 8; ++kt) {
        const int buf = kt & 1;
        *(LAS u32x4*)(lds + AT_K + buf * AT_KB + kw) = kr; *(LAS u32x4*)(lds + AT_V + buf * AT_VB + vw) = vr;
        if (kt + 1 < 8) { kr = *(const u32x4*)(kg + (size_t)(kt + 1) * 32 * 512); vr = *(const u32x4*)(vg + (kt + 1) * 32); }
        __syncthreads();
        bf16x8 kf[2][4], vf[8];
#pragma unroll
        for (int hh = 0; hh < 2; ++hh)
#pragma unroll
            for (int s = 0; s < 4; ++s) kf[hh][s] = *(const LAS bf16x8*)(lds + AT_K + buf * AT_KB + kroff + hh * (4 * 272) + s * 64);
#pragma unroll
        for (int dt = 0; dt < 8; ++dt) vf[dt] = *(const LAS bf16x8*)(lds + AT_V + buf * AT_VB + vroff + dt * (16 * 80));
        attn_tile<false>(kf, vf, qf, o, mrun, lrun, 2, nullptr, 0, false, 0, 0);
    }
    attn_store_o(o, lrun, qp, 512, 2, fr, fq);
}

constexpr int LT_OFF = 98304, LT_WG = 64 * 144, LT_PAR = 2 * LT_WG;
DI void lru_tables_to_lds(const Params& p, LAS unsigned char* lt, int nblk, int tid) {
    const bf16_t* Wt = (const bf16_t*)(p.ws + W_LRU);
    for (int i = tid; i < 2 * 64 * 8; i += NWAVES * 64) { const int g = i >> 9, row = (i >> 3) & 63, seg = i & 7;
        *(LAS u32x4*)(lt + g * LT_WG + row * 144 + seg * 16) = *(const u32x4*)(Wt + (size_t)g * 65536 + (size_t)(nblk * 64 + row) * 64 + seg * 8); }
    for (int i = tid; i < 512; i += NWAVES * 64) { const int k = i >> 6, ch = nblk * 64 + (i & 63);
        const float v = k < 4 ? p.in[18][k * 1024 + ch] : (k == 4 ? p.in[19][ch] : (k == 5 ? p.in[21][ch] : (k == 6 ? p.in[23][ch] : ((const float*)(p.ws + W_C8))[ch])));
        ((LAS float*)(lt + LT_PAR))[i] = v; }
    __syncthreads();
}
template <int PASS>
DI void lru_unit(const Params& p, int seq, int chunk, int nblk, int lane, bf16_t* obase, unsigned opitch, unsigned ocol, const LAS unsigned char* lt) {
    unsigned char* ws = p.ws;
    const char* Ub = (const char*)(ws + W_U);
    const LAS float* par = (const LAS float*)(lt + LT_PAR);
    float* cA = (float*)(ws + W_CA); float* cB = (float*)(ws + W_CB);
    const bool is_s = seq >= NBATCH;
    const int sb = seq - NBATCH;
    const unsigned row0 = is_s ? (unsigned)MP + (unsigned)sb * STOK : (unsigned)seq * TSEQ;
    const int t0 = is_s ? 0 : chunk * 64, ntt = is_s ? 1 : 4;
    float hc[2][8], arun[2][8];
#pragma unroll
    for (int ks = 0; ks < 2; ++ks)
#pragma unroll
        for (int e = 0; e < 8; ++e) { hc[ks][e] = 0.f; arun[ks][e] = 1.f; }
    if (PASS == 1) {
        float H;
        if (is_s) H = p.in[5][(size_t)sb * 1024 + nblk * 64 + lane];
        else { H = 0.f;
            const float* pa = cA + (size_t)seq * 64 * 1024 + nblk * 64 + lane; const float* pb = cB + (size_t)seq * 64 * 1024 + nblk * 64 + lane;
            for (int c2 = 0; c2 < chunk; c2 += 8) {
                float ta[8], tb[8];
#pragma unroll
                for (int j = 0; j < 8; ++j) { const int cc = (c2 + j < chunk) ? c2 + j : chunk - 1; ta[j] = pa[(size_t)cc * 1024]; tb[j] = pb[(size_t)cc * 1024]; }
#pragma unroll
                for (int j = 0; j < 8; ++j) if (c2 + j < chunk) H = ta[j] * H + tb[j];
            } }
        const int fq0 = lane >> 4;
#pragma unroll
        for (int ks = 0; ks < 2; ++ks)
#pragma unroll
            for (int e = 0; e < 8; ++e) hc[ks][e] = __shfl(H, ks * 32 + fq0 * 8 + e);
    }
#pragma unroll 1
    for (int tt = 0; tt < ntt; ++tt) {
        int lo = lane; asm volatile("" : "+v"(lo) :: "memory");
        const int fr = lo & 15, fq = lo >> 4;
        const int t = t0 + tt * 16 + fr;
        const unsigned chb0 = (unsigned)(nblk * 64 + fq * 8);
        float xc[2][8]; bf16x8 xf[2];
#pragma unroll
        for (int ks = 0; ks < 2; ++ks) {
            const unsigned chb = chb0 + ks * 32;
            const int chl = ks * 32 + fq * 8;
            const f32x4 b0 = *(const LAS f32x4*)(par + 4 * 64 + chl), b1 = *(const LAS f32x4*)(par + 4 * 64 + chl + 4);
#pragma unroll
            for (int e = 0; e < 4; ++e) { xc[ks][e] = b0[e]; xc[ks][4 + e] = b1[e]; }
#pragma unroll
            for (int j = 0; j < 4; ++j) {
                const int tj = t - 3 + j;
                float xv[8];
                if (tj >= 0) unpack8(*(const u32x4*)(Ub + ((row0 + (unsigned)tj) * (unsigned)NU + OXR + chb) * 2u), xv);
                else if (is_s) { const char* sp = (const char*)p.in[4] + (((unsigned)sb * 3u + (unsigned)(3 + tj)) * 1024u + chb) * 4u; const f32x4 s0 = *(const f32x4*)sp, s1 = *(const f32x4*)(sp + 16);
#pragma unroll
                    for (int e = 0; e < 4; ++e) { xv[e] = s0[e]; xv[4 + e] = s1[e]; } }
                else {
#pragma unroll
                    for (int e = 0; e < 8; ++e) xv[e] = 0.f; }
                const f32x4 w0 = *(const LAS f32x4*)(par + j * 64 + chl), w1 = *(const LAS f32x4*)(par + j * 64 + chl + 4);
#pragma unroll
                for (int e = 0; e < 4; ++e) { xc[ks][e] += w0[e] * xv[e]; xc[ks][4 + e] += w1[e] * xv[4 + e]; }
            }
            xf[ks] = __builtin_bit_cast(bf16x8, pack8(xc[ks]));
        }
        float av[2][8], bv[2][8];
        const unsigned wbase = (unsigned)((fr >> 2) * 8 + (fr & 3)) * 144u + (unsigned)fq * 16u;
#pragma unroll
        for (int ct = 0; ct < 4; ++ct) {
            const int ks = ct >> 1, hq = ct & 1;
            const unsigned woff = wbase + (unsigned)((ks * 32 + hq * 4) * 144);
            f32x4 aa = (f32x4){0.f, 0.f, 0.f, 0.f}, ax = (f32x4){0.f, 0.f, 0.f, 0.f};
#pragma unroll
            for (int k2 = 0; k2 < 2; ++k2) {
                const bf16x8 wa = *(const LAS bf16x8*)(lt + woff + k2 * 64u), wx = *(const LAS bf16x8*)(lt + LT_WG + woff + k2 * 64u);
                aa = __builtin_amdgcn_mfma_f32_16x16x32_bf16(wa, xf[k2], aa, 0, 0, 0);
                ax = __builtin_amdgcn_mfma_f32_16x16x32_bf16(wx, xf[k2], ax, 0, 0, 0); }
            const int chq = ks * 32 + fq * 8 + hq * 4;
            const f32x4 ba4 = *(const LAS f32x4*)(par + 5 * 64 + chq), bx4 = *(const LAS f32x4*)(par + 6 * 64 + chq), c84 = *(const LAS f32x4*)(par + 7 * 64 + chq);
#pragma unroll
            for (int j = 0; j < 4; ++j) {
                const int e = hq * 4 + j;
                const float r = sigmoidf_(aa[j] + ba4[j]), ig = sigmoidf_(ax[j] + bx4[j]);
                const float a = fast_exp2(c84[j] * r);
                av[ks][e] = a; bv[ks][e] = sqrtf(fmaxf(1.0f - a * a, 0.f)) * ig * xc[ks][e];
            }
        }
#pragma unroll
        for (int ks = 0; ks < 2; ++ks)
#pragma unroll
            for (int e = 0; e < 8; ++e) {
                float a = av[ks][e], b = bv[ks][e], pa, pb;
                pa = dpp_shr<1>(1.f, a); pb = dpp_shr<1>(0.f, b); b = a * pb + b; a = a * pa;
                pa = dpp_shr<2>(1.f, a); pb = dpp_shr<2>(0.f, b); b = a * pb + b; a = a * pa;
                pa = dpp_shr<4>(1.f, a); pb = dpp_shr<4>(0.f, b); b = a * pb + b; a = a * pa;
                pa = dpp_shr<8>(1.f, a); pb = dpp_shr<8>(0.f, b); b = a * pb + b; a = a * pa;
                const float h = a * hc[ks][e] + b;
                bv[ks][e] = h; av[ks][e] = a;
            }
        const int l15 = (lo & 48) | 15;
        if (PASS == 1) {
#pragma unroll
            for (int ks = 0; ks < 2; ++ks) {
                const unsigned chb = chb0 + ks * 32;
                const char* gp = Ub + ((row0 + (unsigned)t) * (unsigned)NU + OGR + chb) * 2u;
                char* op = (char*)obase + ((row0 + (unsigned)t) * opitch + ocol + chb) * 2u;
                float gv[8], ov[8]; unpack8(*(const u32x4*)gp, gv);
#pragma unroll
                for (int e = 0; e < 8; ++e) { const float x = gv[e]; const float u2 = 1.5957691216057308f * (x + 0.044715f * x * x * x); ov[e] = x * fast_rcp(1.0f + fast_exp2(-u2 * LOG2E)) * bv[ks][e]; }
                *(u32x4*)op = pack8(ov);
                if (fr == 15 && tt == ntt - 1 && (is_s || chunk == 63)) {
                    float* lo2 = p.out + (is_s ? O_LS + (size_t)sb * 1024 : O_LP + (size_t)seq * 1024) + chb;
                    *(f32x4*)lo2 = (f32x4){bv[ks][0], bv[ks][1], bv[ks][2], bv[ks][3]}; *(f32x4*)(lo2 + 4) = (f32x4){bv[ks][4], bv[ks][5], bv[ks][6], bv[ks][7]};
                }
#pragma unroll
                for (int e = 0; e < 8; ++e) hc[ks][e] = __shfl(bv[ks][e], l15);
            }
        } else {
#pragma unroll
            for (int ks = 0; ks < 2; ++ks)
#pragma unroll
                for (int e = 0; e < 8; ++e) { hc[ks][e] = __shfl(bv[ks][e], l15); arun[ks][e] *= __shfl(av[ks][e], l15); }
        }
    }
    if (PASS == 0 && (lane & 15) == 0) {
        const int fq = lane >> 4;
#pragma unroll
        for (int ks = 0; ks < 2; ++ks) { const size_t o = ((size_t)seq * 64 + chunk) * 1024 + nblk * 64 + ks * 32 + fq * 8;
            *(f32x4*)(cA + o) = (f32x4){arun[ks][0], arun[ks][1], arun[ks][2], arun[ks][3]}; *(f32x4*)(cA + o + 4) = (f32x4){arun[ks][4], arun[ks][5], arun[ks][6], arun[ks][7]};
            *(f32x4*)(cB + o) = (f32x4){hc[ks][0], hc[ks][1], hc[ks][2], hc[ks][3]}; *(f32x4*)(cB + o + 4) = (f32x4){hc[ks][4], hc[ks][5], hc[ks][6], hc[ks][7]}; }
    }
}


DI void sample_cache_tasks(const Params& p, int first, int stride, int lane) {
    constexpr int T_KS = SBATCH * 512, T_VTS = SBATCH * 8 * 8;
    bf16_t* Ks = (bf16_t*)(p.ws + W_KS); bf16_t* Vts = (bf16_t*)(p.ws + W_VTS);
        for (int r = first; r < T_KS; r += stride) {
                const int b = r >> 9, j = r & 511;
                const float* src = p.in[2] + (size_t)r * 1024 + lane * 16;
                float t0[8], t1[8];
                { const f32x4 a = *(const f32x4*)src, c = *(const f32x4*)(src + 4), d = *(const f32x4*)(src + 8), e = *(const f32x4*)(src + 12);
                  t0[0] = a.x; t0[1] = a.y; t0[2] = a.z; t0[3] = a.w; t0[4] = c.x; t0[5] = c.y; t0[6] = c.z; t0[7] = c.w;
                  t1[0] = d.x; t1[1] = d.y; t1[2] = d.z; t1[3] = d.w; t1[4] = e.x; t1[5] = e.y; t1[6] = e.z; t1[7] = e.w; }
                bf16_t* kd = Ks + ((size_t)b * SKEYS + j) * 1024 + lane * 16;
                *(u32x4*)kd = pack8(t0); *(u32x4*)(kd + 8) = pack8(t1);


        }
        for (int r = first; r < T_VTS; r += stride) {
                const int b = r >> 6, h = (r >> 3) & 7, jg = r & 7, j = jg * 64 + lane;
                const float* src = p.in[3] + (((size_t)b * 512 + j) * 8 + h) * 128;
                bf16_t* dst = Vts + ((size_t)(b * 8 + h) * 128) * SKEYS + j;
#pragma unroll 4
                for (int dc = 0; dc < 32; ++dc) { const f32x4 v = *(const f32x4*)(src + dc * 4);
                    dst[(size_t)(dc * 4 + 0) * SKEYS] = (bf16_t)pk2(v.x, 0.f); dst[(size_t)(dc * 4 + 1) * SKEYS] = (bf16_t)pk2(v.y, 0.f);
                    dst[(size_t)(dc * 4 + 2) * SKEYS] = (bf16_t)pk2(v.z, 0.f); dst[(size_t)(dc * 4 + 3) * SKEYS] = (bf16_t)pk2(v.w, 0.f); }
                if (jg == 7 && lane < 16) { bf16_t* pz = Vts + ((size_t)(b * 8 + h) * 128) * SKEYS + 528 + lane;
                    for (int d = 0; d < 128; ++d) pz[(size_t)d * SKEYS] = 0; }


        }
}

DI void mem_tasks(const Params& p, int first, int stride, int lane) {
    const float* MKVF = (const float*)(p.ws + W_MKVF); bf16_t* Km = (bf16_t*)(p.ws + W_KM); bf16_t* Vtm = (bf16_t*)(p.ws + W_VTM);
        for (int r = first; r < 2048; r += stride) {
            const float* src = MKVF + (size_t)r * 1024 + lane * 8;
            const f32x4 k0 = *(const f32x4*)src, k1 = *(const f32x4*)(src + 4), v0 = *(const f32x4*)(src + 512), v1 = *(const f32x4*)(src + 516);
            float ss = (k0.x * k0.x + k0.y * k0.y + k0.z * k0.z + k0.w * k0.w) + (k1.x * k1.x + k1.y * k1.y + k1.z * k1.z + k1.w * k1.w);
            ss += __shfl_xor(ss, 1); ss += __shfl_xor(ss, 2); ss += __shfl_xor(ss, 4); ss += __shfl_xor(ss, 8);
            const float rs = rsqrtf(ss * (1.f / 128.f) + EPS);
            const f32x4 g0 = *(const f32x4*)(p.in[34] + (lane * 8) % 128), g1 = *(const f32x4*)(p.in[34] + (lane * 8) % 128 + 4);
            const f32x4 n0 = k0 * rs * g0, n1 = k1 * rs * g1;
            float* ko = p.out + O_MK + (size_t)r * 512 + lane * 8; *(f32x4*)ko = n0; *(f32x4*)(ko + 4) = n1;
            float* vo = p.out + O_MV + (size_t)r * 512 + lane * 8; *(f32x4*)vo = v0; *(f32x4*)(vo + 4) = v1;
            u32x4 w; w.x = pk2(n0.x, n0.y); w.y = pk2(n0.z, n0.w); w.z = pk2(n1.x, n1.y); w.w = pk2(n1.z, n1.w);
            *(u32x4*)(Km + (size_t)r * 512 + lane * 8) = w;
        }
        for (int r = first; r < SBATCH * 256; r += stride) {
            const float* src = p.in[6] + (size_t)r * 512 + lane * 8; const f32x4 k0 = *(const f32x4*)src, k1 = *(const f32x4*)(src + 4);
            u32x4 w; w.x = pk2(k0.x, k0.y); w.y = pk2(k0.z, k0.w); w.z = pk2(k1.x, k1.y); w.w = pk2(k1.z, k1.w);
            *(u32x4*)(Km + ((size_t)NBATCH * 256 + r) * 512 + lane * 8) = w;
        }
        for (int it = first; it < NSEQ * 4 * 4; it += stride) {
            const int seq = it >> 4, h = (it >> 2) & 3, j = (it & 3) * 64 + lane;
            const float* src = seq < NBATCH ? MKVF + ((size_t)seq * 256 + j) * 1024 + 512 + h * 128 : p.in[7] + (((size_t)(seq - NBATCH) * 256 + j) * 4 + h) * 128;
            bf16_t* dst = Vtm + ((size_t)(seq * 4 + h) * 128) * 256 + j;
#pragma unroll 4
            for (int dc = 0; dc < 32; ++dc) { const f32x4 v = *(const f32x4*)(src + dc * 4);
                dst[(size_t)(dc * 4 + 0) * 256] = (bf16_t)(pk2(v.x, 0.f)); dst[(size_t)(dc * 4 + 1) * 256] = (bf16_t)(pk2(v.y, 0.f));
                dst[(size_t)(dc * 4 + 2) * 256] = (bf16_t)(pk2(v.z, 0.f)); dst[(size_t)(dc * 4 + 3) * 256] = (bf16_t)(pk2(v.w, 0.f)); }
        }
}

#define XB_TMO      128
#define XB_XCNT(j)  (256  + 64 * (j))
#define XB_XSUB(j)  (1280 + 64 * (j))
#define XB_XGEN(j)  (2304 + 64 * (j))
#define XB_TOP      3328
#define XB_TOPGEN   3392
#define XCD_BAR_WORDS 3456
#define XB_SPIN_CAP (1u << 18)
DI unsigned xb_ld(unsigned* p)              { return __hip_atomic_load(p, __ATOMIC_RELAXED, __HIP_MEMORY_SCOPE_AGENT); }
DI unsigned xb_add(unsigned* p, unsigned v) { return __hip_atomic_fetch_add(p, v, __ATOMIC_RELAXED, __HIP_MEMORY_SCOPE_AGENT); }
DI unsigned xb_xcc_id() { return (unsigned)__builtin_amdgcn_s_getreg((3 << 11) | 20) & 0xFu; }
#define XB_SPIN(cond, bar) do { unsigned _sp = 0; while (cond) { __builtin_amdgcn_s_sleep(1); \
    if ((++_sp & 255u) == 0u) { if (xb_ld(&(bar)[XB_TMO])) break; if (_sp > XB_SPIN_CAP) { atomicAdd(&(bar)[XB_TMO], 1u); break; } } } } while (0)
struct XcdBarrier { unsigned* bar; unsigned x; volatile LAS unsigned* st; };
DI XcdBarrier xcd_barrier_post(unsigned* bar, volatile LAS unsigned* st) {
    XcdBarrier b; b.bar = bar; b.x = xb_xcc_id(); b.st = st;
    if (threadIdx.x == 0) (void)xb_add(&bar[XB_XCNT(b.x)], 1u);
    return b;
}
DI void xcd_barrier_complete(unsigned* bar, unsigned x, unsigned& nloc, unsigned& nx) {
    const unsigned G = gridDim.x * gridDim.y * gridDim.z;
    unsigned sum, cnt, mine, sp = 0u;
    for (;;) {
        sum = 0u; cnt = 0u; mine = 0u;
#pragma unroll
        for (unsigned j = 0; j < 16; ++j) { const unsigned c = xb_ld(&bar[XB_XCNT(j)]); sum += c; cnt += (c > 0u) ? 1u : 0u; mine = (j == x) ? c : mine; }
        if (sum == G) break;
        __builtin_amdgcn_s_sleep(1);
        if ((++sp & 255u) == 0u) { if (xb_ld(&bar[XB_TMO])) break; if (sp > XB_SPIN_CAP) { atomicAdd(&bar[XB_TMO], 1u); break; } }
    }
    nloc = mine > 0u ? mine : 1u; nx = cnt > 0u ? cnt : 1u;
}
DI void xcd_barrier(const XcdBarrier& b) {
    asm volatile("s_waitcnt vmcnt(0)" ::: "memory");
    __syncthreads();
    if (threadIdx.x == 0) {
        unsigned* bar = b.bar;
        __builtin_amdgcn_s_waitcnt(0);
        unsigned nloc = b.st[0], nx = b.st[1];
        if (nloc == 0u) { xcd_barrier_complete(bar, b.x, nloc, nx); b.st[0] = nloc; b.st[1] = nx; }
        const unsigned old = xb_add(&bar[XB_XSUB(b.x)], 1u);
        const unsigned gen = old / nloc;
        if (old + 1u == (gen + 1u) * nloc) {
            __builtin_amdgcn_fence(__ATOMIC_RELEASE, "agent");
            asm volatile("s_waitcnt vmcnt(0)" ::: "memory");
            const unsigned og = xb_add(&bar[XB_TOP], 1u);
            const unsigned tg = og / nx;
            if (og + 1u == (tg + 1u) * nx) xb_add(&bar[XB_TOPGEN], 1u);
            else XB_SPIN(xb_ld(&bar[XB_TOPGEN]) == tg, bar);
            __builtin_amdgcn_fence(__ATOMIC_ACQUIRE, "agent");
            xb_add(&bar[XB_XGEN(b.x)], 1u);
            asm volatile("s_waitcnt vmcnt(0)" ::: "memory");
        } else {
            XB_SPIN(xb_ld(&bar[XB_XGEN(b.x)]) == gen, bar);
            __builtin_amdgcn_fence(__ATOMIC_ACQUIRE, "agent");
            asm volatile("s_waitcnt vmcnt(0)" ::: "memory");
        }
    }
    __syncthreads();
}

__global__ void __launch_bounds__(NWAVES * 64, 2) fwd_megakernel(Params p) {
    extern __shared__ __attribute__((aligned(16))) unsigned char lds_raw[];
    cg::grid_group grid = cg::this_grid();
    LAS unsigned char* lds = (LAS unsigned char*)lds_raw;
#define PH_IDS int tid = threadIdx.x; asm volatile("" : "+v"(tid)); const int lane = tid & 63, wave = __builtin_amdgcn_readfirstlane(tid >> 6); \
    const int G = gridDim.x, gw = blockIdx.x * NWAVES + wave, NGW = G * NWAVES; (void)lane; (void)gw; (void)NGW; (void)G
    unsigned char* ws = p.ws;
    float* R = p.out;
    bf16_t* XN = (bf16_t*)(ws + W_XN); bf16_t* U = (bf16_t*)(ws + W_U); bf16_t* H = (bf16_t*)(ws + W_H);
    bf16_t* Vt = (bf16_t*)(ws + W_VT); bf16_t* Ks = (bf16_t*)(ws + W_KS); bf16_t* Vts = (bf16_t*)(ws + W_VTS);
    bf16_t* Km = (bf16_t*)(ws + W_KM); bf16_t* Vtm = (bf16_t*)(ws + W_VTM);
    bf16_t* MN = (bf16_t*)(ws + W_MN); float* MKVF = (float*)(ws + W_MKVF); bf16_t* MQ = (bf16_t*)(ws + W_MQB);

    for (int rep_ = 0; rep_ < 1 + ((REPM >> 0) & 1); ++rep_) { if (rep_) grid.sync(); PH_IDS;
        if (blockIdx.x == 0) for (int i = tid; i < 4096; i += NWAVES * 64) ((unsigned*)(ws + W_BAR))[i] = 0u;
        if (tid < 2) ((volatile LAS unsigned*)(lds + 131072 + 64))[tid] = 0u;
        LAS float* scr = (LAS float*)(lds + wave * 16384);
        constexpr int I_FU = (D / 64) * (FF / 32), I_FD = (FF / 64) * (D / 32), I_IN = (D / 64) * (NU / 32), I_P = (1024 / 64) * (D / 32), I_O = (D / 64) * (D / 32),
                      I_M = (D / 64) * (512 / 32), I_MO = (512 / 64) * (D / 32);
        constexpr int NITEMS = 4 * I_FU + 2 * I_FD + I_IN + 2 * I_P + I_O + 3 * I_M + I_MO;
        for (int it = gw; it < NITEMS; it += NGW) {
            int r = it;
#define TJ(IDX, KK, NN, OFF, SH, ADD, NI, GN) if (r < (NI)) { transpose_item(p.in[IDX], KK, NN, (bf16_t*)(ws + (OFF)), SH, ADD, scr, r, lane, GN); continue; } r -= (NI);
            TJ(10, D, FF, W_GU1, 8, 0, I_FU, nullptr) TJ(11, D, FF, W_GU1, 8, 128, I_FU, nullptr) TJ(12, FF, D, W_D1, 7, 0, I_FD, nullptr)
            TJ(37, D, FF, W_GU2, 8, 0, I_FU, p.in[36]) TJ(38, D, FF, W_GU2, 8, 128, I_FU, p.in[36]) TJ(39, FF, D, W_D2, 7, 0, I_FD, nullptr)
            TJ(14, D, NU, W_IN, 7, 0, I_IN, p.in[13]) TJ(25, 1024, D, W_PA, 7, 0, I_P, nullptr) TJ(26, 1024, D, W_PB, 7, 0, I_P, nullptr) TJ(27, D, D, W_OUT, 7, 0, I_O, nullptr)
            TJ(30, D, 512, W_MQ, 7, 0, I_M, p.in[28]) TJ(31, D, 512, W_MKV, 7, 0, I_M, nullptr) TJ(32, D, 512, W_MKV, 7, 512, I_M, nullptr)
            transpose_item(p.in[35], 512, D, (bf16_t*)(ws + W_MO), 7, 0, scr, r, lane, nullptr);
#undef TJ
        }
        for (int m = gw; m < MT; m += NGW) norm_row_bf16(m < MP ? p.in[0] + (size_t)m * D : p.in[1] + (size_t)(m - MP) * D, p.in[9], XN + (size_t)m * D, lane);
        for (int m = gw; m < 2048; m += NGW) norm_row_bf16(p.in[8] + (size_t)m * D, p.in[29], MN + (size_t)m * D, lane);
        {
            bf16_t* Wt = (bf16_t*)(ws + W_LRU); float* c8 = (float*)(ws + W_C8);
            for (int i = blockIdx.x * 512 + tid; i < 2 * 65536; i += G * 512) { const int gsel = i >> 16, n = (i >> 12) & 15, c = (i >> 6) & 63, k = i & 63;
                const float v = p.in[gsel ? 22 : 20][n * 4096 + k * 64 + c]; Wt[i] = (bf16_t)(pk2(v, 0.f) & 0xffffu); }
            for (int i = blockIdx.x * 512 + tid; i < 1024; i += G * 512) c8[i] = -8.0f * log1pf(expf(-p.in[24][i])) * LOG2E;
            float* ssz = (float*)(ws + W_SS);
            for (int i = blockIdx.x * 512 + tid; i < 3 * MT; i += G * 512) ssz[i] = 0.f;
            for (int i = blockIdx.x * 512 + tid; i < MS * D / 4; i += G * 512) ((f32x4*)(R + (size_t)MP * D))[i] = ((const f32x4*)p.in[1])[i];
        }
    }
    grid.sync();
    XcdBarrier xbar = xcd_barrier_post((unsigned*)(p.ws + W_BAR), (volatile LAS unsigned*)(lds + 131072 + 64));

    for (int rr = 0; rr < ((REPM >> 18) & 1) * 20; ++rr) grid.sync();
    for (int rep_ = 0; rep_ < 1 + ((REPM >> 1) & 1); ++rep_) { if (rep_) grid.sync(); PH_IDS;
        pg8::Gemm g{XN, (const bf16_t*)(ws + W_GU1), MT, 2 * FF, D, D, D}; pg8::StaticOrder S; S.init(MT, 2 * FF, G, (int)blockIdx.x);
        pg8::EpiSwiglu E{H, FF, nullptr};
        pg8::gemm_phase<pg8::EpiSwiglu, true>(lds, g, S, E, STAG);
        pg8::Gemm g2{MN, (const bf16_t*)(ws + W_MKV), 2048, 1024, D, D, D}; pg8::StaticOrder S2; S2.init(2048, 1024, G, (int)((blockIdx.x + 128) % G));
        pg8::EpiF32 E2{MKVF, 1024};
        pg8::gemm_phase<pg8::EpiF32, true>(lds, g2, S2, E2);
        if (G > 160 && (int)blockIdx.x >= 160) sample_cache_tasks(p, ((int)blockIdx.x - 160) * NWAVES + wave, (G - 160) * NWAVES, lane);
    }
    xcd_barrier(xbar);

    for (int rep_ = 0; rep_ < 1 + ((REPM >> 2) & 1); ++rep_) { if (rep_) grid.sync(); PH_IDS;
        pg8::Gemm g{H, (const bf16_t*)(ws + W_D1), MP, D, FF, FF, FF}; pg8::StaticOrder S; S.init(MP, D, G, (int)blockIdx.x);
        pg8::EpiResid E{R, p.in[0], XN, (float*)(ws + W_SS), 0.5f};
        pg8::gemm_phase<pg8::EpiResid, true>(lds, g, S, E, STAG);
        pg8::Gemm gs{H + (size_t)MP * FF, (const bf16_t*)(ws + W_D1), MS, D, FF, FF, FF / 11}; pg8::SplitOrder Ss; Ss.init(MS, D, 11, G, (int)blockIdx.x);
        pg8::EpiPartial Es{(float*)(ws + W_SLAB), 0.5f};
        pg8::gemm_phase<pg8::EpiPartial, true>(lds, gs, Ss, Es);
        mem_tasks(p, gw, NGW, lane);
    }
    xcd_barrier(xbar);

    for (int rep_ = 0; rep_ < 1 + ((REPM >> 3) & 1); ++rep_) { if (rep_) grid.sync(); PH_IDS;
        for (int m = MP + gw; m < MT; m += NGW) sample_row_reduce(R + (size_t)m * D, (const float*)(ws + W_SLAB) + (size_t)(m - MP) * D, 11, XN + (size_t)m * D, (float*)(ws + W_SS) + m, nullptr, lane);
    }
    xcd_barrier(xbar);

    for (int rep_ = 0; rep_ < 1 + ((REPM >> 4) & 1); ++rep_) { if (rep_) grid.sync(); PH_IDS;
        pg8::Gemm g{XN, (const bf16_t*)(ws + W_IN), MT, NU, D, D, D}; pg8::StaticOrder S; S.init(MT, NU, G, (int)blockIdx.x);
        pg8::EpiBf16 E{U, NU, (const float*)(ws + W_SS)};
        pg8::gemm_phase<pg8::EpiBf16, true>(lds, g, S, E, STAG);
    }
    xcd_barrier(xbar);

    for (int rep_ = 0; rep_ < 1 + ((REPM >> 5) & 1); ++rep_) { if (rep_) grid.sync(); PH_IDS;
        const bool dummy5 = ((REPM >> 5) & 1) && rep_ == 0;
        constexpr int T_ROWS = MT, T_VT = NBATCH * 64 * 8, T_KS = SBATCH * 512, T_VTS = SBATCH * 8 * 8, T_LRU = NBATCH * 64 * 16;
        for (int r = gw; r < T_ROWS; r += NGW) {
                const bool is_s = r >= MP; const int rs_ = r - MP;
                const int b = is_s ? (rs_ >> 4) : (r >> 12), t = is_s ? (rs_ & 15) : (r & 4095);
                bf16_t* urow = U + (size_t)r * NU;
                float kv[16], vv[16];
                { const u32x4 a = *(const u32x4*)(urow + OKK + lane * 16), c = *(const u32x4*)(urow + OKK + lane * 16 + 8);
                  float t0[8], t1[8]; unpack8(a, t0); unpack8(c, t1);
#pragma unroll
                  for (int i = 0; i < 8; ++i) { kv[i] = t0[i]; kv[8 + i] = t1[i]; } }
                const bool wr_kv = is_s || t >= TSEQ - 512;
                if (wr_kv) { const u32x4 a = *(const u32x4*)(urow + OV + lane * 16), c = *(const u32x4*)(urow + OV + lane * 16 + 8);
                  float t0[8], t1[8]; unpack8(a, t0); unpack8(c, t1);
#pragma unroll
                  for (int i = 0; i < 8; ++i) { vv[i] = t0[i]; vv[8 + i] = t1[i]; } }
                else {
#pragma unroll
                  for (int i = 0; i < 16; ++i) vv[i] = 0.f; }
                float ss = 0.f;
#pragma unroll
                for (int i = 0; i < 16; ++i) ss += kv[i] * kv[i];
                ss += __shfl_xor(ss, 1); ss += __shfl_xor(ss, 2); ss += __shfl_xor(ss, 4);
                const float rstd = rsqrtf(ss * (1.f / 128.f) + EPS);
                const float* gp = p.in[16] + (lane * 16) % 128;
#pragma unroll
                for (int i = 0; i < 4; ++i) { const f32x4 gg = *(const f32x4*)(gp + 4 * i);
#pragma unroll
                    for (int j = 0; j < 4; ++j) kv[4 * i + j] *= rstd * gg[j]; }
                bf16_t* kd = is_s ? Ks + ((size_t)b * SKEYS + 512 + t) * 1024 + lane * 16 : (dummy5 ? XN + (size_t)r * 1024 + lane * 16 : urow + OKK + lane * 16);
                { float t0[8], t1[8];
#pragma unroll
                  for (int i = 0; i < 8; ++i) { t0[i] = kv[i]; t1[i] = kv[8 + i]; }
                  *(u32x4*)kd = pack8(t0); *(u32x4*)(kd + 8) = pack8(t1); }
                if (wr_kv) {
                    const size_t ro = is_s ? (size_t)rs_ * 1024 : ((size_t)b * 512 + (t - (TSEQ - 512))) * 1024;
                    float* ko = p.out + (is_s ? O_KS : O_KP) + ro + lane * 16; float* vo = p.out + (is_s ? O_VS : O_VP) + ro + lane * 16;
#pragma unroll
                    for (int i = 0; i < 4; ++i) { *(f32x4*)(ko + 4 * i) = (f32x4){kv[4 * i], kv[4 * i + 1], kv[4 * i + 2], kv[4 * i + 3]}; *(f32x4*)(vo + 4 * i) = (f32x4){vv[4 * i], vv[4 * i + 1], vv[4 * i + 2], vv[4 * i + 3]}; }
                }
                const int tl = is_s ? STOK : TSEQ;
                if (t >= tl - 3) {
                    float xv[16];
                    { const u32x4 a = *(const u32x4*)(urow + OXR + lane * 16), c = *(const u32x4*)(urow + OXR + lane * 16 + 8);
                      float t0[8], t1[8]; unpack8(a, t0); unpack8(c, t1);
#pragma unroll
                      for (int i = 0; i < 8; ++i) { xv[i] = t0[i]; xv[8 + i] = t1[i]; } }
                    float* co = p.out + (is_s ? O_CS : O_CP) + ((size_t)b * 3 + (t - (tl - 3))) * 1024 + lane * 16;
#pragma unroll
                    for (int i = 0; i < 4; ++i) *(f32x4*)(co + 4 * i) = (f32x4){xv[4 * i], xv[4 * i + 1], xv[4 * i + 2], xv[4 * i + 3]};
                }
                if (is_s) {
                    const int h = lane >> 3, d0 = (lane & 7) * 16;
                    bf16_t* dst = Vts + ((size_t)(b * 8 + h) * 128 + d0) * SKEYS + 512 + t;
#pragma unroll
                    for (int i = 0; i < 16; ++i) dst[(size_t)i * SKEYS] = (bf16_t)pk2(vv[i], 0.f);
                }


        }
        for (int r = gw; r < T_VT; r += NGW) {
                const int b = r >> 9, c = (r >> 3) & 63, h = r & 7, t = c * 64 + lane;
                const bf16_t* src = U + ((size_t)b * TSEQ + t) * NU + OV + h * 128;
                bf16_t* dst = Vt + ((size_t)(b * 8 + h) * 128) * TSEQ + t;
#pragma unroll 4
                for (int dc = 0; dc < 16; ++dc) { const u32x4 w = *(const u32x4*)(src + dc * 8);
                    dst[(size_t)(dc * 8 + 0) * TSEQ] = (bf16_t)(w.x & 0xffffu); dst[(size_t)(dc * 8 + 1) * TSEQ] = (bf16_t)(w.x >> 16);
                    dst[(size_t)(dc * 8 + 2) * TSEQ] = (bf16_t)(w.y & 0xffffu); dst[(size_t)(dc * 8 + 3) * TSEQ] = (bf16_t)(w.y >> 16);
                    dst[(size_t)(dc * 8 + 4) * TSEQ] = (bf16_t)(w.z & 0xffffu); dst[(size_t)(dc * 8 + 5) * TSEQ] = (bf16_t)(w.z >> 16);
                    dst[(size_t)(dc * 8 + 6) * TSEQ] = (bf16_t)(w.w & 0xffffu); dst[(size_t)(dc * 8 + 7) * TSEQ] = (bf16_t)(w.w >> 16); }


        }
        if (G <= 160) sample_cache_tasks(p, gw, NGW, lane);
        {
            const int nblk = blockIdx.x & 15, slot = (blockIdx.x >> 4) * NWAVES + wave, nslot = (G >> 4) * NWAVES;
            __syncthreads();
            lru_tables_to_lds(p, lds + LT_OFF, nblk, tid);
            for (int rr = 0; rr < 1 + ((REPM >> 17) & 1) * 3; ++rr)
            for (int u = slot; u < NBATCH * 64; u += nslot) lru_unit<0>(p, u >> 6, u & 63, nblk, lane, nullptr, 0u, 0u, lds + LT_OFF);
            (void)T_LRU;
        }
    }
    xcd_barrier(xbar);

    for (int rep_ = 0; rep_ < 1 + ((REPM >> 6) & 1); ++rep_) { if (rep_) grid.sync(); PH_IDS;
        const bool dummy = ((REPM >> 6) & 1) && rep_ == 0;
        LAS float* tbl = (LAS float*)(lds + 65536);
        constexpr int T_AP = NBATCH * 64 * 8 * 2, T_AS = SBATCH * 8, T_LP = NBATCH * 64 * 16, T_LS = SBATCH * 16;
        for (int wt = blockIdx.x; wt < NBATCH * 8 * 16; wt += G) {
            int pair, cg4;
            if (G == 256) { const int itp = wt >> 8, x = blockIdx.x & 7, j = blockIdx.x >> 3; pair = x * 8 + itp * 2 + (j >> 4); cg4 = (j + itp * 4) & 15; }
            else { pair = wt >> 4; cg4 = wt & 15; }
            attn_wg_prompt(p, lds, pair >> 3, pair & 7, cg4, dummy ? XN : U, dummy ? 1024 : NU, dummy ? 0 : OQ, tid);
        }
        __syncthreads();
        for (int q = blockIdx.x; q < T_AS; q += G) if (wave == 0) {
            const int b = q >> 3, h = q & 7;
            for (int i = lane; i < 640; i += 64) { int d = i - 63; d = d < -256 ? -256 : (d > 256 ? 256 : d); tbl[i] = p.in[17][h * 513 + d + 256] * LOG2E; }
            asm volatile("s_waitcnt lgkmcnt(0)" ::: "memory");
            __builtin_amdgcn_wave_barrier();
            bf16_t* qp = U + ((size_t)MP + (size_t)b * STOK) * NU + OQ + h * 128;
            attn_task<true>(qp, NU, dummy ? XN + ((size_t)MP + (size_t)b * STOK) * 1024 + h * 128 : qp, dummy ? 1024 : NU, Ks + (size_t)b * SKEYS * 1024 + h * 128, 1024, Vts + ((size_t)(b * 8 + h) * 128) * SKEYS, SKEYS,
                            17, 528, 1, p.in[15], tbl, 1024 - 512 + 63, lane);
            asm volatile("s_waitcnt lgkmcnt(0)" ::: "memory");
            __builtin_amdgcn_wave_barrier();
        }
        {
            const int nblk = blockIdx.x & 15, slot = (blockIdx.x >> 4) * NWAVES + wave, nslot = (G >> 4) * NWAVES;
            __syncthreads();
            lru_tables_to_lds(p, lds + LT_OFF, nblk, tid);
            for (int u = slot; u < NBATCH * 64 + SBATCH; u += nslot) { const bool pr = u < NBATCH * 64;
                lru_unit<1>(p, pr ? (u >> 6) : NBATCH + (u - NBATCH * 64), pr ? (u & 63) : 0, nblk, lane, dummy ? XN + (size_t)MT * 1024 : U, dummy ? 1024u : (unsigned)NU, dummy ? 0u : (unsigned)OGR, lds + LT_OFF); }
            (void)T_LP; (void)T_LS;
        }
    }
    xcd_barrier(xbar);

    for (int rep_ = 0; rep_ < 1 + ((REPM >> 7) & 1); ++rep_) { if (rep_) grid.sync(); PH_IDS;
        pg8::PairOrder S; S.init(MT, D, G, (int)blockIdx.x);
        pg8::Gemm g1{U + OQ, (const bf16_t*)(ws + W_PA), MT, D, 1024, NU, 1024, U + OGR, (const bf16_t*)(ws + W_PB)};
        pg8::EpiGate E1{U + OGA, U + OGA, U + OGB, NU};
        pg8::gemm_phase<pg8::EpiGate, true>(lds, g1, S, E1, STAG);
    }
    xcd_barrier(xbar);

    for (int rep_ = 0; rep_ < 1 + ((REPM >> 8) & 1); ++rep_) { if (rep_) grid.sync(); PH_IDS;
        pg8::Gemm g{U + OGA, (const bf16_t*)(ws + W_OUT), MP, D, D, NU, D}; pg8::StaticOrder S; S.init(MP, D, G, (int)blockIdx.x);
        pg8::EpiResid E{R, nullptr, XN, (float*)(ws + W_SS) + MT, 1.0f};
        pg8::gemm_phase<pg8::EpiResid, true>(lds, g, S, E, STAG);
        pg8::Gemm gs{U + (size_t)MP * NU + OGA, (const bf16_t*)(ws + W_OUT), MS, D, D, NU, D / 4}; pg8::SplitOrder Ss; Ss.init(MS, D, 4, G, (int)blockIdx.x);
        pg8::EpiPartial Es{(float*)(ws + W_SLAB), 1.0f};
        pg8::gemm_phase<pg8::EpiPartial, true>(lds, gs, Ss, Es);
    }
    xcd_barrier(xbar);

    for (int rep_ = 0; rep_ < 1 + ((REPM >> 9) & 1); ++rep_) { PH_IDS;
    for (int m = MP + gw; m < MT; m += NGW) sample_row_reduce(R + (size_t)m * D, (const float*)(ws + W_SLAB) + (size_t)(m - MP) * D, 4, XN + (size_t)m * D, (float*)(ws + W_SS) + MT + m, nullptr, lane);
    for (int i = blockIdx.x * 512 + tid; i < MP; i += G * 512) ((float*)(ws + W_SS))[i] = 0.f; }
    xcd_barrier(xbar);

    for (int rep_ = 0; rep_ < 1 + ((REPM >> 10) & 1); ++rep_) { if (rep_) grid.sync(); PH_IDS;
        pg8::Gemm g{XN, (const bf16_t*)(ws + W_MQ), MT, 512, D, D, D}; pg8::StaticOrder S; S.init(MT, 512, G, (int)blockIdx.x);
        pg8::EpiBf16 E{MQ, 512, (const float*)(ws + W_SS) + MT};
        pg8::gemm_phase<pg8::EpiBf16, true>(lds, g, S, E, 0);
    }
    xcd_barrier(xbar);

    for (int rep_ = 0; rep_ < 1 + ((REPM >> 11) & 1); ++rep_) { if (rep_) grid.sync(); PH_IDS;
        for (int wt = blockIdx.x; wt < NBATCH * 4 * 16; wt += G) attn_wg_mem(p, lds, wt >> 6, (wt >> 4) & 3, wt & 15, tid);
        for (int q = gw; q < SBATCH * 4; q += NGW) { const int b = q >> 2, h = q & 3, seq = NBATCH + b;
            bf16_t* qp = MQ + ((size_t)MP + (size_t)b * STOK) * 512 + h * 128;
            attn_task<false>(qp, 512, qp, 512, Km + (size_t)seq * 256 * 512 + h * 128, 512, Vtm + ((size_t)(seq * 4 + h) * 128) * 256, 256, 8, 256, 1, p.in[33], nullptr, 0, lane);
        }
    }
    xcd_barrier(xbar);

    for (int rep_ = 0; rep_ < 1 + ((REPM >> 12) & 1); ++rep_) { if (rep_) grid.sync(); PH_IDS;
        pg8::Gemm g{MQ, (const bf16_t*)(ws + W_MO), MT, D, 512, 512, 512}; pg8::StaticOrder S; S.init(MT, D, G, (int)blockIdx.x);
        pg8::EpiResid E{R, nullptr, XN, (float*)(ws + W_SS) + 2 * MT, 1.0f};
        pg8::gemm_phase<pg8::EpiResid, true>(lds, g, S, E, 0);
    }
    xcd_barrier(xbar);

    for (int rep_ = 0; rep_ < 1 + ((REPM >> 14) & 1); ++rep_) { if (rep_) grid.sync(); PH_IDS;
        pg8::Gemm g{XN, (const bf16_t*)(ws + W_GU2), MT, 2 * FF, D, D, D}; pg8::StaticOrder S; S.init(MT, 2 * FF, G, (int)blockIdx.x);
        pg8::EpiSwiglu E{H, FF, (const float*)(ws + W_SS) + 2 * MT};
        pg8::gemm_phase<pg8::EpiSwiglu, true>(lds, g, S, E, STAG);
    }
    xcd_barrier(xbar);

    for (int rep_ = 0; rep_ < 1 + ((REPM >> 15) & 1); ++rep_) { if (rep_) grid.sync(); PH_IDS;
        pg8::Gemm g{H, (const bf16_t*)(ws + W_D2), MP, D, FF, FF, FF}; pg8::StaticOrder S; S.init(MP, D, G, (int)blockIdx.x);
        pg8::EpiResid E{R, nullptr, XN, (float*)(ws + W_SS), 0.5f};
        pg8::gemm_phase<pg8::EpiResid, true>(lds, g, S, E, STAG);
        pg8::Gemm gs{H + (size_t)MP * FF, (const bf16_t*)(ws + W_D2), MS, D, FF, FF, FF / 11}; pg8::SplitOrder Ss; Ss.init(MS, D, 11, G, (int)blockIdx.x);
        pg8::EpiPartial Es{(float*)(ws + W_SLAB), 0.5f};
        pg8::gemm_phase<pg8::EpiPartial, true>(lds, gs, Ss, Es);
    }
    xcd_barrier(xbar);

    for (int rep_ = 0; rep_ < 1 + ((REPM >> 16) & 1); ++rep_) { PH_IDS;
    for (int m = gw; m < MT; m += NGW) {
        if (m >= MP) { sample_row_reduce(R + (size_t)m * D, (const float*)(ws + W_SLAB) + (size_t)(m - MP) * D, 11, nullptr, nullptr, p.in[40], lane); continue; }
        const float rs = rsqrtf(((const float*)(ws + W_SS))[m] * (1.f / D) + EPS);
        const u32x2* xb = (const u32x2*)(XN + (size_t)m * D) + lane; f32x4* yo = (f32x4*)(R + (size_t)m * D) + lane;
#pragma unroll
        for (int j = 0; j < 8; ++j) { const u32x2 w = xb[64 * j]; const f32x4 gg = ((const f32x4*)p.in[40])[lane + 64 * j];
            yo[64 * j] = (f32x4){bf_lo(w.x) * rs * gg.x, bf_hi(w.x) * rs * gg.y, bf_lo(w.y) * rs * gg.z, bf_hi(w.y) * rs * gg.w}; }
    } }
}

extern "C" void kernel_launch(void* const* d_in, const int* in_sizes, int n_in, void* d_out, int out_size, void* d_ws, size_t ws_size, hipStream_t stream) {
    static int grid = 0;
    if (grid == 0) {
        if (n_in != 41 || (size_t)out_size != O_END || ws_size < W_END) {
            fprintf(stderr, "kernel_launch: unexpected sizes: n_in %d out %d (want %zu) ws %zu (want >= %zu)\n", n_in, out_size, (size_t)O_END, ws_size, (size_t)W_END); grid = -1; return; }
        int dev = 0, cus = 0, per_cu = 0;
        hipGetDevice(&dev); hipDeviceGetAttribute(&cus, hipDeviceAttributeMultiprocessorCount, dev);
        hipFuncSetAttribute((const void*)fwd_megakernel, hipFuncAttributeMaxDynamicSharedMemorySize, LDS_BYTES);
        hipOccupancyMaxActiveBlocksPerMultiprocessor(&per_cu, (const void*)fwd_megakernel, NWAVES * 64, LDS_BYTES);
        if (per_cu < 1) { fprintf(stderr, "kernel_launch: occupancy query says %d blocks per CU\n", per_cu); per_cu = 1; }
        (void)hipGetLastError();
        grid = cus * 1;
    }
    if (grid < 0) return;
    Params p{};
    for (int i = 0; i < 41; ++i) p.in[i] = (const float*)d_in[i];
    p.out = (float*)d_out; p.ws = (unsigned char*)d_ws;
    void* args[] = {&p};
    hipError_t e = hipLaunchCooperativeKernel((const void*)fwd_megakernel, dim3(grid), dim3(NWAVES * 64), args, LDS_BYTES, stream);
    if (e != hipSuccess) fprintf(stderr, "kernel_launch: cooperative launch failed: %s (grid %d)\n", hipGetErrorString(e), grid);
}
```

```cpp
#include <hip/hip_runtime.h>
#include <hip/hip_cooperative_groups.h>
#include <cstdio>
#include <cstdint>
namespace cg = cooperative_groups;

#define LAS __attribute__((address_space(3)))
typedef unsigned short bf16_t;
typedef short bf16x8 __attribute__((ext_vector_type(8)));
typedef float f32x4 __attribute__((ext_vector_type(4)));
typedef float f32x2 __attribute__((ext_vector_type(2)));
typedef unsigned u32x4 __attribute__((ext_vector_type(4)));
typedef unsigned u32x2 __attribute__((ext_vector_type(2)));
typedef __bf16 bf16x2_t __attribute__((ext_vector_type(2)));
#define DI __device__ __forceinline__

constexpr int D = 2048, NBATCH = 8, TSEQ = 4096, MP = NBATCH * TSEQ, SBATCH = 32, STOK = 16, MS = SBATCH * STOK, MT = MP + MS;
constexpr int FF = 5632, NU = 9216, NWAVES = 8;
constexpr int OQ = 0, OKK = 1024, OV = 2048, OXR = 3072, OGR = 4096, OGA = 5120, OGB = 7168;
constexpr int SKEYS = 544;
constexpr float EPS = 1e-6f, LOG2E = 1.4426950408889634f;
constexpr int NSEQ = NBATCH + SBATCH;

constexpr size_t O_YP = 0, O_YS = (size_t)MP * D, O_KP = O_YS + (size_t)MS * D, O_VP = O_KP + (size_t)NBATCH * 512 * 1024,
                 O_CP = O_VP + (size_t)NBATCH * 512 * 1024, O_LP = O_CP + (size_t)NBATCH * 3 * 1024, O_MK = O_LP + (size_t)NBATCH * 1024,
                 O_MV = O_MK + (size_t)NBATCH * 256 * 512, O_KS = O_MV + (size_t)NBATCH * 256 * 512, O_VS = O_KS + (size_t)MS * 1024,
                 O_CS = O_VS + (size_t)MS * 1024, O_LS = O_CS + (size_t)SBATCH * 3 * 1024, O_END = O_LS + (size_t)SBATCH * 1024;

constexpr size_t al256(size_t x) { return (x + 255) & ~(size_t)255; }
constexpr size_t W_GU1 = 0, W_D1 = W_GU1 + (size_t)2 * FF * D * 2, W_IN = W_D1 + (size_t)D * FF * 2, W_PA = W_IN + (size_t)NU * D * 2,
                 W_PB = W_PA + (size_t)D * 1024 * 2, W_OUT = W_PB + (size_t)D * 1024 * 2, W_MQ = W_OUT + (size_t)D * D * 2, W_MKV = W_MQ + (size_t)512 * D * 2,
                 W_MO = W_MKV + (size_t)1024 * D * 2, W_GU2 = W_MO + (size_t)D * 512 * 2, W_D2 = W_GU2 + (size_t)2 * FF * D * 2, W_LRU = W_D2 + (size_t)D * FF * 2,
                 W_C8 = W_LRU + (size_t)2 * 16 * 64 * 64 * 2, W_XN = al256(W_C8 + 1024 * 4), W_U = W_XN + (size_t)MT * D * 2, W_VT = W_U + (size_t)MT * NU * 2,
                 W_KS = W_VT + (size_t)NBATCH * 8 * 128 * TSEQ * 2, W_VTS = W_KS + (size_t)SBATCH * SKEYS * 1024 * 2, W_KM = W_VTS + (size_t)SBATCH * 8 * 128 * SKEYS * 2,
                 W_VTM = W_KM + (size_t)NSEQ * 256 * 512 * 2, W_CA = W_VTM + (size_t)NSEQ * 4 * 128 * 256 * 2, W_CB = W_CA + (size_t)NBATCH * 64 * 1024 * 4,
                 W_SS = W_CB + (size_t)NBATCH * 64 * 1024 * 4, W_BAR = al256(W_SS + (size_t)3 * MT * 4), W_END = W_BAR + 16384;
constexpr size_t W_SLAB = W_VT + (size_t)20 * 1048576;
constexpr size_t W_H = W_U, W_MQB = W_U, W_MN = W_VT, W_MKVF = W_MN + (size_t)2048 * D * 2;

#ifndef STAG
#define STAG 0
#endif
#ifndef REPM
#define REPM 0
#endif
constexpr int RING_BYTES = 131072, LDS_BYTES = 147456;

struct Params { const float* in[41]; float* out; unsigned char* ws; };

DI unsigned pk2(float a, float b) { f32x2 v = {a, b}; bf16x2_t r = __builtin_convertvector(v, bf16x2_t); return __builtin_bit_cast(unsigned, r); }
DI float bf_lo(unsigned w) { return __builtin_bit_cast(float, w << 16); }
DI float bf_hi(unsigned w) { return __builtin_bit_cast(float, w & 0xffff0000u); }
DI void unpack8(const u32x4 w, float (&f)[8]) { f[0] = bf_lo(w.x); f[1] = bf_hi(w.x); f[2] = bf_lo(w.y); f[3] = bf_hi(w.y); f[4] = bf_lo(w.z); f[5] = bf_hi(w.z); f[6] = bf_lo(w.w); f[7] = bf_hi(w.w); }
DI u32x4 pack8(const float (&f)[8]) { u32x4 w; w.x = pk2(f[0], f[1]); w.y = pk2(f[2], f[3]); w.z = pk2(f[4], f[5]); w.w = pk2(f[6], f[7]); return w; }
DI float wave_sum(float v) {
#pragma unroll
    for (int o = 1; o < 64; o <<= 1) v += __shfl_xor(v, o);
    return v;
}
DI float fast_exp2(float x) { return __builtin_amdgcn_exp2f(x); }
DI float fast_rcp(float x) { return __builtin_amdgcn_rcpf(x); }
DI float sigmoidf_(float x) { return fast_rcp(1.0f + fast_exp2(-x * LOG2E)); }
template <int S> DI float dpp_shr(float old, float v) {
    return __builtin_bit_cast(float, __builtin_amdgcn_update_dpp(__builtin_bit_cast(int, old), __builtin_bit_cast(int, v), 0x110 + S, 0xf, 0xf, false));
}
#define LDS_WAIT() asm volatile("s_waitcnt lgkmcnt(0)" ::: "memory")

namespace pg8 {
constexpr int BM = 256, BK = 64, HALF = 128, HTB = HALF * BK * 2, STAGE_BYTES = 8 * HTB, NXCD = 8, WGM = 8;
DI int lds_byte(int r, int c) { const int st = (r >> 4) * 2 + (c >> 5), rr = r & 15, cc = c & 31, ob = rr * 64 + cc * 2; return st * 1024 + (ob ^ (((ob >> 9) & 1) << 5)); }
DI void stage_rc(int b, int& R, int& C) { const int st = b / 1024, sb = b % 1024, swz = sb ^ (((sb >> 9) & 1) << 5); R = (st >> 1) * 16 + swz / 64; C = (st & 1) * 32 + (swz % 64) / 2; }
DI int perm32(int rho) { const int n = rho >> 4, i = rho & 15; return 8 * (i >> 2) + 4 * n + (i & 3); }
struct Unit { int pm, pn, ks, sel; };
struct Gemm { const bf16_t* A; const bf16_t* Bt; int M, N, K, lda, kloop; const bf16_t* A2; const bf16_t* Bt2; };
struct StaticOrder {
    int nM, nN, nwg, G, c;
    DI void init(int M, int N, int G_, int c_) { nM = M / BM; nN = N / BM; nwg = nM * nN; G = G_; c = c_; }
    DI bool next(int i, Unit& u) const {
        const long L = (long)i * G + c; if (L >= nwg) return false;
        int wgid = (int)L; { const int q = nwg / NXCD, r = nwg % NXCD, xcd = wgid % NXCD, off = wgid / NXCD; wgid = (xcd < r ? xcd * (q + 1) : r * (q + 1) + (xcd - r) * q) + off; }
        const int nig = WGM * nN, gid = wgid / nig, fm = gid * WGM, gsz = (nM - fm) < WGM ? (nM - fm) : WGM;
        u.pm = fm + ((wgid % nig) % gsz); u.pn = (wgid % nig) / gsz; u.ks = 0; u.sel = 0; return true;
    }
};
struct PairOrder {
    StaticOrder S;
    DI void init(int M, int N, int G_, int c_) { S.init(M, N, G_, c_); }
    DI bool next(int i, Unit& u) const { if (!S.next(i >> 1, u)) return false; u.sel = i & 1; return true; }
};
struct SplitOrder {
    int nM, nN, ntot, G, c;
    DI void init(int M, int N, int nsplit, int G_, int c_) { nM = M / BM; nN = N / BM; ntot = nM * nN * nsplit; G = G_; c = c_; }
    DI bool next(int i, Unit& u) const {
        const int L = i * G + c; if (L >= ntot) return false;
        u.pm = L % nM; const int r = L / nM; u.pn = r % nN; u.ks = r / nN; u.sel = 0; return true;
    }
};
typedef f32x4 Acc[2][2][4][2];

struct EpiBf16 {
    static constexpr bool PERM = true;
    bf16_t* O; int ldc; const float* ss;
    DI void operator()(const Acc& acc, const Unit& u, int wr, int wc, int fr, int fq) const {
        const int row0 = u.pm * BM + wr * 64 + fr, col0 = u.pn * BM + wc * 32 + 8 * fq;
#pragma unroll
        for (int ai = 0; ai < 2; ++ai)
#pragma unroll
            for (int m = 0; m < 4; ++m) { bf16_t* rowp = O + (size_t)(row0 + ai * HALF + m * 16) * ldc + col0;
                const float rs = ss ? rsqrtf(ss[row0 + ai * HALF + m * 16] * (1.f / D) + EPS) : 1.f;
#pragma unroll
                for (int bj = 0; bj < 2; ++bj) { const f32x4 v0 = acc[ai][bj][m][0] * rs, v1 = acc[ai][bj][m][1] * rs;
                    u32x4 w; w.x = pk2(v0[0], v0[1]); w.y = pk2(v0[2], v0[3]); w.z = pk2(v1[0], v1[1]); w.w = pk2(v1[2], v1[3]);
                    *(u32x4*)(rowp + bj * HALF) = w; } }
    }
};
struct EpiSwiglu {
    static constexpr bool PERM = true;
    bf16_t* O; int ldc; const float* ss;
    DI void operator()(const Acc& acc, const Unit& u, int wr, int wc, int fr, int fq) const {
        const int row0 = u.pm * BM + wr * 64 + fr, col0 = u.pn * HALF + wc * 32 + 8 * fq;
#pragma unroll
        for (int ai = 0; ai < 2; ++ai)
#pragma unroll
            for (int m = 0; m < 4; ++m) {
                const float rs = ss ? rsqrtf(ss[row0 + ai * HALF + m * 16] * (1.f / D) + EPS) : 1.f;
                float h[8];
#pragma unroll
                for (int n = 0; n < 2; ++n)
#pragma unroll
                    for (int j = 0; j < 4; ++j) { const float g = acc[ai][0][m][n][j] * rs, up = acc[ai][1][m][n][j] * rs; h[n * 4 + j] = g * sigmoidf_(g) * up; }
                *(u32x4*)(O + (size_t)(row0 + ai * HALF + m * 16) * ldc + col0) = pack8(h); }
    }
};
struct EpiGate {
    static constexpr bool PERM = true;
    bf16_t* O; const bf16_t* G0; const bf16_t* G1; int ld;
    DI void operator()(const Acc& acc, const Unit& u, int wr, int wc, int fr, int fq) const {
        const int row0 = u.pm * BM + wr * 64 + fr, col0 = u.pn * BM + wc * 32 + 8 * fq;
        const int accum = u.sel; const bf16_t* const G = accum ? G1 : G0;
#pragma unroll
        for (int ai = 0; ai < 2; ++ai)
#pragma unroll
            for (int m = 0; m < 4; ++m)
#pragma unroll
                for (int bj = 0; bj < 2; ++bj) {
                    const size_t off = (size_t)(row0 + ai * HALF + m * 16) * ld + col0 + bj * HALF;
                    float gv[8], o[8]; unpack8(*(const u32x4*)(G + off), gv);
                    if (accum) unpack8(*(const u32x4*)(O + off), o);
                    else {
#pragma unroll
                        for (int i = 0; i < 8; ++i) o[i] = 0.f; }
#pragma unroll
                    for (int n = 0; n < 2; ++n)
#pragma unroll
                        for (int j = 0; j < 4; ++j) o[n * 4 + j] += sigmoidf_(gv[n * 4 + j]) * acc[ai][bj][m][n][j];
                    *(u32x4*)(O + off) = pack8(o); }
    }
};
struct EpiResid {
    static constexpr bool PERM = false;
    float* R; const float* xp; bf16_t* Xb; float* ss; float alpha;
    DI void operator()(const Acc& acc, const Unit& u, int wr, int wc, int fr, int fq) const {
        const float al = alpha; bf16_t* const xb = Xb; float* const ssp = ss; const float* const xin = xp; float* const rf = R;
        const int row0 = u.pm * BM + wr * 64 + fr, col0 = u.pn * BM + wc * 32 + 4 * fq;
        const bool smp = u.pm * BM >= MP;
#pragma unroll
        for (int ai = 0; ai < 2; ++ai)
#pragma unroll
            for (int m = 0; m < 4; ++m) { const int row = row0 + ai * HALF + m * 16;
                const size_t ro = (size_t)row * D + col0;
                float sq = 0.f;
#pragma unroll
                for (int bj = 0; bj < 2; ++bj)
#pragma unroll
                    for (int n = 0; n < 2; ++n) { const size_t o = ro + bj * HALF + n * 16;
                        f32x4 b;
                        if (smp) b = *(const f32x4*)(rf + o);
                        else if (xin) b = *(const f32x4*)(xin + o);
                        else { const u32x2 w0 = *(const u32x2*)(xb + o); b = (f32x4){bf_lo(w0.x), bf_hi(w0.x), bf_lo(w0.y), bf_hi(w0.y)}; }
                        const f32x4 a4 = acc[ai][bj][m][n];
                        f32x4 v; v[0] = b[0] + al * a4[0]; v[1] = b[1] + al * a4[1]; v[2] = b[2] + al * a4[2]; v[3] = b[3] + al * a4[3];
                        if (smp) *(f32x4*)(rf + o) = v;
                        u32x2 w; w.x = pk2(v[0], v[1]); w.y = pk2(v[2], v[3]); *(u32x2*)(xb + o) = w;
                        sq += (v[0] * v[0] + v[1] * v[1]) + (v[2] * v[2] + v[3] * v[3]); }
                sq += __shfl_xor(sq, 16); sq += __shfl_xor(sq, 32); if (fq == 0) unsafeAtomicAdd(ssp + row, sq); }
    }
};
struct EpiPartial {
    static constexpr bool PERM = false;
    float* C; float alpha;
    DI void operator()(const Acc& acc, const Unit& u, int wr, int wc, int fr, int fq) const {
        const float al = alpha;
        const int row0 = u.pm * BM + wr * 64 + fr, col0 = u.pn * BM + wc * 32 + 4 * fq;
        float* const base = C + (size_t)u.ks * ((size_t)MS * D);
#pragma unroll
        for (int ai = 0; ai < 2; ++ai)
#pragma unroll
            for (int m = 0; m < 4; ++m) { float* rp = base + (size_t)(row0 + ai * HALF + m * 16) * D + col0;
#pragma unroll
                for (int bj = 0; bj < 2; ++bj)
#pragma unroll
                    for (int n = 0; n < 2; ++n) { const f32x4 a4 = acc[ai][bj][m][n]; *(f32x4*)(rp + bj * HALF + n * 16) = (f32x4){al * a4[0], al * a4[1], al * a4[2], al * a4[3]}; } }
    }
};
struct EpiResidAtomic {
    static constexpr bool PERM = false;
    float* R; float alpha;
    DI void operator()(const Acc& acc, const Unit& u, int wr, int wc, int fr, int fq) const {
        const int row0 = u.pm * BM + wr * 64 + fr, col0 = u.pn * BM + wc * 32 + 4 * fq;
#pragma unroll
        for (int ai = 0; ai < 2; ++ai)
#pragma unroll
            for (int m = 0; m < 4; ++m) { float* rp = R + (size_t)(row0 + ai * HALF + m * 16) * D + col0;
#pragma unroll
                for (int bj = 0; bj < 2; ++bj)
#pragma unroll
                    for (int n = 0; n < 2; ++n)
#pragma unroll
                        for (int j = 0; j < 4; ++j) unsafeAtomicAdd(rp + bj * HALF + n * 16 + j, alpha * acc[ai][bj][m][n][j]); }
    }
};
struct EpiF32 {
    static constexpr bool PERM = false;
    float* C; int ldc;
    DI void operator()(const Acc& acc, const Unit& u, int wr, int wc, int fr, int fq) const {
        const int row0 = u.pm * BM + wr * 64 + fr, col0 = u.pn * BM + wc * 32 + 4 * fq;
#pragma unroll
        for (int ai = 0; ai < 2; ++ai)
#pragma unroll
            for (int m = 0; m < 4; ++m) { float* rp = C + (size_t)(row0 + ai * HALF + m * 16) * ldc + col0;
#pragma unroll
                for (int bj = 0; bj < 2; ++bj)
#pragma unroll
                    for (int n = 0; n < 2; ++n) *(f32x4*)(rp + bj * HALF + n * 16) = acc[ai][bj][m][n]; }
    }
};

template <class Epi, bool ALIGN_EPI, class Sched>
DI void gemm_phase(LAS unsigned char* lds, const Gemm g, const Sched& S, const Epi& E, int stag = 0) {
    int tid = threadIdx.x; asm volatile("" : "+v"(tid));
    const int wid = __builtin_amdgcn_readfirstlane(tid >> 6), lane = tid & 63, wr = wid >> 2, wc = wid & 3, fr = lane & 15, fq = lane >> 4;
    const int K = g.K, nt = g.kloop / BK;
    const size_t ksl = (size_t)g.kloop * 2;
    unsigned voffA[2], voffB[2];
#pragma unroll
    for (int i = 0; i < 2; ++i) { int R, C; stage_rc(tid * 16 + i * 8192, R, C); const int Rb = Epi::PERM ? ((R & ~31) + perm32(R & 31)) : R;
        voffA[i] = (unsigned)(R * g.lda + C) * 2u; voffB[i] = (unsigned)(Rb * K + C) * 2u; }
    const size_t kstep = (size_t)(BK * 2);
    const size_t hstepA = (size_t)HALF * g.lda * 2, hstepB = (size_t)HALF * K * 2;
    const size_t tstepA = 2 * hstepA, tstepB = 2 * hstepB;
    const unsigned ldsw = (unsigned)wid * 1024u;
    const int aoff = lds_byte(wr * 64 + fr, fq * 8), boff = lds_byte(wc * 32 + fr, fq * 8);
#define PG8_SA(b, h) (((b) * 2 + (h)) * HTB)
#define PG8_SB(b, h) ((4 + (b) * 2 + (h)) * HTB)
#define PG8_STAGE(bufoff, gbase, voff) do { _Pragma("unroll") for (int _i = 0; _i < 2; ++_i) \
        __builtin_amdgcn_global_load_lds((const unsigned*)((const char*)(gbase) + (voff)[_i]), (LAS unsigned*)(lds + (bufoff) + ldsw + _i * 8192), 16, 0, 0); } while (0)
#define PG8_LDA(dst, b, h) do { _Pragma("unroll") for (int m = 0; m < 4; ++m) _Pragma("unroll") for (int k = 0; k < 2; ++k) dst[m][k] = *(const LAS bf16x8*)(lds + PG8_SA(b, h) + aoff + m * 2048 + k * 1024); } while (0)
#define PG8_LDB(dst, b, h) do { _Pragma("unroll") for (int n = 0; n < 2; ++n) _Pragma("unroll") for (int k = 0; k < 2; ++k) dst[n][k] = *(const LAS bf16x8*)(lds + PG8_SB(b, h) + boff + n * 2048 + k * 1024); } while (0)
#define PG8_MMA(ai, bj, At, Bt) do { __builtin_amdgcn_s_setprio(1); _Pragma("unroll") for (int m = 0; m < 4; ++m) _Pragma("unroll") for (int n = 0; n < 2; ++n) _Pragma("unroll") for (int k = 0; k < 2; ++k) \
        acc[ai][bj][m][n] = __builtin_amdgcn_mfma_f32_16x16x32_bf16(Bt[n][k], At[m][k], acc[ai][bj][m][n], 0, 0, 0); __builtin_amdgcn_s_setprio(0); } while (0)
#define PG8_WAIT_V(n) asm volatile("s_waitcnt vmcnt(" #n ")" ::: "memory")
#define PG8_WAIT_L(n) asm volatile("s_waitcnt lgkmcnt(" #n ")" ::: "memory")
#define PG8_BAR __builtin_amdgcn_s_barrier()
#define PG8_SCHED __builtin_amdgcn_sched_barrier(0)
    Unit cur, nxt; int ui = 0;
    if (!S.next(0, cur)) return;
    if (stag) {
        const unsigned long long t0 = __builtin_amdgcn_s_memrealtime(), dl = (unsigned long long)((blockIdx.x >> 5) & 7) * (unsigned)stag;
        while (__builtin_amdgcn_s_memrealtime() - t0 < dl) __builtin_amdgcn_s_sleep(8);
    }
    Acc acc;
#pragma unroll
    for (int a = 0; a < 2; ++a)
#pragma unroll
        for (int b = 0; b < 2; ++b)
#pragma unroll
            for (int m = 0; m < 4; ++m)
#pragma unroll
                for (int n = 0; n < 2; ++n) acc[a][b][m][n] = (f32x4){0.f, 0.f, 0.f, 0.f};
    bf16x8 At[4][2], B0[2][2], B1[2][2];
    const char* cA = (const char*)(cur.sel ? g.A2 : g.A) + (size_t)cur.pm * tstepA + (size_t)cur.ks * ksl; const char* cB = (const char*)(cur.sel ? g.Bt2 : g.Bt) + (size_t)cur.pn * tstepB + (size_t)cur.ks * ksl;
    PG8_STAGE(PG8_SB(0, 0), cB, voffB); PG8_STAGE(PG8_SB(0, 1), cB + hstepB, voffB); PG8_STAGE(PG8_SA(0, 0), cA, voffA); PG8_STAGE(PG8_SA(0, 1), cA + hstepA, voffA);
    if (wr == 1) PG8_BAR;
    PG8_WAIT_V(2); PG8_BAR;
    PG8_STAGE(PG8_SB(1, 0), cB + kstep, voffB); PG8_STAGE(PG8_SA(1, 0), cA + kstep, voffA); PG8_STAGE(PG8_SB(1, 1), cB + hstepB + kstep, voffB);
    PG8_WAIT_V(6); PG8_BAR;
    for (;;) {
        const bool has_next = S.next(ui + 1, nxt);
        const char* nA = has_next ? (const char*)(nxt.sel ? g.A2 : g.A) + (size_t)nxt.pm * tstepA + (size_t)nxt.ks * ksl : cA; const char* nB = has_next ? (const char*)(nxt.sel ? g.Bt2 : g.Bt) + (size_t)nxt.pn * tstepB + (size_t)nxt.ks * ksl : cB;
        for (int t = 0; t < nt; t += 2) {
            const bool last = (t == nt - 2);
            const char* a1 = cA + (size_t)(t + 1) * kstep;
            const char* a2 = last ? nA : cA + (size_t)(t + 2) * kstep; const char* b2 = last ? nB : cB + (size_t)(t + 2) * kstep;
            const char* a3 = a2 + kstep; const char* b3 = b2 + kstep;
            PG8_LDB(B0, 0, 0); PG8_LDB(B1, 0, 1); PG8_SCHED; PG8_LDA(At, 0, 0); PG8_STAGE(PG8_SA(1, 1), a1 + hstepA, voffA);
            PG8_WAIT_V(8); PG8_WAIT_L(0); PG8_BAR; PG8_MMA(0, 0, At, B0); PG8_MMA(0, 1, At, B1); PG8_BAR; PG8_SCHED;
            PG8_LDA(At, 0, 1); PG8_STAGE(PG8_SB(0, 0), b2, voffB); PG8_STAGE(PG8_SB(0, 1), b2 + hstepB, voffB); PG8_STAGE(PG8_SA(0, 0), a2, voffA);
            PG8_WAIT_V(8); PG8_WAIT_L(0); PG8_BAR; PG8_MMA(1, 0, At, B0); PG8_MMA(1, 1, At, B1); PG8_BAR; PG8_SCHED;
            PG8_LDB(B0, 1, 0); PG8_LDB(B1, 1, 1); PG8_SCHED; PG8_LDA(At, 1, 0); PG8_STAGE(PG8_SA(0, 1), a2 + hstepA, voffA);
            PG8_WAIT_V(8); PG8_WAIT_L(0); PG8_BAR; PG8_MMA(0, 0, At, B0); PG8_MMA(0, 1, At, B1); PG8_BAR; PG8_SCHED;
            PG8_LDA(At, 1, 1); PG8_STAGE(PG8_SB(1, 0), b3, voffB); PG8_STAGE(PG8_SB(1, 1), b3 + hstepB, voffB); PG8_STAGE(PG8_SA(1, 0), a3, voffA);
            PG8_WAIT_V(8); PG8_WAIT_L(0); PG8_BAR; PG8_MMA(1, 0, At, B0); PG8_MMA(1, 1, At, B1); PG8_BAR; PG8_SCHED;
        }
        if constexpr (ALIGN_EPI) { if (wr == 0) PG8_BAR; }
        E(acc, cur, wr, wc, fr, fq);
        if (!has_next) break;
#pragma unroll
        for (int a = 0; a < 2; ++a)
#pragma unroll
            for (int b = 0; b < 2; ++b)
#pragma unroll
                for (int m = 0; m < 4; ++m)
#pragma unroll
                    for (int n = 0; n < 2; ++n) acc[a][b][m][n] = (f32x4){0.f, 0.f, 0.f, 0.f};
        cur = nxt; cA = nA; cB = nB; ++ui;
        if constexpr (ALIGN_EPI) { if (wr == 1) PG8_BAR; }
    }
    PG8_WAIT_V(0);
    if constexpr (!ALIGN_EPI) { if (wr == 0) PG8_BAR; }
    PG8_BAR;
#undef PG8_SA
#undef PG8_SB
#undef PG8_STAGE
#undef PG8_LDA
#undef PG8_LDB
#undef PG8_MMA
#undef PG8_WAIT_V
#undef PG8_WAIT_L
#undef PG8_BAR
#undef PG8_SCHED
}
}

DI void transpose_item(const float* W, int K, int N, bf16_t* WT, int sh, int add, LAS float* scr, int item, int lane, const float* gain) {
    const int nblk = N / 32, kb = item / nblk, nb = item % nblk, k0 = 64 * kb, n0 = 32 * nb;
#pragma unroll 8
    for (int i = 0; i < 32; ++i) { const int kk = 2 * i + (lane >> 5); const float gk = gain ? gain[k0 + kk] : 1.f; scr[kk * 33 + (lane & 31)] = W[(size_t)(k0 + kk) * N + n0 + (lane & 31)] * gk; }
    LDS_WAIT();
    const int c = lane & 7;
#pragma unroll
    for (int j = 0; j < 4; ++j) { const int n = (lane >> 3) + 8 * j; const LAS float* s = scr + (8 * c) * 33 + n;
        u32x4 o; o.x = pk2(s[0 * 33], s[1 * 33]); o.y = pk2(s[2 * 33], s[3 * 33]); o.z = pk2(s[4 * 33], s[5 * 33]); o.w = pk2(s[6 * 33], s[7 * 33]);
        const int cc = n0 + n, drow = ((cc >> 7) << sh) + add + (cc & 127);
        *(u32x4*)(WT + (size_t)drow * K + k0 + 8 * c) = o; }
    LDS_WAIT();
}
DI void norm_row_bf16(const float* xrow, const float* gain, bf16_t* orow, int lane) {
    const f32x4* xr = (const f32x4*)xrow + lane;
    f32x4 v[8]; float s = 0.f;
#pragma unroll
    for (int j = 0; j < 8; ++j) { v[j] = xr[64 * j]; s += (v[j].x * v[j].x + v[j].y * v[j].y) + (v[j].z * v[j].z + v[j].w * v[j].w); }
    const float rstd = rsqrtf(wave_sum(s) * (1.f / D) + EPS);
    u32x2* o8 = (u32x2*)orow + lane;
#pragma unroll
    for (int j = 0; j < 8; ++j) { const f32x4 gg = ((const f32x4*)gain)[lane + 64 * j]; u32x2 w; w.x = pk2(v[j].x * rstd * gg.x, v[j].y * rstd * gg.y); w.y = pk2(v[j].z * rstd * gg.z, v[j].w * rstd * gg.w); o8[64 * j] = w; }
}
DI void norm_row_f32(float* xrow, const float* gain, int lane) {
    f32x4* xr = (f32x4*)xrow + lane;
    f32x4 v[8]; float s = 0.f;
#pragma unroll
    for (int j = 0; j < 8; ++j) { v[j] = xr[64 * j]; s += (v[j].x * v[j].x + v[j].y * v[j].y) + (v[j].z * v[j].z + v[j].w * v[j].w); }
    const float rstd = rsqrtf(wave_sum(s) * (1.f / D) + EPS);
#pragma unroll
    for (int j = 0; j < 8; ++j) { const f32x4 gg = ((const f32x4*)gain)[lane + 64 * j]; xr[64 * j] = v[j] * rstd * gg; }
}

DI void feed_row(const float* xrow, bf16_t* orow, float* ssp, int lane) {
    const f32x4* xr = (const f32x4*)xrow + lane;
    f32x4 v[8]; float s = 0.f;
#pragma unroll
    for (int j = 0; j < 8; ++j) { v[j] = xr[64 * j]; s += (v[j].x * v[j].x + v[j].y * v[j].y) + (v[j].z * v[j].z + v[j].w * v[j].w); }
    s = wave_sum(s);
    u32x2* o8 = (u32x2*)orow + lane;
#pragma unroll
    for (int j = 0; j < 8; ++j) { u32x2 w; w.x = pk2(v[j].x, v[j].y); w.y = pk2(v[j].z, v[j].w); o8[64 * j] = w; }
    if (lane == 0) *ssp = s;
}

DI void sample_row_reduce(float* xrow, const float* slab, int nsl, bf16_t* orow, float* ssp, const float* gain, int lane) {
    f32x4* xr = (f32x4*)xrow + lane;
    f32x4 v[8];
#pragma unroll
    for (int j = 0; j < 8; ++j) v[j] = xr[64 * j];
    for (int k = 0; k < nsl; ++k) { const f32x4* sp = (const f32x4*)(slab + (size_t)k * MS * D) + lane;
#pragma unroll
        for (int j = 0; j < 8; ++j) v[j] = v[j] + sp[64 * j]; }
    float s = 0.f;
#pragma unroll
    for (int j = 0; j < 8; ++j) s += (v[j].x * v[j].x + v[j].y * v[j].y) + (v[j].z * v[j].z + v[j].w * v[j].w);
    s = wave_sum(s);
    if (gain) { const float rstd = rsqrtf(s * (1.f / D) + EPS);
#pragma unroll
        for (int j = 0; j < 8; ++j) { const f32x4 gg = ((const f32x4*)gain)[lane + 64 * j]; xr[64 * j] = v[j] * rstd * gg; }
        return; }
    u32x2* o8 = (u32x2*)orow + lane;
#pragma unroll
    for (int j = 0; j < 8; ++j) { xr[64 * j] = v[j]; u32x2 w; w.x = pk2(v[j].x, v[j].y); w.y = pk2(v[j].z, v[j].w); o8[64 * j] = w; }
    if (lane == 0) *ssp = s;
}

DI void attn_load_q(bf16x8 (&qf)[2][4], const bf16_t* Qp, int ldq, int nqg, const float* qgain, int fr, int fq) {
#pragma unroll
    for (int g = 0; g < 2; ++g) {
        if (g < nqg) {
            const bf16_t* qrow = Qp + (size_t)(g * 16 + fr) * ldq + fq * 8;
            float qv[4][8]; float ss = 0.f;
#pragma unroll
            for (int s = 0; s < 4; ++s) { unpack8(*(const u32x4*)(qrow + s * 32), qv[s]);
#pragma unroll
                for (int e = 0; e < 8; ++e) ss += qv[s][e] * qv[s][e]; }
            ss += __shfl_xor(ss, 16); ss += __shfl_xor(ss, 32);
            const float rs = rsqrtf(ss * (1.f / 128.f) + EPS) * (0.08838834764831845f * LOG2E);
#pragma unroll
            for (int s = 0; s < 4; ++s) { const f32x4 g0 = *(const f32x4*)(qgain + s * 32 + fq * 8), g1 = *(const f32x4*)(qgain + s * 32 + fq * 8 + 4);
                float t[8];
#pragma unroll
                for (int e = 0; e < 4; ++e) { t[e] = qv[s][e] * rs * g0[e]; t[4 + e] = qv[s][4 + e] * rs * g1[e]; }
                qf[g][s] = __builtin_bit_cast(bf16x8, pack8(t)); }
        } else {
#pragma unroll
            for (int s = 0; s < 4; ++s) qf[g][s] = (bf16x8){0, 0, 0, 0, 0, 0, 0, 0};
        }
    }
}
template <bool BIAS>
DI void attn_tile(const bf16x8 (&kf)[2][4], const bf16x8 (&vf)[8], const bf16x8 (&qf)[2][4], f32x4 (&o)[2][8], float (&mrun)[2], float (&lrun)[2],
                  int nqg, const LAS float* tbl, int idx0, bool tail, int kpos0, int nvalid) {
    f32x4 st[2][2];
#pragma unroll
    for (int g = 0; g < 2; ++g)
#pragma unroll
        for (int hh = 0; hh < 2; ++hh) { st[g][hh] = (f32x4){0.f, 0.f, 0.f, 0.f};
#pragma unroll
            for (int s = 0; s < 4; ++s) st[g][hh] = __builtin_amdgcn_mfma_f32_16x16x32_bf16(kf[hh][s], qf[g][s], st[g][hh], 0, 0, 0); }
#pragma unroll
    for (int g = 0; g < 2; ++g) {
        if (g < nqg) {
            float sv[8];
#pragma unroll
            for (int e = 0; e < 4; ++e) { sv[e] = st[g][0][e]; sv[4 + e] = st[g][1][e]; }
            if (BIAS) {
#pragma unroll
                for (int e = 0; e < 8; ++e) sv[e] += tbl[idx0 + g * 16 - e]; }
            if (tail) {
#pragma unroll
                for (int e = 0; e < 8; ++e) if (kpos0 + e >= nvalid) sv[e] = -1e30f; }
            float tmax = fmaxf(fmaxf(fmaxf(sv[0], sv[1]), fmaxf(sv[2], sv[3])), fmaxf(fmaxf(sv[4], sv[5]), fmaxf(sv[6], sv[7])));
            tmax = fmaxf(tmax, __shfl_xor(tmax, 16)); tmax = fmaxf(tmax, __shfl_xor(tmax, 32));
            const float mn = fmaxf(mrun[g], tmax), alpha = fast_exp2(mrun[g] - mn); mrun[g] = mn;
            float pv[8], ps = 0.f;
#pragma unroll
            for (int e = 0; e < 8; ++e) { pv[e] = fast_exp2(sv[e] - mn); ps += pv[e]; }
            lrun[g] = lrun[g] * alpha + ps;
            const bf16x8 pf = __builtin_bit_cast(bf16x8, pack8(pv));
#pragma unroll
            for (int dt = 0; dt < 8; ++dt) { o[g][dt] = o[g][dt] * alpha; o[g][dt] = __builtin_amdgcn_mfma_f32_16x16x32_bf16(vf[dt], pf, o[g][dt], 0, 0, 0); }
        }
    }
}
DI void attn_store_o(const f32x4 (&o)[2][8], const float (&lrun)[2], bf16_t* Op, int ldo, int nqg, int fr, int fq) {
#pragma unroll
    for (int g = 0; g < 2; ++g) {
        if (g < nqg) {
            float lt = lrun[g]; lt += __shfl_xor(lt, 16); lt += __shfl_xor(lt, 32);
            const float inv = 1.0f / lt;
            bf16_t* orow = Op + (size_t)(g * 16 + fr) * ldo + fq * 4;
#pragma unroll
            for (int dt = 0; dt < 8; ++dt) { u32x2 w; w.x = pk2(o[g][dt][0] * inv, o[g][dt][1] * inv); w.y = pk2(o[g][dt][2] * inv, o[g][dt][3] * inv); *(u32x2*)(orow + dt * 16) = w; }
        }
    }
}
template <bool BIAS>
DI void attn_task(const bf16_t* Qp, int ldq, bf16_t* Op, int ldo, const bf16_t* Kp, int ldk, const bf16_t* Vtp, int ldv,
                  int nkt, int nvalid, int nqg, const float* qgain, const LAS float* tbl, int dbase, int lane) {
    const int fr = lane & 15, fq = lane >> 4;
    bf16x8 qf[2][4];
    attn_load_q(qf, Qp, ldq, nqg, qgain, fr, fq);
    f32x4 o[2][8];
#pragma unroll
    for (int g = 0; g < 2; ++g)
#pragma unroll
        for (int dt = 0; dt < 8; ++dt) o[g][dt] = (f32x4){0.f, 0.f, 0.f, 0.f};
    float mrun[2] = {-1e30f, -1e30f}, lrun[2] = {0.f, 0.f};
    const bf16_t* kb0 = Kp + (size_t)((fr >> 2) * 8 + (fr & 3)) * ldk + fq * 8;
    const bf16_t* vb0 = Vtp + (size_t)fr * ldv + fq * 8;
#pragma unroll 1
    for (int kt = 0; kt < nkt; ++kt) {
        const bf16_t* kb = kb0 + (size_t)kt * 32 * ldk;
        bf16x8 kf[2][4];
#pragma unroll
        for (int hh = 0; hh < 2; ++hh)
#pragma unroll
            for (int s = 0; s < 4; ++s) kf[hh][s] = *(const bf16x8*)(kb + (size_t)hh * 4 * ldk + s * 32);
        bf16x8 vf[8];
#pragma unroll
        for (int dt = 0; dt < 8; ++dt) vf[dt] = *(const bf16x8*)(vb0 + (size_t)dt * 16 * ldv + kt * 32);
        attn_tile<BIAS>(kf, vf, qf, o, mrun, lrun, nqg, tbl, dbase + fr - kt * 32 - fq * 8, kt * 32 + 32 > nvalid, kt * 32 + fq * 8, nvalid);
    }
    attn_store_o(o, lrun, Op, ldo, nqg, fr, fq);
}
constexpr int AT_TBL = 0, AT_K = 4096, AT_KB = 32 * 272, AT_V = AT_K + 2 * AT_KB, AT_VB = 128 * 80;
DI void attn_wg_prompt(const Params& p, LAS unsigned char* lds, int b, int h, int cg, bf16_t* obase, int ldo, int ocol, int tid) {
    const int lane = tid & 63, wave = __builtin_amdgcn_readfirstlane(tid >> 6), fr = lane & 15, fq = lane >> 4;
    const int c = cg * 4 + (wave >> 1), half = wave & 1;
    const bf16_t* Ub = (const bf16_t*)(p.ws + W_U); const bf16_t* Vtg = (const bf16_t*)(p.ws + W_VT);
    LAS float* tbl = (LAS float*)(lds + AT_TBL);
    __syncthreads();
    for (int i = tid; i < 640; i += NWAVES * 64) { int d = i - 63; d = d < -256 ? -256 : (d > 256 ? 256 : d); tbl[i] = p.in[17][h * 513 + d + 256] * LOG2E; }
    const size_t qrow0 = (size_t)b * TSEQ + c * 64 + half * 32;
    bf16x8 qf[2][4];
    attn_load_q(qf, Ub + qrow0 * NU + OQ + h * 128, NU, 2, p.in[15], fr, fq);
    f32x4 o[2][8];
#pragma unroll
    for (int g = 0; g < 2; ++g)
#pragma unroll
        for (int dt = 0; dt < 8; ++dt) o[g][dt] = (f32x4){0.f, 0.f, 0.f, 0.f};
    float mrun[2] = {-1e30f, -1e30f}, lrun[2] = {0.f, 0.f};
    const int key_lo = (cg * 4 - 8) * 64 > 0 ? (cg * 4 - 8) * 64 : 0, nkt = ((cg * 4 + 4) * 64 - key_lo) / 32;
    const bf16_t* kg = Ub + ((size_t)b * TSEQ + key_lo + (tid >> 4)) * NU + OKK + h * 128 + (tid & 15) * 8;
    const bf16_t* vg = Vtg + ((size_t)(b * 8 + h) * 128 + (tid >> 2)) * TSEQ + key_lo + (tid & 3) * 8;
    const unsigned kw = (unsigned)(tid >> 4) * 272u + (unsigned)(tid & 15) * 16u, vw = (unsigned)(tid >> 2) * 80u + (unsigned)(tid & 3) * 16u;
    const unsigned kroff = (unsigned)((fr >> 2) * 8 + (fr & 3)) * 272u + (unsigned)fq * 16u, vroff = (unsigned)fr * 80u + (unsigned)fq * 16u;
    const int dbase = c * 64 + half * 32 - key_lo + 63;
    const f32x4 kg0 = *(const f32x4*)(p.in[16] + (tid & 15) * 8), kg1 = *(const f32x4*)(p.in[16] + (tid & 15) * 8 + 4);
    u32x4 kr = *(const u32x4*)kg, vr = *(const u32x4*)vg;
#pragma unroll 1
    for (int kt = 0; kt < nkt; ++kt) {
        const int buf = kt & 1;
        {
            float kv[8]; unpack8(kr, kv);
            float ssq = 0.f;
#pragma unroll
            for (int e = 0; e < 8; ++e) ssq += kv[e] * kv[e];
            ssq += __shfl_xor(ssq, 1); ssq += __shfl_xor(ssq, 2); ssq += __shfl_xor(ssq, 4); ssq += __shfl_xor(ssq, 8);
            const float rk = rsqrtf(ssq * (1.f / 128.f) + EPS);
#pragma unroll
            for (int e = 0; e < 4; ++e) { kv[e] *= rk * kg0[e]; kv[4 + e] *= rk * kg1[e]; }
            *(LAS u32x4*)(lds + AT_K + buf * AT_KB + kw) = pack8(kv);
        }
        *(LAS u32x4*)(lds + AT_V + buf * AT_VB + vw) = vr;
        if (kt + 1 < nkt) { kr = *(const u32x4*)(kg + (size_t)(kt + 1) * 32 * NU); vr = *(const u32x4*)(vg + (kt + 1) * 32); }
        __syncthreads();
        const int kc = (key_lo + kt * 32) >> 6;
        if (kc >= c - 8 && kc <= c) {
            bf16x8 kf[2][4], vf[8];
#pragma unroll
            for (int hh = 0; hh < 2; ++hh)
#pragma unroll
                for (int s = 0; s < 4; ++s) kf[hh][s] = *(const LAS bf16x8*)(lds + AT_K + buf * AT_KB + kroff + hh * (4 * 272) + s * 64);
#pragma unroll
            for (int dt = 0; dt < 8; ++dt) vf[dt] = *(const LAS bf16x8*)(lds + AT_V + buf * AT_VB + vroff + dt * (16 * 80));
            attn_tile<true>(kf, vf, qf, o, mrun, lrun, 2, tbl, dbase + fr - kt * 32 - fq * 8, false, 0, 0);
        }
    }
    attn_store_o(o, lrun, obase + qrow0 * ldo + ocol + h * 128, ldo, 2, fr, fq);
}

DI void attn_wg_mem(const Params& p, LAS unsigned char* lds, int seq, int h, int rg, int tid) {
    const int lane = tid & 63, wave = __builtin_amdgcn_readfirstlane(tid >> 6), fr = lane & 15, fq = lane >> 4;
    bf16_t* MQb = (bf16_t*)(p.ws + W_MQB); const bf16_t* Kmb = (const bf16_t*)(p.ws + W_KM); const bf16_t* Vtmb = (const bf16_t*)(p.ws + W_VTM);
    __syncthreads();
    bf16_t* qp = MQb + ((size_t)seq * TSEQ + rg * 256 + wave * 32) * 512 + h * 128;
    bf16x8 qf[2][4];
    attn_load_q(qf, qp, 512, 2, p.in[33], fr, fq);
    f32x4 o[2][8];
#pragma unroll
    for (int g = 0; g < 2; ++g)
#pragma unroll
        for (int dt = 0; dt < 8; ++dt) o[g][dt] = (f32x4){0.f, 0.f, 0.f, 0.f};
    float mrun[2] = {-1e30f, -1e30f}, lrun[2] = {0.f, 0.f};
    const bf16_t* kg = Kmb + ((size_t)seq * 256 + (tid >> 4)) * 512 + h * 128 + (tid & 15) * 8;
    const bf16_t* vg = Vtmb + ((size_t)(seq * 4 + h) * 128 + (tid >> 2)) * 256 + (tid & 3) * 8;
    const unsigned kw = (unsigned)(tid >> 4) * 272u + (unsigned)(tid & 15) * 16u, vw = (unsigned)(tid >> 2) * 80u + (unsigned)(tid & 3) * 16u;
    const unsigned kroff = (unsigned)((fr >> 2) * 8 + (fr & 3)) * 272u + (unsigned)fq * 16u, vroff = (unsigned)fr * 80u + (unsigned)fq * 16u;
    u32x4 kr = *(const u32x4*)kg, vr = *(const u32x4*)vg;
#pragma unroll 1
    for (int kt = 0; kt < 8; ++kt) {
        const int buf = kt & 1;
        *(LAS u32x4*)(lds + AT_K + buf * AT_KB + kw) = kr; *(LAS u32x4*)(lds + AT_V + buf * AT_VB + vw) = vr;
        if (kt + 1 < 8) { kr = *(const u32x4*)(kg + (size_t)(kt + 1) * 32 * 512); vr = *(const u32x4*)(vg + (kt + 1) * 32); }
        __syncthreads();
        bf16x8 kf[2][4], vf[8];
#pragma unroll
        for (int hh = 0; hh < 2; ++hh)
#pragma unroll
            for (int s = 0; s < 4; ++s) kf[hh][s] = *(const LAS bf16x8*)(lds + AT_K + buf * AT_KB + kroff + hh * (4 * 272) + s * 64);
#pragma unroll
        for (int dt = 0; dt < 8; ++dt) vf[dt] = *(const LAS bf16x8*)(lds + AT_V + buf * AT_VB + vroff + dt * (16 * 80));
        attn_tile<false>(kf, vf, qf, o, mrun, lrun, 2, nullptr, 0, false, 0, 0);
    }
    attn_store_o(o, lrun, qp, 512, 2, fr, fq);
}

constexpr int LT_OFF = 98304, LT_WG = 64 * 144, LT_PAR = 2 * LT_WG;
DI void lru_tables_to_lds(const Params& p, LAS unsigned char* lt, int nblk, int tid) {
    const bf16_t* Wt = (const bf16_t*)(p.ws + W_LRU);
    for (int i = tid; i < 2 * 64 * 8; i += NWAVES * 64) { const int g = i >> 9, row = (i >> 3) & 63, seg = i & 7;
        *(LAS u32x4*)(lt + g * LT_WG + row * 144 + seg * 16) = *(const u32x4*)(Wt + (size_t)g * 65536 + (size_t)(nblk * 64 + row) * 64 + seg * 8); }
    for (int i = tid; i < 512; i += NWAVES * 64) { const int k = i >> 6, ch = nblk * 64 + (i & 63);
        const float v = k < 4 ? p.in[18][k * 1024 + ch] : (k == 4 ? p.in[19][ch] : (k == 5 ? p.in[21][ch] : (k == 6 ? p.in[23][ch] : ((const float*)(p.ws + W_C8))[ch])));
        ((LAS float*)(lt + LT_PAR))[i] = v; }
    __syncthreads();
}
template <int PASS>
DI void lru_unit(const Params& p, int seq, int chunk, int nblk, int lane, bf16_t* obase, unsigned opitch, unsigned ocol, const LAS unsigned char* lt) {
    unsigned char* ws = p.ws;
    const char* Ub = (const char*)(ws + W_U);
    const LAS float* par = (const LAS float*)(lt + LT_PAR);
    float* cA = (float*)(ws + W_CA); float* cB = (float*)(ws + W_CB);
    const bool is_s = seq >= NBATCH;
    const int sb = seq - NBATCH;
    const unsigned row0 = is_s ? (unsigned)MP + (unsigned)sb * STOK : (unsigned)seq * TSEQ;
    const int t0 = is_s ? 0 : chunk * 64, ntt = is_s ? 1 : 4;
    float hc[2][8], arun[2][8];
#pragma unroll
    for (int ks = 0; ks < 2; ++ks)
#pragma unroll
        for (int e = 0; e < 8; ++e) { hc[ks][e] = 0.f; arun[ks][e] = 1.f; }
    if (PASS == 1) {
        float H;
        if (is_s) H = p.in[5][(size_t)sb * 1024 + nblk * 64 + lane];
        else { H = 0.f;
            const float* pa = cA + (size_t)seq * 64 * 1024 + nblk * 64 + lane; const float* pb = cB + (size_t)seq * 64 * 1024 + nblk * 64 + lane;
            for (int c2 = 0; c2 < chunk; c2 += 8) {
                float ta[8], tb[8];
#pragma unroll
                for (int j = 0; j < 8; ++j) { const int cc = (c2 + j < chunk) ? c2 + j : chunk - 1; ta[j] = pa[(size_t)cc * 1024]; tb[j] = pb[(size_t)cc * 1024]; }
#pragma unroll
                for (int j = 0; j < 8; ++j) if (c2 + j < chunk) H = ta[j] * H + tb[j];
            } }
        const int fq0 = lane >> 4;
#pragma unroll
        for (int ks = 0; ks < 2; ++ks)
#pragma unroll
            for (int e = 0; e < 8; ++e) hc[ks][e] = __shfl(H, ks * 32 + fq0 * 8 + e);
    }
#pragma unroll 1
    for (int tt = 0; tt < ntt; ++tt) {
        int lo = lane; asm volatile("" : "+v"(lo) :: "memory");
        const int fr = lo & 15, fq = lo >> 4;
        const int t = t0 + tt * 16 + fr;
        const unsigned chb0 = (unsigned)(nblk * 64 + fq * 8);
        float xc[2][8]; bf16x8 xf[2];
#pragma unroll
        for (int ks = 0; ks < 2; ++ks) {
            const unsigned chb = chb0 + ks * 32;
            const int chl = ks * 32 + fq * 8;
            const f32x4 b0 = *(const LAS f32x4*)(par + 4 * 64 + chl), b1 = *(const LAS f32x4*)(par + 4 * 64 + chl + 4);
#pragma unroll
            for (int e = 0; e < 4; ++e) { xc[ks][e] = b0[e]; xc[ks][4 + e] = b1[e]; }
#pragma unroll
            for (int j = 0; j < 4; ++j) {
                const int tj = t - 3 + j;
                float xv[8];
                if (tj >= 0) unpack8(*(const u32x4*)(Ub + ((row0 + (unsigned)tj) * (unsigned)NU + OXR + chb) * 2u), xv);
                else if (is_s) { const char* sp = (const char*)p.in[4] + (((unsigned)sb * 3u + (unsigned)(3 + tj)) * 1024u + chb) * 4u; const f32x4 s0 = *(const f32x4*)sp, s1 = *(const f32x4*)(sp + 16);
#pragma unroll
                    for (int e = 0; e < 4; ++e) { xv[e] = s0[e]; xv[4 + e] = s1[e]; } }
                else {
#pragma unroll
                    for (int e = 0; e < 8; ++e) xv[e] = 0.f; }
                const f32x4 w0 = *(const LAS f32x4*)(par + j * 64 + chl), w1 = *(const LAS f32x4*)(par + j * 64 + chl + 4);
#pragma unroll
                for (int e = 0; e < 4; ++e) { xc[ks][e] += w0[e] * xv[e]; xc[ks][4 + e] += w1[e] * xv[4 + e]; }
            }
            xf[ks] = __builtin_bit_cast(bf16x8, pack8(xc[ks]));
        }
        float av[2][8], bv[2][8];
        const unsigned wbase = (unsigned)((fr >> 2) * 8 + (fr & 3)) * 144u + (unsigned)fq * 16u;
#pragma unroll
        for (int ct = 0; ct < 4; ++ct) {
            const int ks = ct >> 1, hq = ct & 1;
            const unsigned woff = wbase + (unsigned)((ks * 32 + hq * 4) * 144);
            f32x4 aa = (f32x4){0.f, 0.f, 0.f, 0.f}, ax = (f32x4){0.f, 0.f, 0.f, 0.f};
#pragma unroll
            for (int k2 = 0; k2 < 2; ++k2) {
                const bf16x8 wa = *(const LAS bf16x8*)(lt + woff + k2 * 64u), wx = *(const LAS bf16x8*)(lt + LT_WG + woff + k2 * 64u);
                aa = __builtin_amdgcn_mfma_f32_16x16x32_bf16(wa, xf[k2], aa, 0, 0, 0);
                ax = __builtin_amdgcn_mfma_f32_16x16x32_bf16(wx, xf[k2], ax, 0, 0, 0); }
            const int chq = ks * 32 + fq * 8 + hq * 4;
            const f32x4 ba4 = *(const LAS f32x4*)(par + 5 * 64 + chq), bx4 = *(const LAS f32x4*)(par + 6 * 64 + chq), c84 = *(const LAS f32x4*)(par + 7 * 64 + chq);
#pragma unroll
            for (int j = 0; j < 4; ++j) {
                const int e = hq * 4 + j;
                const float r = sigmoidf_(aa[j] + ba4[j]), ig = sigmoidf_(ax[j] + bx4[j]);
                const float a = fast_exp2(c84[j] * r);
                av[ks][e] = a; bv[ks][e] = sqrtf(fmaxf(1.0f - a * a, 0.f)) * ig * xc[ks][e];
            }
        }
#pragma unroll
        for (int ks = 0; ks < 2; ++ks)
#pragma unroll
            for (int e = 0; e < 8; ++e) {
                float a = av[ks][e], b = bv[ks][e], pa, pb;
                pa = dpp_shr<1>(1.f, a); pb = dpp_shr<1>(0.f, b); b = a * pb + b; a = a * pa;
                pa = dpp_shr<2>(1.f, a); pb = dpp_shr<2>(0.f, b); b = a * pb + b; a = a * pa;
                pa = dpp_shr<4>(1.f, a); pb = dpp_shr<4>(0.f, b); b = a * pb + b; a = a * pa;
                pa = dpp_shr<8>(1.f, a); pb = dpp_shr<8>(0.f, b); b = a * pb + b; a = a * pa;
                const float h = a * hc[ks][e] + b;
                bv[ks][e] = h; av[ks][e] = a;
            }
        const int l15 = (lo & 48) | 15;
        if (PASS == 1) {
#pragma unroll
            for (int ks = 0; ks < 2; ++ks) {
                const unsigned chb = chb0 + ks * 32;
                const char* gp = Ub + ((row0 + (unsigned)t) * (unsigned)NU + OGR + chb) * 2u;
                char* op = (char*)obase + ((row0 + (unsigned)t) * opitch + ocol + chb) * 2u;
                float gv[8], ov[8]; unpack8(*(const u32x4*)gp, gv);
#pragma unroll
                for (int e = 0; e < 8; ++e) { const float x = gv[e]; const float u2 = 1.5957691216057308f * (x + 0.044715f * x * x * x); ov[e] = x * fast_rcp(1.0f + fast_exp2(-u2 * LOG2E)) * bv[ks][e]; }
                *(u32x4*)op = pack8(ov);
                if (fr == 15 && tt == ntt - 1 && (is_s || chunk == 63)) {
                    float* lo2 = p.out + (is_s ? O_LS + (size_t)sb * 1024 : O_LP + (size_t)seq * 1024) + chb;
                    *(f32x4*)lo2 = (f32x4){bv[ks][0], bv[ks][1], bv[ks][2], bv[ks][3]}; *(f32x4*)(lo2 + 4) = (f32x4){bv[ks][4], bv[ks][5], bv[ks][6], bv[ks][7]};
                }
#pragma unroll
                for (int e = 0; e < 8; ++e) hc[ks][e] = __shfl(bv[ks][e], l15);
            }
        } else {
#pragma unroll
            for (int ks = 0; ks < 2; ++ks)
#pragma unroll
                for (int e = 0; e < 8; ++e) { hc[ks][e] = __shfl(bv[ks][e], l15); arun[ks][e] *= __shfl(av[ks][e], l15); }
        }
    }
    if (PASS == 0 && (lane & 15) == 0) {
        const int fq = lane >> 4;
#pragma unroll
        for (int ks = 0; ks < 2; ++ks) { const size_t o = ((size_t)seq * 64 + chunk) * 1024 + nblk * 64 + ks * 32 + fq * 8;
            *(f32x4*)(cA + o) = (f32x4){arun[ks][0], arun[ks][1], arun[ks][2], arun[ks][3]}; *(f32x4*)(cA + o + 4) = (f32x4){arun[ks][4], arun[ks][5], arun[ks][6], arun[ks][7]};
            *(f32x4*)(cB + o) = (f32x4){hc[ks][0], hc[ks][1], hc[ks][2], hc[ks][3]}; *(f32x4*)(cB + o + 4) = (f32x4){hc[ks][4], hc[ks][5], hc[ks][6], hc[ks][7]}; }
    }
}


DI void sample_cache_tasks(const Params& p, int first, int stride, int lane) {
    constexpr int T_KS = SBATCH * 512, T_VTS = SBATCH * 8 * 8;
    bf16_t* Ks = (bf16_t*)(p.ws + W_KS); bf16_t* Vts = (bf16_t*)(p.ws + W_VTS);
        for (int r = first; r < T_KS; r += stride) {
                const int b = r >> 9, j = r & 511;
                const float* src = p.in[2] + (size_t)r * 1024 + lane * 16;
                float t0[8], t1[8];
                { const f32x4 a = *(const f32x4*)src, c = *(const f32x4*)(src + 4), d = *(const f32x4*)(src + 8), e = *(const f32x4*)(src + 12);
                  t0[0] = a.x; t0[1] = a.y; t0[2] = a.z; t0[3] = a.w; t0[4] = c.x; t0[5] = c.y; t0[6] = c.z; t0[7] = c.w;
                  t1[0] = d.x; t1[1] = d.y; t1[2] = d.z; t1[3] = d.w; t1[4] = e.x; t1[5] = e.y; t1[6] = e.z; t1[7] = e.w; }
                bf16_t* kd = Ks + ((size_t)b * SKEYS + j) * 1024 + lane * 16;
                *(u32x4*)kd = pack8(t0); *(u32x4*)(kd + 8) = pack8(t1);


        }
        for (int r = first; r < T_VTS; r += stride) {
                const int b = r >> 6, h = (r >> 3) & 7, jg = r & 7, j = jg * 64 + lane;
                const float* src = p.in[3] + (((size_t)b * 512 + j) * 8 + h) * 128;
                bf16_t* dst = Vts + ((size_t)(b * 8 + h) * 128) * SKEYS + j;
#pragma unroll 4
                for (int dc = 0; dc < 32; ++dc) { const f32x4 v = *(const f32x4*)(src + dc * 4);
                    dst[(size_t)(dc * 4 + 0) * SKEYS] = (bf16_t)pk2(v.x, 0.f); dst[(size_t)(dc * 4 + 1) * SKEYS] = (bf16_t)pk2(v.y, 0.f);
                    dst[(size_t)(dc * 4 + 2) * SKEYS] = (bf16_t)pk2(v.z, 0.f); dst[(size_t)(dc * 4 + 3) * SKEYS] = (bf16_t)pk2(v.w, 0.f); }
                if (jg == 7 && lane < 16) { bf16_t* pz = Vts + ((size_t)(b * 8 + h) * 128) * SKEYS + 528 + lane;
                    for (int d = 0; d < 128; ++d) pz[(size_t)d * SKEYS] = 0; }


        }
}

DI void mem_tasks(const Params& p, int first, int stride, int lane) {
    const float* MKVF = (const float*)(p.ws + W_MKVF); bf16_t* Km = (bf16_t*)(p.ws + W_KM); bf16_t* Vtm = (bf16_t*)(p.ws + W_VTM);
        for (int r = first; r < 2048; r += stride) {
            const float* src = MKVF + (size_t)r * 1024 + lane * 8;
            const f32x4 k0 = *(const f32x4*)src, k1 = *(const f32x4*)(src + 4), v0 = *(const f32x4*)(src + 512), v1 = *(const f32x4*)(src + 516);
            float ss = (k0.x * k0.x + k0.y * k0.y + k0.z * k0.z + k0.w * k0.w) + (k1.x * k1.x + k1.y * k1.y + k1.z * k1.z + k1.w * k1.w);
            ss += __shfl_xor(ss, 1); ss += __shfl_xor(ss, 2); ss += __shfl_xor(ss, 4); ss += __shfl_xor(ss, 8);
            const float rs = rsqrtf(ss * (1.f / 128.f) + EPS);
            const f32x4 g0 = *(const f32x4*)(p.in[34] + (lane * 8) % 128), g1 = *(const f32x4*)(p.in[34] + (lane * 8) % 128 + 4);
            const f32x4 n0 = k0 * rs * g0, n1 = k1 * rs * g1;
            float* ko = p.out + O_MK + (size_t)r * 512 + lane * 8; *(f32x4*)ko = n0; *(f32x4*)(ko + 4) = n1;
            float* vo = p.out + O_MV + (size_t)r * 512 + lane * 8; *(f32x4*)vo = v0; *(f32x4*)(vo + 4) = v1;
            u32x4 w; w.x = pk2(n0.x, n0.y); w.y = pk2(n0.z, n0.w); w.z = pk2(n1.x, n1.y); w.w = pk2(n1.z, n1.w);
            *(u32x4*)(Km + (size_t)r * 512 + lane * 8) = w;
        }
        for (int r = first; r < SBATCH * 256; r += stride) {
            const float* src = p.in[6] + (size_t)r * 512 + lane * 8; const f32x4 k0 = *(const f32x4*)src, k1 = *(const f32x4*)(src + 4);
            u32x4 w; w.x = pk2(k0.x, k0.y); w.y = pk2(k0.z, k0.w); w.z = pk2(k1.x, k1.y); w.w = pk2(k1.z, k1.w);
            *(u32x4*)(Km + ((size_t)NBATCH * 256 + r) * 512 + lane * 8) = w;
        }
        for (int it = first; it < NSEQ * 4 * 4; it += stride) {
            const int seq = it >> 4, h = (it >> 2) & 3, j = (it & 3) * 64 + lane;
            const float* src = seq < NBATCH ? MKVF + ((size_t)seq * 256 + j) * 1024 + 512 + h * 128 : p.in[7] + (((size_t)(seq - NBATCH) * 256 + j) * 4 + h) * 128;
            bf16_t* dst = Vtm + ((size_t)(seq * 4 + h) * 128) * 256 + j;
#pragma unroll 4
            for (int dc = 0; dc < 32; ++dc) { const f32x4 v = *(const f32x4*)(src + dc * 4);
                dst[(size_t)(dc * 4 + 0) * 256] = (bf16_t)(pk2(v.x, 0.f)); dst[(size_t)(dc * 4 + 1) * 256] = (bf16_t)(pk2(v.y, 0.f));
                dst[(size_t)(dc * 4 + 2) * 256] = (bf16_t)(pk2(v.z, 0.f)); dst[(size_t)(dc * 4 + 3) * 256] = (bf16_t)(pk2(v.w, 0.f)); }
        }
}

#define XB_TMO      128
#define XB_XCNT(j)  (256  + 64 * (j))
#define XB_XSUB(j)  (1280 + 64 * (j))
#define XB_XGEN(j)  (2304 + 64 * (j))
#define XB_TOP      3328
#define XB_TOPGEN   3392
#define XCD_BAR_WORDS 3456
#define XB_SPIN_CAP (1u << 18)
DI unsigned xb_ld(unsigned* p)              { return __hip_atomic_load(p, __ATOMIC_RELAXED, __HIP_MEMORY_SCOPE_AGENT); }
DI unsigned xb_add(unsigned* p, unsigned v) { return __hip_atomic_fetch_add(p, v, __ATOMIC_RELAXED, __HIP_MEMORY_SCOPE_AGENT); }
DI unsigned xb_xcc_id() { return (unsigned)__builtin_amdgcn_s_getreg((3 << 11) | 20) & 0xFu; }
#define XB_SPIN(cond, bar) do { unsigned _sp = 0; while (cond) { __builtin_amdgcn_s_sleep(1); \
    if ((++_sp & 255u) == 0u) { if (xb_ld(&(bar)[XB_TMO])) break; if (_sp > XB_SPIN_CAP) { atomicAdd(&(bar)[XB_TMO], 1u); break; } } } } while (0)
struct XcdBarrier { unsigned* bar; unsigned x; volatile LAS unsigned* st; };
DI XcdBarrier xcd_barrier_post(unsigned* bar, volatile LAS unsigned* st) {
    XcdBarrier b; b.bar = bar; b.x = xb_xcc_id(); b.st = st;
    if (threadIdx.x == 0) (void)xb_add(&bar[XB_XCNT(b.x)], 1u);
    return b;
}
DI void xcd_barrier_complete(unsigned* bar, unsigned x, unsigned& nloc, unsigned& nx) {
    const unsigned G = gridDim.x * gridDim.y * gridDim.z;
    unsigned sum, cnt, mine, sp = 0u;
    for (;;) {
        sum = 0u; cnt = 0u; mine = 0u;
#pragma unroll
        for (unsigned j = 0; j < 16; ++j) { const unsigned c = xb_ld(&bar[XB_XCNT(j)]); sum += c; cnt += (c > 0u) ? 1u : 0u; mine = (j == x) ? c : mine; }
        if (sum == G) break;
        __builtin_amdgcn_s_sleep(1);
        if ((++sp & 255u) == 0u) { if (xb_ld(&bar[XB_TMO])) break; if (sp > XB_SPIN_CAP) { atomicAdd(&bar[XB_TMO], 1u); break; } }
    }
    nloc = mine > 0u ? mine : 1u; nx = cnt > 0u ? cnt : 1u;
}
DI void xcd_barrier(const XcdBarrier& b) {
    asm volatile("s_waitcnt vmcnt(0)" ::: "memory");
    __syncthreads();
    if (threadIdx.x == 0) {
        unsigned* bar = b.bar;
        __builtin_amdgcn_s_waitcnt(0);
        unsigned nloc = b.st[0], nx = b.st[1];
        if (nloc == 0u) { xcd_barrier_complete(bar, b.x, nloc, nx); b.st[0] = nloc; b.st[1] = nx; }
        const unsigned old = xb_add(&bar[XB_XSUB(b.x)], 1u);
        const unsigned gen = old / nloc;
        if (old + 1u == (gen + 1u) * nloc) {
            __builtin_amdgcn_fence(__ATOMIC_RELEASE, "agent");
            asm volatile("s_waitcnt vmcnt(0)" ::: "memory");
            const unsigned og = xb_add(&bar[XB_TOP], 1u);
            const unsigned tg = og / nx;
            if (og + 1u == (tg + 1u) * nx) xb_add(&bar[XB_TOPGEN], 1u);
            else XB_SPIN(xb_ld(&bar[XB_TOPGEN]) == tg, bar);
            __builtin_amdgcn_fence(__ATOMIC_ACQUIRE, "agent");
            xb_add(&bar[XB_XGEN(b.x)], 1u);
            asm volatile("s_waitcnt vmcnt(0)" ::: "memory");
        } else {
            XB_SPIN(xb_ld(&bar[XB_XGEN(b.x)]) == gen, bar);
            __builtin_amdgcn_fence(__ATOMIC_ACQUIRE, "agent");
            asm volatile("s_waitcnt vmcnt(0)" ::: "memory");
        }
    }
    __syncthreads();
}

__global__ void __launch_bounds__(NWAVES * 64, 2) fwd_megakernel(Params p) {
    extern __shared__ __attribute__((aligned(16))) unsigned char lds_raw[];
    cg::grid_group grid = cg::this_grid();
    LAS unsigned char* lds = (LAS unsigned char*)lds_raw;
#define PH_IDS int tid = threadIdx.x; asm volatile("" : "+v"(tid)); const int lane = tid & 63, wave = __builtin_amdgcn_readfirstlane(tid >> 6); \
    const int G = gridDim.x, gw = blockIdx.x * NWAVES + wave, NGW = G * NWAVES; (void)lane; (void)gw; (void)NGW; (void)G
    unsigned char* ws = p.ws;
    float* R = p.out;
    bf16_t* XN = (bf16_t*)(ws + W_XN); bf16_t* U = (bf16_t*)(ws + W_U); bf16_t* H = (bf16_t*)(ws + W_H);
    bf16_t* Vt = (bf16_t*)(ws + W_VT); bf16_t* Ks = (bf16_t*)(ws + W_KS); bf16_t* Vts = (bf16_t*)(ws + W_VTS);
    bf16_t* Km = (bf16_t*)(ws + W_KM); bf16_t* Vtm = (bf16_t*)(ws + W_VTM);
    bf16_t* MN = (bf16_t*)(ws + W_MN); float* MKVF = (float*)(ws + W_MKVF); bf16_t* MQ = (bf16_t*)(ws + W_MQB);

    for (int rep_ = 0; rep_ < 1 + ((REPM >> 0) & 1); ++rep_) { if (rep_) grid.sync(); PH_IDS;
        if (blockIdx.x == 0) for (int i = tid; i < 4096; i += NWAVES * 64) ((unsigned*)(ws + W_BAR))[i] = 0u;
        if (tid < 2) ((volatile LAS unsigned*)(lds + 131072 + 64))[tid] = 0u;
        LAS float* scr = (LAS float*)(lds + wave * 16384);
        constexpr int I_FU = (D / 64) * (FF / 32), I_FD = (FF / 64) * (D / 32), I_IN = (D / 64) * (NU / 32), I_P = (1024 / 64) * (D / 32), I_O = (D / 64) * (D / 32),
                      I_M = (D / 64) * (512 / 32), I_MO = (512 / 64) * (D / 32);
        constexpr int NITEMS = 4 * I_FU + 2 * I_FD + I_IN + 2 * I_P + I_O + 3 * I_M + I_MO;
        for (int it = gw; it < NITEMS; it += NGW) {
            int r = it;
#define TJ(IDX, KK, NN, OFF, SH, ADD, NI, GN) if (r < (NI)) { transpose_item(p.in[IDX], KK, NN, (bf16_t*)(ws + (OFF)), SH, ADD, scr, r, lane, GN); continue; } r -= (NI);
            TJ(10, D, FF, W_GU1, 8, 0, I_FU, nullptr) TJ(11, D, FF, W_GU1, 8, 128, I_FU, nullptr) TJ(12, FF, D, W_D1, 7, 0, I_FD, nullptr)
            TJ(37, D, FF, W_GU2, 8, 0, I_FU, p.in[36]) TJ(38, D, FF, W_GU2, 8, 128, I_FU, p.in[36]) TJ(39, FF, D, W_D2, 7, 0, I_FD, nullptr)
            TJ(14, D, NU, W_IN, 7, 0, I_IN, p.in[13]) TJ(25, 1024, D, W_PA, 7, 0, I_P, nullptr) TJ(26, 1024, D, W_PB, 7, 0, I_P, nullptr) TJ(27, D, D, W_OUT, 7, 0, I_O, nullptr)
            TJ(30, D, 512, W_MQ, 7, 0, I_M, p.in[28]) TJ(31, D, 512, W_MKV, 7, 0, I_M, nullptr) TJ(32, D, 512, W_MKV, 7, 512, I_M, nullptr)
            transpose_item(p.in[35], 512, D, (bf16_t*)(ws + W_MO), 7, 0, scr, r, lane, nullptr);
#undef TJ
        }
        for (int m = gw; m < MT; m += NGW) norm_row_bf16(m < MP ? p.in[0] + (size_t)m * D : p.in[1] + (size_t)(m - MP) * D, p.in[9], XN + (size_t)m * D, lane);
        for (int m = gw; m < 2048; m += NGW) norm_row_bf16(p.in[8] + (size_t)m * D, p.in[29], MN + (size_t)m * D, lane);
        {
            bf16_t* Wt = (bf16_t*)(ws + W_LRU); float* c8 = (float*)(ws + W_C8);
            for (int i = blockIdx.x * 512 + tid; i < 2 * 65536; i += G * 512) { const int gsel = i >> 16, n = (i >> 12) & 15, c = (i >> 6) & 63, k = i & 63;
                const float v = p.in[gsel ? 22 : 20][n * 4096 + k * 64 + c]; Wt[i] = (bf16_t)(pk2(v, 0.f) & 0xffffu); }
            for (int i = blockIdx.x * 512 + tid; i < 1024; i += G * 512) c8[i] = -8.0f * log1pf(expf(-p.in[24][i])) * LOG2E;
            float* ssz = (float*)(ws + W_SS);
            for (int i = blockIdx.x * 512 + tid; i < 3 * MT; i += G * 512) ssz[i] = 0.f;
            for (int i = blockIdx.x * 512 + tid; i < MS * D / 4; i += G * 512) ((f32x4*)(R + (size_t)MP * D))[i] = ((const f32x4*)p.in[1])[i];
        }
    }
    grid.sync();
    XcdBarrier xbar = xcd_barrier_post((unsigned*)(p.ws + W_BAR), (volatile LAS unsigned*)(lds + 131072 + 64));

    for (int rr = 0; rr < ((REPM >> 18) & 1) * 20; ++rr) grid.sync();
    for (int rep_ = 0; rep_ < 1 + ((REPM >> 1) & 1); ++rep_) { if (rep_) grid.sync(); PH_IDS;
        pg8::Gemm g{XN, (const bf16_t*)(ws + W_GU1), MT, 2 * FF, D, D, D}; pg8::StaticOrder S; S.init(MT, 2 * FF, G, (int)blockIdx.x);
        pg8::EpiSwiglu E{H, FF, nullptr};
        pg8::gemm_phase<pg8::EpiSwiglu, true>(lds, g, S, E, STAG);
        pg8::Gemm g2{MN, (const bf16_t*)(ws + W_MKV), 2048, 1024, D, D, D}; pg8::StaticOrder S2; S2.init(2048, 1024, G, (int)((blockIdx.x + 128) % G));
        pg8::EpiF32 E2{MKVF, 1024};
        pg8::gemm_phase<pg8::EpiF32, true>(lds, g2, S2, E2);
        if (G > 160 && (int)blockIdx.x >= 160) sample_cache_tasks(p, ((int)blockIdx.x - 160) * NWAVES + wave, (G - 160) * NWAVES, lane);
    }
    xcd_barrier(xbar);

    for (int rep_ = 0; rep_ < 1 + ((REPM >> 2) & 1); ++rep_) { if (rep_) grid.sync(); PH_IDS;
        pg8::Gemm g{H, (const bf16_t*)(ws + W_D1), MP, D, FF, FF, FF}; pg8::StaticOrder S; S.init(MP, D, G, (int)blockIdx.x);
        pg8::EpiResid E{R, p.in[0], XN, (float*)(ws + W_SS), 0.5f};
        pg8::gemm_phase<pg8::EpiResid, true>(lds, g, S, E, STAG);
        pg8::Gemm gs{H + (size_t)MP * FF, (const bf16_t*)(ws + W_D1), MS, D, FF, FF, FF / 11}; pg8::SplitOrder Ss; Ss.init(MS, D, 11, G, (int)blockIdx.x);
        pg8::EpiPartial Es{(float*)(ws + W_SLAB), 0.5f};
        pg8::gemm_phase<pg8::EpiPartial, true>(lds, gs, Ss, Es);
        mem_tasks(p, gw, NGW, lane);
    }
    xcd_barrier(xbar);

    for (int rep_ = 0; rep_ < 1 + ((REPM >> 3) & 1); ++rep_) { if (rep_) grid.sync(); PH_IDS;
        for (int m = MP + gw; m < MT; m += NGW) sample_row_reduce(R + (size_t)m * D, (const float*)(ws + W_SLAB) + (size_t)(m - MP) * D, 11, XN + (size_t)m * D, (float*)(ws + W_SS) + m, nullptr, lane);
    }
    xcd_barrier(xbar);

    for (int rep_ = 0; rep_ < 1 + ((REPM >> 4) & 1); ++rep_) { if (rep_) grid.sync(); PH_IDS;
        pg8::Gemm g{XN, (const bf16_t*)(ws + W_IN), MT, NU, D, D, D}; pg8::StaticOrder S; S.init(MT, NU, G, (int)blockIdx.x);
        pg8::EpiBf16 E{U, NU, (const float*)(ws + W_SS)};
        pg8::gemm_phase<pg8::EpiBf16, true>(lds, g, S, E, STAG);
    }
    xcd_barrier(xbar);

    for (int rep_ = 0; rep_ < 1 + ((REPM >> 5) & 1); ++rep_) { if (rep_) grid.sync(); PH_IDS;
        const bool dummy5 = ((REPM >> 5) & 1) && rep_ == 0;
        constexpr int T_ROWS = MT, T_VT = NBATCH * 64 * 8, T_KS = SBATCH * 512, T_VTS = SBATCH * 8 * 8, T_LRU = NBATCH * 64 * 16;
        for (int rr = gw; rr < NBATCH * 512 + MS; rr += NGW) {
            const int r = rr < NBATCH * 512 ? (rr >> 9) * TSEQ + (TSEQ - 512) + (rr & 511) : MP + (rr - NBATCH * 512);
                const bool is_s = r >= MP; const int rs_ = r - MP;
                const int b = is_s ? (rs_ >> 4) : (r >> 12), t = is_s ? (rs_ & 15) : (r & 4095);
                bf16_t* urow = U + (size_t)r * NU;
                float kv[16], vv[16];
                { const u32x4 a = *(const u32x4*)(urow + OKK + lane * 16), c = *(const u32x4*)(urow + OKK + lane * 16 + 8);
                  float t0[8], t1[8]; unpack8(a, t0); unpack8(c, t1);
#pragma unroll
                  for (int i = 0; i < 8; ++i) { kv[i] = t0[i]; kv[8 + i] = t1[i]; } }
                const bool wr_kv = is_s || t >= TSEQ - 512;
                if (wr_kv) { const u32x4 a = *(const u32x4*)(urow + OV + lane * 16), c = *(const u32x4*)(urow + OV + lane * 16 + 8);
                  float t0[8], t1[8]; unpack8(a, t0); unpack8(c, t1);
#pragma unroll
                  for (int i = 0; i < 8; ++i) { vv[i] = t0[i]; vv[8 + i] = t1[i]; } }
                else {
#pragma unroll
                  for (int i = 0; i < 16; ++i) vv[i] = 0.f; }
                float ss = 0.f;
#pragma unroll
                for (int i = 0; i < 16; ++i) ss += kv[i] * kv[i];
                ss += __shfl_xor(ss, 1); ss += __shfl_xor(ss, 2); ss += __shfl_xor(ss, 4);
                const float rstd = rsqrtf(ss * (1.f / 128.f) + EPS);
                const float* gp = p.in[16] + (lane * 16) % 128;
#pragma unroll
                for (int i = 0; i < 4; ++i) { const f32x4 gg = *(const f32x4*)(gp + 4 * i);
#pragma unroll
                    for (int j = 0; j < 4; ++j) kv[4 * i + j] *= rstd * gg[j]; }
                bf16_t* kd = Ks + ((size_t)b * SKEYS + 512 + t) * 1024 + lane * 16;
                if (is_s) { float t0[8], t1[8];
#pragma unroll
                  for (int i = 0; i < 8; ++i) { t0[i] = kv[i]; t1[i] = kv[8 + i]; }
                  *(u32x4*)kd = pack8(t0); *(u32x4*)(kd + 8) = pack8(t1); }
                if (wr_kv) {
                    const size_t ro = is_s ? (size_t)rs_ * 1024 : ((size_t)b * 512 + (t - (TSEQ - 512))) * 1024;
                    float* ko = p.out + (is_s ? O_KS : O_KP) + ro + lane * 16; float* vo = p.out + (is_s ? O_VS : O_VP) + ro + lane * 16;
#pragma unroll
                    for (int i = 0; i < 4; ++i) { *(f32x4*)(ko + 4 * i) = (f32x4){kv[4 * i], kv[4 * i + 1], kv[4 * i + 2], kv[4 * i + 3]}; *(f32x4*)(vo + 4 * i) = (f32x4){vv[4 * i], vv[4 * i + 1], vv[4 * i + 2], vv[4 * i + 3]}; }
                }
                const int tl = is_s ? STOK : TSEQ;
                if (t >= tl - 3) {
                    float xv[16];
                    { const u32x4 a = *(const u32x4*)(urow + OXR + lane * 16), c = *(const u32x4*)(urow + OXR + lane * 16 + 8);
                      float t0[8], t1[8]; unpack8(a, t0); unpack8(c, t1);
#pragma unroll
                      for (int i = 0; i < 8; ++i) { xv[i] = t0[i]; xv[8 + i] = t1[i]; } }
                    float* co = p.out + (is_s ? O_CS : O_CP) + ((size_t)b * 3 + (t - (tl - 3))) * 1024 + lane * 16;
#pragma unroll
                    for (int i = 0; i < 4; ++i) *(f32x4*)(co + 4 * i) = (f32x4){xv[4 * i], xv[4 * i + 1], xv[4 * i + 2], xv[4 * i + 3]};
                }
                if (is_s) {
                    const int h = lane >> 3, d0 = (lane & 7) * 16;
                    bf16_t* dst = Vts + ((size_t)(b * 8 + h) * 128 + d0) * SKEYS + 512 + t;
#pragma unroll
                    for (int i = 0; i < 16; ++i) dst[(size_t)i * SKEYS] = (bf16_t)pk2(vv[i], 0.f);
                }


        }
        for (int r = gw; r < T_VT; r += NGW) {
                const int b = r >> 9, c = (r >> 3) & 63, h = r & 7, t = c * 64 + lane;
                const bf16_t* src = U + ((size_t)b * TSEQ + t) * NU + OV + h * 128;
                bf16_t* dst = Vt + ((size_t)(b * 8 + h) * 128) * TSEQ + t;
#pragma unroll 4
                for (int dc = 0; dc < 16; ++dc) { const u32x4 w = *(const u32x4*)(src + dc * 8);
                    dst[(size_t)(dc * 8 + 0) * TSEQ] = (bf16_t)(w.x & 0xffffu); dst[(size_t)(dc * 8 + 1) * TSEQ] = (bf16_t)(w.x >> 16);
                    dst[(size_t)(dc * 8 + 2) * TSEQ] = (bf16_t)(w.y & 0xffffu); dst[(size_t)(dc * 8 + 3) * TSEQ] = (bf16_t)(w.y >> 16);
                    dst[(size_t)(dc * 8 + 4) * TSEQ] = (bf16_t)(w.z & 0xffffu); dst[(size_t)(dc * 8 + 5) * TSEQ] = (bf16_t)(w.z >> 16);
                    dst[(size_t)(dc * 8 + 6) * TSEQ] = (bf16_t)(w.w & 0xffffu); dst[(size_t)(dc * 8 + 7) * TSEQ] = (bf16_t)(w.w >> 16); }


        }
        if (G <= 160) sample_cache_tasks(p, gw, NGW, lane);
        {
            const int nblk = blockIdx.x & 15, slot = (blockIdx.x >> 4) * NWAVES + wave, nslot = (G >> 4) * NWAVES;
            __syncthreads();
            lru_tables_to_lds(p, lds + LT_OFF, nblk, tid);
            for (int rr = 0; rr < 1 + ((REPM >> 17) & 1) * 3; ++rr)
            for (int u = slot; u < NBATCH * 64; u += nslot) lru_unit<0>(p, u >> 6, u & 63, nblk, lane, nullptr, 0u, 0u, lds + LT_OFF);
            (void)T_LRU;
        }
    }
    xcd_barrier(xbar);

    for (int rep_ = 0; rep_ < 1 + ((REPM >> 6) & 1); ++rep_) { if (rep_) grid.sync(); PH_IDS;
        const bool dummy = ((REPM >> 6) & 1) && rep_ == 0;
        LAS float* tbl = (LAS float*)(lds + 65536);
        constexpr int T_AP = NBATCH * 64 * 8 * 2, T_AS = SBATCH * 8, T_LP = NBATCH * 64 * 16, T_LS = SBATCH * 16;
        for (int wt = blockIdx.x; wt < NBATCH * 8 * 16; wt += G) {
            int pair, cg4;
            if (G == 256) { const int itp = wt >> 8, x = blockIdx.x & 7, j = blockIdx.x >> 3; pair = x * 8 + itp * 2 + (j >> 4); cg4 = (j + itp * 4) & 15; }
            else { pair = wt >> 4; cg4 = wt & 15; }
            attn_wg_prompt(p, lds, pair >> 3, pair & 7, cg4, dummy ? XN : U, dummy ? 1024 : NU, dummy ? 0 : OQ, tid);
        }
        __syncthreads();
        for (int q = blockIdx.x; q < T_AS; q += G) if (wave == 0) {
            const int b = q >> 3, h = q & 7;
            for (int i = lane; i < 640; i += 64) { int d = i - 63; d = d < -256 ? -256 : (d > 256 ? 256 : d); tbl[i] = p.in[17][h * 513 + d + 256] * LOG2E; }
            asm volatile("s_waitcnt lgkmcnt(0)" ::: "memory");
            __builtin_amdgcn_wave_barrier();
            bf16_t* qp = U + ((size_t)MP + (size_t)b * STOK) * NU + OQ + h * 128;
            attn_task<true>(qp, NU, dummy ? XN + ((size_t)MP + (size_t)b * STOK) * 1024 + h * 128 : qp, dummy ? 1024 : NU, Ks + (size_t)b * SKEYS * 1024 + h * 128, 1024, Vts + ((size_t)(b * 8 + h) * 128) * SKEYS, SKEYS,
                            17, 528, 1, p.in[15], tbl, 1024 - 512 + 63, lane);
            asm volatile("s_waitcnt lgkmcnt(0)" ::: "memory");
            __builtin_amdgcn_wave_barrier();
        }
        {
            const int nblk = blockIdx.x & 15, slot = (blockIdx.x >> 4) * NWAVES + wave, nslot = (G >> 4) * NWAVES;
            __syncthreads();
            lru_tables_to_lds(p, lds + LT_OFF, nblk, tid);
            for (int u = slot; u < NBATCH * 64 + SBATCH; u += nslot) { const bool pr = u < NBATCH * 64;
                lru_unit<1>(p, pr ? (u >> 6) : NBATCH + (u - NBATCH * 64), pr ? (u & 63) : 0, nblk, lane, dummy ? XN + (size_t)MT * 1024 : U, dummy ? 1024u : (unsigned)NU, dummy ? 0u : (unsigned)OGR, lds + LT_OFF); }
            (void)T_LP; (void)T_LS;
        }
    }
    xcd_barrier(xbar);

    for (int rep_ = 0; rep_ < 1 + ((REPM >> 7) & 1); ++rep_) { if (rep_) grid.sync(); PH_IDS;
        pg8::PairOrder S; S.init(MT, D, G, (int)blockIdx.x);
        pg8::Gemm g1{U + OQ, (const bf16_t*)(ws + W_PA), MT, D, 1024, NU, 1024, U + OGR, (const bf16_t*)(ws + W_PB)};
        pg8::EpiGate E1{U + OGA, U + OGA, U + OGB, NU};
        pg8::gemm_phase<pg8::EpiGate, true>(lds, g1, S, E1, STAG);
    }
    xcd_barrier(xbar);

    for (int rep_ = 0; rep_ < 1 + ((REPM >> 8) & 1); ++rep_) { if (rep_) grid.sync(); PH_IDS;
        pg8::Gemm g{U + OGA, (const bf16_t*)(ws + W_OUT), MP, D, D, NU, D}; pg8::StaticOrder S; S.init(MP, D, G, (int)blockIdx.x);
        pg8::EpiResid E{R, nullptr, XN, (float*)(ws + W_SS) + MT, 1.0f};
        pg8::gemm_phase<pg8::EpiResid, true>(lds, g, S, E, STAG);
        pg8::Gemm gs{U + (size_t)MP * NU + OGA, (const bf16_t*)(ws + W_OUT), MS, D, D, NU, D / 4}; pg8::SplitOrder Ss; Ss.init(MS, D, 4, G, (int)blockIdx.x);
        pg8::EpiPartial Es{(float*)(ws + W_SLAB), 1.0f};
        pg8::gemm_phase<pg8::EpiPartial, true>(lds, gs, Ss, Es);
    }
    xcd_barrier(xbar);

    for (int rep_ = 0; rep_ < 1 + ((REPM >> 9) & 1); ++rep_) { PH_IDS;
    for (int m = MP + gw; m < MT; m += NGW) sample_row_reduce(R + (size_t)m * D, (const float*)(ws + W_SLAB) + (size_t)(m - MP) * D, 4, XN + (size_t)m * D, (float*)(ws + W_SS) + MT + m, nullptr, lane);
    for (int i = blockIdx.x * 512 + tid; i < MP; i += G * 512) ((float*)(ws + W_SS))[i] = 0.f; }
    xcd_barrier(xbar);

    for (int rep_ = 0; rep_ < 1 + ((REPM >> 10) & 1); ++rep_) { if (rep_) grid.sync(); PH_IDS;
        pg8::Gemm g{XN, (const bf16_t*)(ws + W_MQ), MT, 512, D, D, D}; pg8::StaticOrder S; S.init(MT, 512, G, (int)blockIdx.x);
        pg8::EpiBf16 E{MQ, 512, (const float*)(ws + W_SS) + MT};
        pg8::gemm_phase<pg8::EpiBf16, true>(lds, g, S, E, 0);
    }
    xcd_barrier(xbar);

    for (int rep_ = 0; rep_ < 1 + ((REPM >> 11) & 1); ++rep_) { if (rep_) grid.sync(); PH_IDS;
        for (int wt = blockIdx.x; wt < NBATCH * 4 * 16; wt += G) attn_wg_mem(p, lds, wt >> 6, (wt >> 4) & 3, wt & 15, tid);
        for (int q = gw; q < SBATCH * 4; q += NGW) { const int b = q >> 2, h = q & 3, seq = NBATCH + b;
            bf16_t* qp = MQ + ((size_t)MP + (size_t)b * STOK) * 512 + h * 128;
            attn_task<false>(qp, 512, qp, 512, Km + (size_t)seq * 256 * 512 + h * 128, 512, Vtm + ((size_t)(seq * 4 + h) * 128) * 256, 256, 8, 256, 1, p.in[33], nullptr, 0, lane);
        }
    }
    xcd_barrier(xbar);

    for (int rep_ = 0; rep_ < 1 + ((REPM >> 12) & 1); ++rep_) { if (rep_) grid.sync(); PH_IDS;
        pg8::Gemm g{MQ, (const bf16_t*)(ws + W_MO), MT, D, 512, 512, 512}; pg8::StaticOrder S; S.init(MT, D, G, (int)blockIdx.x);
        pg8::EpiResid E{R, nullptr, XN, (float*)(ws + W_SS) + 2 * MT, 1.0f};
        pg8::gemm_phase<pg8::EpiResid, true>(lds, g, S, E, 0);
    }
    xcd_barrier(xbar);

    for (int rep_ = 0; rep_ < 1 + ((REPM >> 14) & 1); ++rep_) { if (rep_) grid.sync(); PH_IDS;
        pg8::Gemm g{XN, (const bf16_t*)(ws + W_GU2), MT, 2 * FF, D, D, D}; pg8::StaticOrder S; S.init(MT, 2 * FF, G, (int)blockIdx.x);
        pg8::EpiSwiglu E{H, FF, (const float*)(ws + W_SS) + 2 * MT};
        pg8::gemm_phase<pg8::EpiSwiglu, true>(lds, g, S, E, STAG);
    }
    xcd_barrier(xbar);

    for (int rep_ = 0; rep_ < 1 + ((REPM >> 15) & 1); ++rep_) { if (rep_) grid.sync(); PH_IDS;
        pg8::Gemm g{H, (const bf16_t*)(ws + W_D2), MP, D, FF, FF, FF}; pg8::StaticOrder S; S.init(MP, D, G, (int)blockIdx.x);
        pg8::EpiResid E{R, nullptr, XN, (float*)(ws + W_SS), 0.5f};
        pg8::gemm_phase<pg8::EpiResid, true>(lds, g, S, E, STAG);
        pg8::Gemm gs{H + (size_t)MP * FF, (const bf16_t*)(ws + W_D2), MS, D, FF, FF, FF / 11}; pg8::SplitOrder Ss; Ss.init(MS, D, 11, G, (int)blockIdx.x);
        pg8::EpiPartial Es{(float*)(ws + W_SLAB), 0.5f};
        pg8::gemm_phase<pg8::EpiPartial, true>(lds, gs, Ss, Es);
    }
    xcd_barrier(xbar);

    for (int rep_ = 0; rep_ < 1 + ((REPM >> 16) & 1); ++rep_) { PH_IDS;
    for (int m = gw; m < MT; m += NGW) {
        if (m >= MP) { sample_row_reduce(R + (size_t)m * D, (const float*)(ws + W_SLAB) + (size_t)(m - MP) * D, 11, nullptr, nullptr, p.in[40], lane); continue; }
        const float rs = rsqrtf(((const float*)(ws + W_SS))[m] * (1.f / D) + EPS);
        const u32x2* xb = (const u32x2*)(XN + (size_t)m * D) + lane; f32x4* yo = (f32x4*)(R + (size_t)m * D) + lane;
#pragma unroll
        for (int j = 0; j < 8; ++j) { const u32x2 w = xb[64 * j]; const f32x4 gg = ((const f32x4*)p.in[40])[lane + 64 * j];
            yo[64 * j] = (f32x4){bf_lo(w.x) * rs * gg.x, bf_hi(w.x) * rs * gg.y, bf_lo(w.y) * rs * gg.z, bf_hi(w.y) * rs * gg.w}; }
    } }
}

extern "C" void kernel_launch(void* const* d_in, const int* in_sizes, int n_in, void* d_out, int out_size, void* d_ws, size_t ws_size, hipStream_t stream) {
    static int grid = 0;
    if (grid == 0) {
        if (n_in != 41 || (size_t)out_size != O_END || ws_size < W_END) {
            fprintf(stderr, "kernel_launch: unexpected sizes: n_in %d out %d (want %zu) ws %zu (want >= %zu)\n", n_in, out_size, (size_t)O_END, ws_size, (size_t)W_END); grid = -1; return; }
        int dev = 0, cus = 0, per_cu = 0;
        hipGetDevice(&dev); hipDeviceGetAttribute(&cus, hipDeviceAttributeMultiprocessorCount, dev);
        hipFuncSetAttribute((const void*)fwd_megakernel, hipFuncAttributeMaxDynamicSharedMemorySize, LDS_BYTES);
        hipOccupancyMaxActiveBlocksPerMultiprocessor(&per_cu, (const void*)fwd_megakernel, NWAVES * 64, LDS_BYTES);
        if (per_cu < 1) { fprintf(stderr, "kernel_launch: occupancy query says %d blocks per CU\n", per_cu); per_cu = 1; }
        (void)hipGetLastError();
        grid = cus * 1;
    }
    if (grid < 0) return;
    Params p{};
    for (int i = 0; i < 41; ++i) p.in[i] = (const float*)d_in[i];
    p.out = (float*)d_out; p.ws = (unsigned char*)d_ws;
    void* args[] = {&p};
    hipError_t e = hipLaunchCooperativeKernel((const void*)fwd_megakernel, dim3(grid), dim3(NWAVES * 64), args, LDS_BYTES, stream);
    if (e != hipSuccess) fprintf(stderr, "kernel_launch: cooperative launch failed: %s (grid %d)\n", hipGetErrorString(e), grid);
}
```
